# Optimizing an MI355X kernel written in HIP

```python
import math
import jax
import jax.numpy as jnp
from jax import lax
import numpy as np

D_MODEL = 1024
BATCH = 8
SEQ = 2048
DEPTH = 4
DEC_BATCH = 128
DEC_SEQ = 1
PAST_LEN = 16384
PAGE_SIZE = 128

N_HYB_LAYERS = (DEPTH + 1) // 2
N_SSM_LAYERS = DEPTH // 2
CONV_WIDTH = 4
CHUNK = 64
NORM_EPS = 1e-6

GDN_HEADS = 4
GDN_KEY_DIM = 128
GDN_VAL_DIM = 128
GDN_QKV_DIM = GDN_HEADS * (2 * GDN_KEY_DIM + GDN_VAL_DIM)
GDN_OUT_DIM = GDN_HEADS * GDN_VAL_DIM

RET_HEADS = 4
RET_KEY_DIM = 64
RET_VAL_DIM = 128
RET_OUT_DIM = RET_HEADS * RET_VAL_DIM
ROPE_BASE = 10000.0

HYB_MIX_DIM = GDN_OUT_DIM + RET_OUT_DIM
HYB_IN_SIZES = (GDN_QKV_DIM, GDN_OUT_DIM, GDN_HEADS, GDN_HEADS,
                RET_HEADS * RET_KEY_DIM, RET_HEADS * RET_KEY_DIM, RET_OUT_DIM, RET_OUT_DIM)
HYB_IN_DIM = sum(HYB_IN_SIZES)

SSM_INNER = 2 * D_MODEL
SSM_HEAD_DIM = 64
SSM_HEADS = SSM_INNER // SSM_HEAD_DIM
SSM_GROUPS = 4
SSM_HEADS_PER_GROUP = SSM_HEADS // SSM_GROUPS
SSM_STATE = 128
SSM_CONV_DIM = SSM_INNER + 2 * SSM_GROUPS * SSM_STATE
SSM_IN_SIZES = (SSM_INNER, SSM_CONV_DIM, SSM_HEADS)
SSM_IN_DIM = sum(SSM_IN_SIZES)

MLP_HIDDEN = 4 * D_MODEL

kernel_name = 'hybrid_gdn_retnet_ssd_decoder_step'


def split_last(t, sizes):
    return jnp.split(t, np.cumsum(sizes)[:-1].tolist(), axis=-1)


def chunk_len(length):
    return CHUNK if length % CHUNK == 0 else length


def rms_norm(x, w):
    x32 = x.astype(jnp.float32)
    y = x32 * lax.rsqrt(jnp.mean(x32 * x32, axis=-1, keepdims=True) + NORM_EPS)
    return (y * w.astype(jnp.float32)).astype(x.dtype)


def l2_normalize(x):
    x32 = x.astype(jnp.float32)
    return x32 * lax.rsqrt(jnp.sum(x32 * x32, axis=-1, keepdims=True) + NORM_EPS)


def head_group_norm(x):
    x32 = x.astype(jnp.float32)
    xc = x32 - jnp.mean(x32, axis=-1, keepdims=True)
    return xc * lax.rsqrt(jnp.mean(xc * xc, axis=-1, keepdims=True) + NORM_EPS)


def rotary(t, pos):
    half = t.shape[-1] // 2
    inv_freq = ROPE_BASE ** (-jnp.arange(half, dtype=jnp.float32) / half)
    ang = pos.astype(jnp.float32)[:, None] * inv_freq[None, :]
    cos = jnp.cos(ang)[None, :, None, :]
    sin = jnp.sin(ang)[None, :, None, :]
    t32 = t.astype(jnp.float32)
    t1, t2 = t32[..., :half], t32[..., half:]
    return jnp.concatenate([t1 * cos - t2 * sin, t2 * cos + t1 * sin], axis=-1)


def causal_conv(x, buf, w, bias=None):
    l = x.shape[1]
    xp = jnp.concatenate([buf.astype(x.dtype), x], axis=1)
    out = xp[:, 0:l] * w[0]
    for i in range(1, w.shape[0]):
        out = out + xp[:, i:i + l] * w[i]
    if bias is not None:
        out = out + bias
    return out, xp[:, l:]


def decay_linear_attention(q, k, v, g, s0, chunk):
    dtype = s0.dtype
    b, l = q.shape[:2]
    out_shape = v.shape

    def blocks(t):
        return jnp.moveaxis(t.astype(jnp.float32).reshape(b, l // chunk, chunk, *t.shape[2:]), 1, 0)

    idx = jnp.arange(chunk)
    causal = (idx[:, None] >= idx[None, :])[None, :, :, None, None]

    def step(s, blk):
        qc, kc, vc, gc = blk
        gcum = jnp.cumsum(gc, axis=1)
        diff = gcum[:, :, None] - gcum[:, None, :]
        decay = jnp.where(causal, jnp.exp(jnp.where(causal, diff, 0.0)), 0.0)
        scores = jnp.einsum('bigk,bjgk->bijg', qc, kc)
        y_intra = jnp.einsum('bijgr,bjgrv->bigrv', scores[..., None] * decay, vc)
        y_inter = jnp.einsum('bigk,bgrkv->bigrv', qc, s) * jnp.exp(gcum)[..., None]
        g_end = gcum[:, -1]
        s_new = s * jnp.exp(g_end)[..., None, None] + jnp.einsum(
            'bjgk,bjgrv->bgrkv', kc, vc * jnp.exp(g_end[:, None] - gcum)[..., None])
        return s_new, y_intra + y_inter

    s_final, ys = lax.scan(step, s0.astype(jnp.float32), (blocks(q), blocks(k), blocks(v), blocks(g)))
    y = jnp.moveaxis(ys, 0, 1).reshape(out_shape)
    return y, s_final.astype(dtype)


def gated_delta_rule(q, k, v, g, beta, s0, chunk):
    dtype = s0.dtype
    b, l, h, _ = q.shape
    dv = v.shape[-1]

    def blocks(t):
        t = t.astype(jnp.float32).reshape(b, l // chunk, chunk, *t.shape[2:])
        return jnp.moveaxis(jnp.moveaxis(t, 1, 0), 2, 3)

    idx = jnp.arange(chunk)
    causal = idx[:, None] >= idx[None, :]
    strict = idx[:, None] > idx[None, :]
    eye = jnp.eye(chunk, dtype=jnp.float32)

    def step(s, blk):
        qc, kc, vc, gc, bc = blk
        gcum = jnp.cumsum(gc, axis=-1)
        diff = gcum[..., :, None] - gcum[..., None, :]
        decay = jnp.where(causal, jnp.exp(jnp.where(causal, diff, 0.0)), 0.0)
        kk = jnp.einsum('bhik,bhjk->bhij', kc, kc)
        lower = jnp.where(strict, bc[..., :, None] * kk * decay, 0.0)
        rhs = jnp.concatenate([vc * bc[..., None], kc * (bc * jnp.exp(gcum))[..., None]], axis=-1)
        sol = lax.linalg.triangular_solve(eye + lower, rhs, left_side=True, lower=True, unit_diagonal=True)
        u, w = sol[..., :dv], sol[..., dv:]
        delta = u - jnp.einsum('bhik,bhkv->bhiv', w, s)
        qk = jnp.einsum('bhik,bhjk->bhij', qc, kc) * decay
        y = (jnp.einsum('bhik,bhkv->bhiv', qc * jnp.exp(gcum)[..., None], s)
             + jnp.einsum('bhij,bhjv->bhiv', qk, delta))
        g_end = gcum[..., -1:]
        s_new = s * jnp.exp(g_end)[..., None] + jnp.einsum(
            'bhjk,bhjv->bhkv', kc * jnp.exp(g_end - gcum)[..., None], delta)
        return s_new, y

    s_final, ys = lax.scan(step, s0.astype(jnp.float32),
                           (blocks(q), blocks(k), blocks(v), blocks(g), blocks(beta)))
    y = jnp.swapaxes(jnp.moveaxis(ys, 0, 1), 2, 3).reshape(b, l, h, dv)
    return y, s_final.astype(dtype)


def hybrid_mixer(h, pos, s_gdn, c_gdn, s_ret, w_in, gdn_conv_w, gdn_a_log, gdn_dt_bias,
                 gdn_norm_w, ret_norm_w, w_out):
    b, l, _ = h.shape
    chunk = chunk_len(l)
    proj = jnp.einsum('bld,de->ble', h, w_in)
    qkv_a, z_a, beta_raw, a_raw, q_b, k_b, v_b, gate_b = split_last(proj, HYB_IN_SIZES)

    qkv_a, c_gdn_new = causal_conv(qkv_a, c_gdn, gdn_conv_w)
    qkv_a = jax.nn.silu(qkv_a)
    q_a, k_a, v_a = split_last(qkv_a, (GDN_HEADS * GDN_KEY_DIM, GDN_HEADS * GDN_KEY_DIM, GDN_OUT_DIM))
    q_a = l2_normalize(q_a.reshape(b, l, GDN_HEADS, GDN_KEY_DIM)) * GDN_KEY_DIM ** -0.5
    k_a = l2_normalize(k_a.reshape(b, l, GDN_HEADS, GDN_KEY_DIM))
    v_a = v_a.reshape(b, l, GDN_HEADS, GDN_VAL_DIM)
    beta = jax.nn.sigmoid(beta_raw.astype(jnp.float32))
    g_a = -jnp.exp(gdn_a_log.astype(jnp.float32)) * jax.nn.softplus(a_raw.astype(jnp.float32) + gdn_dt_bias)
    o_a, s_gdn_new = gated_delta_rule(q_a, k_a, v_a, g_a, beta, s_gdn, chunk)
    o_a = rms_norm(o_a, gdn_norm_w) * jax.nn.silu(z_a.astype(jnp.float32).reshape(b, l, GDN_HEADS, GDN_VAL_DIM))

    q_b = rotary(q_b.reshape(b, l, RET_HEADS, RET_KEY_DIM), pos)
    k_b = rotary(k_b.reshape(b, l, RET_HEADS, RET_KEY_DIM), pos) * RET_KEY_DIM ** -0.5
    v_b = v_b.reshape(b, l, RET_HEADS, 1, RET_VAL_DIM)
    log_gamma = jnp.log(1.0 - jnp.exp2(-5.0 - jnp.arange(RET_HEADS, dtype=jnp.float32)))
    g_b = jnp.broadcast_to(log_gamma[:, None], (b, l, RET_HEADS, 1))
    o_b, s_ret_new = decay_linear_attention(q_b, k_b, v_b, g_b, s_ret[:, :, None], chunk)
    o_b = head_group_norm(o_b.reshape(b, l, RET_HEADS, RET_VAL_DIM)).reshape(b, l, RET_OUT_DIM)
    o_b = o_b * ret_norm_w * jax.nn.silu(gate_b.astype(jnp.float32))

    mixed = jnp.concatenate([o_a.reshape(b, l, GDN_OUT_DIM), o_b], axis=-1).astype(h.dtype)
    out = jnp.einsum('ble,ed->bld', mixed, w_out)
    return out, s_gdn_new, c_gdn_new, s_ret_new[:, :, 0]


def ssd_mixer(h, s_ssm, c_ssm, w_in, conv_w, conv_b, dt_bias, a_log, d_skip, norm_w, w_out):
    b, l, _ = h.shape
    chunk = chunk_len(l)
    proj = jnp.einsum('bld,de->ble', h, w_in)
    z, xbc, dt_raw = split_last(proj, SSM_IN_SIZES)
    xbc, c_ssm_new = causal_conv(xbc, c_ssm, conv_w, conv_b)
    xbc = jax.nn.silu(xbc)
    xs, b_mat, c_mat = split_last(xbc, (SSM_INNER, SSM_GROUPS * SSM_STATE, SSM_GROUPS * SSM_STATE))
    dt = jax.nn.softplus(dt_raw.astype(jnp.float32) + dt_bias).reshape(b, l, SSM_GROUPS, SSM_HEADS_PER_GROUP)
    a = -jnp.exp(a_log.astype(jnp.float32)).reshape(SSM_GROUPS, SSM_HEADS_PER_GROUP)
    xh = xs.astype(jnp.float32).reshape(b, l, SSM_GROUPS, SSM_HEADS_PER_GROUP, SSM_HEAD_DIM)
    s0 = s_ssm.reshape(b, SSM_GROUPS, SSM_HEADS_PER_GROUP, SSM_STATE, SSM_HEAD_DIM)
    y, s_new = decay_linear_attention(
        c_mat.reshape(b, l, SSM_GROUPS, SSM_STATE), b_mat.reshape(b, l, SSM_GROUPS, SSM_STATE),
        xh * dt[..., None], dt * a, s0, chunk)
    y = y + d_skip.reshape(SSM_GROUPS, SSM_HEADS_PER_GROUP)[..., None] * xh
    y = y.reshape(b, l, SSM_INNER) * jax.nn.silu(z.astype(jnp.float32))
    y = rms_norm(y.reshape(b, l, SSM_GROUPS, SSM_INNER // SSM_GROUPS),
                 norm_w.reshape(SSM_GROUPS, SSM_INNER // SSM_GROUPS)).reshape(b, l, SSM_INNER)
    out = jnp.einsum('ble,ed->bld', y.astype(h.dtype), w_out)
    return out, s_new.reshape(b, SSM_HEADS, SSM_STATE, SSM_HEAD_DIM), c_ssm_new


def squared_relu_mlp(h, w1, w2):
    a = jax.nn.relu(jnp.einsum('bld,df->blf', h, w1))
    return jnp.einsum('blf,fd->bld', a * a, w2)


def trunk(x, pos, s_gdn, c_gdn, s_ret, s_ssm, c_ssm, norm_mix, norm_mlp, norm_final,
          w_in_hyb, gdn_conv_w, gdn_a_log, gdn_dt_bias, gdn_norm_w, ret_norm_w, w_out_hyb,
          w_in_ssm, ssm_conv_w, ssm_conv_b, ssm_dt_bias, ssm_a_log, ssm_d, ssm_norm_w, w_out_ssm,
          mlp_w1, mlp_w2):
    new_gdn, new_gdn_conv, new_ret, new_ssm, new_ssm_conv = [], [], [], [], []
    for layer in range(DEPTH):
        i = layer // 2
        h = rms_norm(x, norm_mix[layer])
        if layer % 2 == 0:
            out, sg, cg, sr = hybrid_mixer(h, pos, s_gdn[i], c_gdn[i], s_ret[i], w_in_hyb[i], gdn_conv_w[i],
                                           gdn_a_log[i], gdn_dt_bias[i], gdn_norm_w[i], ret_norm_w[i],
                                           w_out_hyb[i])
            new_gdn.append(sg)
            new_gdn_conv.append(cg)
            new_ret.append(sr)
        else:
            out, ss, cs = ssd_mixer(h, s_ssm[i], c_ssm[i], w_in_ssm[i], ssm_conv_w[i], ssm_conv_b[i],
                                    ssm_dt_bias[i], ssm_a_log[i], ssm_d[i], ssm_norm_w[i], w_out_ssm[i])
            new_ssm.append(ss)
            new_ssm_conv.append(cs)
        x = x + out
        x = x + squared_relu_mlp(rms_norm(x, norm_mlp[layer]), mlp_w1[layer], mlp_w2[layer])
    return (rms_norm(x, norm_final), jnp.stack(new_gdn), jnp.stack(new_gdn_conv), jnp.stack(new_ret),
            jnp.stack(new_ssm), jnp.stack(new_ssm_conv))


def setup_inputs(seed: int = 0) -> dict:
    key = jax.random.key(seed)
    ks = jax.random.split(key, 32)
    f32 = jnp.float32

    def normal(k, shape, scale):
        return scale * jax.random.normal(k, shape, f32)

    def gain(k, shape):
        return 1.0 + 0.01 * jax.random.normal(k, shape, f32)

    def dt_bias(k, shape):
        dt = jnp.exp(jax.random.uniform(k, shape, f32, math.log(1e-3), math.log(1e-1)))
        return dt + jnp.log(-jnp.expm1(-dt))

    def a_log(k, shape):
        return jnp.log(jax.random.uniform(k, shape, f32, 1.0, 16.0))

    return {
        'x_prompt': normal(ks[0], (BATCH, SEQ, D_MODEL), 1.0),
        'x_sample': normal(ks[1], (DEC_BATCH, DEC_SEQ, D_MODEL), 1.0),
        'state_gdn': normal(ks[2], (N_HYB_LAYERS, DEC_BATCH, GDN_HEADS, GDN_KEY_DIM, GDN_VAL_DIM), 0.1),
        'state_gdn_conv': normal(ks[3], (N_HYB_LAYERS, DEC_BATCH, CONV_WIDTH - 1, GDN_QKV_DIM), 1.0),
        'state_ret': normal(ks[4], (N_HYB_LAYERS, DEC_BATCH, RET_HEADS, RET_KEY_DIM, RET_VAL_DIM), 0.5),
        'state_ssm': normal(ks[5], (N_SSM_LAYERS, DEC_BATCH, SSM_HEADS, SSM_STATE, SSM_HEAD_DIM), 0.1),
        'state_ssm_conv': normal(ks[6], (N_SSM_LAYERS, DEC_BATCH, CONV_WIDTH - 1, SSM_CONV_DIM), 1.0),
        'norm_mix': gain(ks[7], (DEPTH, D_MODEL)),
        'norm_mlp': gain(ks[8], (DEPTH, D_MODEL)),
        'norm_final': gain(ks[9], (D_MODEL,)),
        'w_in_hyb': normal(ks[10], (N_HYB_LAYERS, D_MODEL, HYB_IN_DIM), D_MODEL ** -0.5),
        'gdn_conv_w': normal(ks[11], (N_HYB_LAYERS, CONV_WIDTH, GDN_QKV_DIM), CONV_WIDTH ** -0.5),
        'gdn_a_log': a_log(ks[12], (N_HYB_LAYERS, GDN_HEADS)),
        'gdn_dt_bias': dt_bias(ks[13], (N_HYB_LAYERS, GDN_HEADS)),
        'gdn_norm_w': gain(ks[14], (N_HYB_LAYERS, GDN_VAL_DIM)),
        'ret_norm_w': gain(ks[15], (N_HYB_LAYERS, RET_OUT_DIM)),
        'w_out_hyb': normal(ks[16], (N_HYB_LAYERS, HYB_MIX_DIM, D_MODEL), HYB_MIX_DIM ** -0.5),
        'w_in_ssm': normal(ks[17], (N_SSM_LAYERS, D_MODEL, SSM_IN_DIM), D_MODEL ** -0.5),
        'ssm_conv_w': normal(ks[18], (N_SSM_LAYERS, CONV_WIDTH, SSM_CONV_DIM), CONV_WIDTH ** -0.5),
        'ssm_conv_b': normal(ks[19], (N_SSM_LAYERS, SSM_CONV_DIM), 0.02),
        'ssm_dt_bias': dt_bias(ks[20], (N_SSM_LAYERS, SSM_HEADS)),
        'ssm_a_log': a_log(ks[21], (N_SSM_LAYERS, SSM_HEADS)),
        'ssm_d': 1.0 + 0.1 * jax.random.normal(ks[22], (N_SSM_LAYERS, SSM_HEADS), f32),
        'ssm_norm_w': gain(ks[23], (N_SSM_LAYERS, SSM_INNER)),
        'w_out_ssm': normal(ks[24], (N_SSM_LAYERS, SSM_INNER, D_MODEL), SSM_INNER ** -0.5),
        'mlp_w1': normal(ks[25], (DEPTH, D_MODEL, MLP_HIDDEN), D_MODEL ** -0.5),
        'mlp_w2': normal(ks[26], (DEPTH, MLP_HIDDEN, D_MODEL), 0.5 * MLP_HIDDEN ** -0.5),
    }


def reference(x_prompt, x_sample, state_gdn, state_gdn_conv, state_ret, state_ssm, state_ssm_conv,
              norm_mix, norm_mlp, norm_final, w_in_hyb, gdn_conv_w, gdn_a_log, gdn_dt_bias, gdn_norm_w,
              ret_norm_w, w_out_hyb, w_in_ssm, ssm_conv_w, ssm_conv_b, ssm_dt_bias, ssm_a_log, ssm_d,
              ssm_norm_w, w_out_ssm, mlp_w1, mlp_w2):
    bp, lp, _ = x_prompt.shape
    ls = x_sample.shape[1]
    dt = x_prompt.dtype
    z_gdn = jnp.zeros((N_HYB_LAYERS, bp, GDN_HEADS, GDN_KEY_DIM, GDN_VAL_DIM), dt)
    z_gdn_conv = jnp.zeros((N_HYB_LAYERS, bp, CONV_WIDTH - 1, GDN_QKV_DIM), dt)
    z_ret = jnp.zeros((N_HYB_LAYERS, bp, RET_HEADS, RET_KEY_DIM, RET_VAL_DIM), dt)
    z_ssm = jnp.zeros((N_SSM_LAYERS, bp, SSM_HEADS, SSM_STATE, SSM_HEAD_DIM), dt)
    z_ssm_conv = jnp.zeros((N_SSM_LAYERS, bp, CONV_WIDTH - 1, SSM_CONV_DIM), dt)
    pos_prompt = jnp.arange(lp, dtype=jnp.int32)
    pos_sample = PAST_LEN + jnp.arange(ls, dtype=jnp.int32)

    y_prompt, p_gdn, p_gdn_conv, p_ret, p_ssm, p_ssm_conv = trunk(
        x_prompt, pos_prompt, z_gdn, z_gdn_conv, z_ret, z_ssm, z_ssm_conv, norm_mix, norm_mlp, norm_final,
        w_in_hyb, gdn_conv_w, gdn_a_log, gdn_dt_bias, gdn_norm_w, ret_norm_w, w_out_hyb,
        w_in_ssm, ssm_conv_w, ssm_conv_b, ssm_dt_bias, ssm_a_log, ssm_d, ssm_norm_w, w_out_ssm,
        mlp_w1, mlp_w2)
    y_sample, s_gdn, s_gdn_conv, s_ret, s_ssm, s_ssm_conv = trunk(
        x_sample, pos_sample, state_gdn, state_gdn_conv, state_ret, state_ssm, state_ssm_conv,
        norm_mix, norm_mlp, norm_final,
        w_in_hyb, gdn_conv_w, gdn_a_log, gdn_dt_bias, gdn_norm_w, ret_norm_w, w_out_hyb,
        w_in_ssm, ssm_conv_w, ssm_conv_b, ssm_dt_bias, ssm_a_log, ssm_d, ssm_norm_w, w_out_ssm,
        mlp_w1, mlp_w2)
    return (y_prompt, y_sample, p_gdn, p_gdn_conv, p_ret, p_ssm, p_ssm_conv,
            s_gdn, s_gdn_conv, s_ret, s_ssm, s_ssm_conv)
```

```cpp
#include <hip/hip_runtime.h>
#include <hip/hip_cooperative_groups.h>
#include <cstdio>
namespace cg = cooperative_groups;
namespace pg8 {
#define PG8_LAS __attribute__((address_space(3)))
typedef unsigned short bf16_t;
typedef short bf16x8 __attribute__((ext_vector_type(8)));
typedef float f32x4 __attribute__((ext_vector_type(4)));
typedef unsigned u32x4 __attribute__((ext_vector_type(4)));
constexpr int BM = 256, BK = 64, HALF = 128, HTB = HALF * BK * 2  , STAGE_BYTES = 8 * HTB, NXCD = 8, WGM = 8;

__host__ __device__ __forceinline__ int lds_byte(int r, int c) { const int st = (r >> 4) * 2 + (c >> 5), rr = r & 15, cc = c & 31, ob = rr * 64 + cc * 2; return st * 1024 + (ob ^ (((ob >> 9) & 1) << 5)); }
__host__ __device__ __forceinline__ void stage_rc(int b, int& R, int& C) { const int st = b / 1024, sb = b % 1024, swz = sb ^ (((sb >> 9) & 1) << 5); R = (st >> 1) * 16 + swz / 64; C = (st & 1) * 32 + (swz % 64) / 2; }
__host__ __device__ __forceinline__ int perm32(int rho) { const int n = rho >> 4, i = rho & 15; return 8 * (i >> 2) + 4 * n + (i & 3); }

struct Unit { int pm, pn; };
struct Gemm { const bf16_t* A; const bf16_t* Bt; int M, N, K; };

struct StaticOrder {
    int nM, nN, nwg, G, c;
    __host__ __device__ void init(int M, int N, int G_, int c_) { nM = M / BM; nN = N / BM; nwg = nM * nN; G = G_; c = c_; }
    __host__ __device__ bool next(int i, Unit& u) const {
        const long L = (long)i * G + c; if (L >= nwg) return false;
        int wgid = (int)L; { const int q = nwg / NXCD, r = nwg % NXCD, xcd = wgid % NXCD, off = wgid / NXCD; wgid = (xcd < r ? xcd * (q + 1) : r * (q + 1) + (xcd - r) * q) + off; }
        const int nig = WGM * nN, gid = wgid / nig, fm = gid * WGM, gsz = (nM - fm) < WGM ? (nM - fm) : WGM;
        u.pm = fm + ((wgid % nig) % gsz); u.pn = (wgid % nig) / gsz; return true;
    }
    __device__ __forceinline__ void a_ready(const Unit&) const {}
    __device__ __forceinline__ void done(const Unit&) const {}
};
template <class Epi, class Sched, bool STAMP = false>
__device__ __forceinline__ void gemm_phase(PG8_LAS unsigned char* lds, const Gemm g, const Sched& S, const Epi& E, unsigned long long* stamps, const int tid_in) {
    const int tid = tid_in, wid = __builtin_amdgcn_readfirstlane(tid >> 6), lane = tid & 63, wr = wid >> 2, wc = wid & 3, fr = lane & 15, fq = lane >> 4;
    const int K = g.K, nt = K / BK;
    int ts_lo = 0, ts_hi = 0, nts = 0; const unsigned long long rt_entry = STAMP ? (unsigned long long)wall_clock64() : 0ull;
#define PG8_STAMP() do { if (STAMP && wid == 0 && nts < 64) { const unsigned long long _c = (unsigned long long)clock64(); \
        ts_lo = (lane == nts) ? (int)(unsigned)_c : ts_lo; ts_hi = (lane == nts) ? (int)(unsigned)(_c >> 32) : ts_hi; ++nts; } } while (0)
    PG8_STAMP();
    unsigned voffA[2], voffB[2];
#pragma unroll
    for (int i = 0; i < 2; ++i) { int R, C; stage_rc(tid * 16 + i * 8192, R, C); const int Rb = Epi::PERM ? ((R & ~31) + perm32(R & 31)) : R;
        voffA[i] = (unsigned)(R * K + C) * 2u; voffB[i] = (unsigned)(Rb * K + C) * 2u; }
    const size_t kstep = (size_t)(BK * 2);
    const size_t hstep = (size_t)HALF * K * 2;
    const size_t tstep = 2 * hstep;
    const unsigned ldsw = (unsigned)wid * 1024u;
    const int aoff = lds_byte(wr * 64 + fr, fq * 8), boff = lds_byte(wc * 32 + fr, fq * 8);
#define PG8_SA(b, h) (((b) * 2 + (h)) * HTB)
#define PG8_SB(b, h) ((4 + (b) * 2 + (h)) * HTB)
#define PG8_STAGE(bufoff, gbase, voff) do { _Pragma("unroll") for (int _i = 0; _i < 2; ++_i) \
        __builtin_amdgcn_global_load_lds((const unsigned*)((const char*)(gbase) + (voff)[_i]), (PG8_LAS unsigned*)(lds + (bufoff) + ldsw + _i * 8192), 16, 0, 0); } while (0)
#define PG8_LDA(dst, b, h) do { _Pragma("unroll") for (int m = 0; m < 4; ++m) _Pragma("unroll") for (int k = 0; k < 2; ++k) dst[m][k] = *(const PG8_LAS bf16x8*)(lds + PG8_SA(b, h) + aoff + m * 2048 + k * 1024); } while (0)
#define PG8_LDB(dst, b, h) do { _Pragma("unroll") for (int n = 0; n < 2; ++n) _Pragma("unroll") for (int k = 0; k < 2; ++k) dst[n][k] = *(const PG8_LAS bf16x8*)(lds + PG8_SB(b, h) + boff + n * 2048 + k * 1024); } while (0)
#define PG8_MMA(ai, bj, At, Bt) do { __builtin_amdgcn_s_setprio(1); _Pragma("unroll") for (int m = 0; m < 4; ++m) _Pragma("unroll") for (int n = 0; n < 2; ++n) _Pragma("unroll") for (int k = 0; k < 2; ++k) \
        acc[ai][bj][m][n] = __builtin_amdgcn_mfma_f32_16x16x32_bf16(Bt[n][k], At[m][k], acc[ai][bj][m][n], 0, 0, 0); __builtin_amdgcn_s_setprio(0); } while (0)
#define PG8_WAIT_V(n) asm volatile("s_waitcnt vmcnt(" #n ")" ::: "memory")
#define PG8_WAIT_L(n) asm volatile("s_waitcnt lgkmcnt(" #n ")" ::: "memory")
#define PG8_BAR __builtin_amdgcn_s_barrier()
#define PG8_SCHED __builtin_amdgcn_sched_barrier(0)
    Unit cur, nxt; int ui = 0;
    if (!S.next(0, cur)) return;
    f32x4 acc[2][2][4][2];
#pragma unroll
    for (int a = 0; a < 2; ++a)
#pragma unroll
        for (int b = 0; b < 2; ++b)
#pragma unroll
            for (int m = 0; m < 4; ++m)
#pragma unroll
                for (int n = 0; n < 2; ++n) acc[a][b][m][n] = (f32x4){0.f, 0.f, 0.f, 0.f};
    bf16x8 At[4][2], B0[2][2], B1[2][2];
    const char* cA = (const char*)g.A + (size_t)cur.pm * tstep; const char* cB = (const char*)g.Bt + (size_t)cur.pn * tstep;
    S.a_ready(cur);
    PG8_STAGE(PG8_SB(0, 0), cB, voffB); PG8_STAGE(PG8_SA(0, 0), cA, voffA); PG8_STAGE(PG8_SB(0, 1), cB + hstep, voffB); PG8_STAGE(PG8_SA(0, 1), cA + hstep, voffA);
    if (wr == 1) PG8_BAR;
    PG8_WAIT_V(4); PG8_BAR;
    PG8_STAGE(PG8_SB(1, 0), cB + kstep, voffB); PG8_STAGE(PG8_SA(1, 0), cA + kstep, voffA); PG8_STAGE(PG8_SB(1, 1), cB + hstep + kstep, voffB);
    PG8_WAIT_V(6); PG8_BAR;
    PG8_STAMP();
    for (;;) {
        const bool has_next = S.next(ui + 1, nxt);
        const char* nA = has_next ? (const char*)g.A + (size_t)nxt.pm * tstep : cA; const char* nB = has_next ? (const char*)g.Bt + (size_t)nxt.pn * tstep : cB;
        for (int t = 0; t < nt; t += 2) {
            const bool last = (t == nt - 2);
            const char* a1 = cA + (size_t)(t + 1) * kstep;
            const char* a2 = last ? nA : cA + (size_t)(t + 2) * kstep; const char* b2 = last ? nB : cB + (size_t)(t + 2) * kstep;
            const char* a3 = a2 + kstep; const char* b3 = b2 + kstep;
            if (last && has_next) S.a_ready(nxt);
            PG8_LDB(B0, 0, 0); PG8_SCHED; PG8_LDA(At, 0, 0); PG8_STAGE(PG8_SA(1, 1), a1 + hstep, voffA);
            PG8_WAIT_L(8); PG8_BAR; PG8_WAIT_L(0); PG8_MMA(0, 0, At, B0); PG8_BAR; PG8_SCHED;
            PG8_LDB(B1, 0, 1); PG8_STAGE(PG8_SB(0, 0), b2, voffB);
            PG8_BAR; PG8_WAIT_L(0); PG8_MMA(0, 1, At, B1); PG8_BAR;
            PG8_LDA(At, 0, 1); PG8_STAGE(PG8_SA(0, 0), a2, voffA);
            PG8_BAR; PG8_WAIT_L(0); PG8_MMA(1, 0, At, B0); PG8_BAR; PG8_SCHED;
            PG8_STAGE(PG8_SB(0, 1), b2 + hstep, voffB);
            PG8_WAIT_V(6); PG8_BAR; PG8_MMA(1, 1, At, B1); PG8_BAR;
            PG8_LDB(B0, 1, 0); PG8_SCHED; PG8_LDA(At, 1, 0); PG8_STAGE(PG8_SA(0, 1), a2 + hstep, voffA);
            PG8_WAIT_L(8); PG8_BAR; PG8_WAIT_L(0); PG8_MMA(0, 0, At, B0); PG8_BAR; PG8_SCHED;
            PG8_LDB(B1, 1, 1); PG8_STAGE(PG8_SB(1, 0), b3, voffB);
            PG8_BAR; PG8_WAIT_L(0); PG8_MMA(0, 1, At, B1); PG8_BAR;
            PG8_LDA(At, 1, 1); PG8_STAGE(PG8_SA(1, 0), a3, voffA);
            PG8_BAR; PG8_WAIT_L(0); PG8_MMA(1, 0, At, B0); PG8_BAR; PG8_SCHED;
            PG8_STAGE(PG8_SB(1, 1), b3 + hstep, voffB);
            PG8_WAIT_V(6); PG8_BAR; PG8_MMA(1, 1, At, B1); PG8_BAR;
        }
        PG8_STAMP();
        if constexpr (!Epi::AFTER_DRAIN) { E(acc, cur, wr, wc, fr, fq); S.done(cur); }
        PG8_STAMP();
        if (!has_next) break;
#pragma unroll
        for (int a = 0; a < 2; ++a)
#pragma unroll
            for (int b = 0; b < 2; ++b)
#pragma unroll
                for (int m = 0; m < 4; ++m)
#pragma unroll
                    for (int n = 0; n < 2; ++n) acc[a][b][m][n] = (f32x4){0.f, 0.f, 0.f, 0.f};
        cur = nxt; cA = nA; cB = nB; ++ui;
    }
    PG8_WAIT_V(0);
    if (wr == 0) PG8_BAR;
    PG8_BAR;
    if constexpr (Epi::AFTER_DRAIN) { E.fused(acc, cur, wr, wc, fr, fq, lds, wid, lane); S.done(cur); }
    PG8_STAMP();
    if (STAMP && wid == 0) { stamps[lane] = lane < nts ? (((unsigned long long)(unsigned)ts_hi << 32) | (unsigned)ts_lo) : 0ull;
        if (lane == 62) stamps[62] = rt_entry; if (lane == 63) stamps[63] = (unsigned long long)wall_clock64(); }
#undef PG8_STAMP
#undef PG8_SA
#undef PG8_SB
#undef PG8_STAGE
#undef PG8_LDA
#undef PG8_LDB
#undef PG8_MMA
#undef PG8_WAIT_V
#undef PG8_WAIT_L
#undef PG8_BAR
#undef PG8_SCHED
}
}

#define DI __device__ __forceinline__
#define LAS __attribute__((address_space(3)))
using pg8::bf16_t; using pg8::bf16x8; using pg8::f32x4; using pg8::u32x4;
typedef short s16x4 __attribute__((ext_vector_type(4)));
typedef unsigned u32x2 __attribute__((ext_vector_type(2)));
typedef float f32x2 __attribute__((ext_vector_type(2)));
typedef __bf16 bfv2 __attribute__((ext_vector_type(2)));

constexpr int D = 1024, TP = 16384, TS = 128, TR = TP + TS, MP = 16640, SEQ = 2048;
constexpr int NH = 3840, NHR = 3592, NS = 5376, NSR = 5152, FF = 4096;
constexpr int LDS_BYTES = 150 * 1024;
constexpr size_t O_YP = 0, O_YS = 16777216, O_PGDN = O_YS + 131072, O_PGC = O_PGDN + 1048576, O_PRET = O_PGC + 73728, O_PSSM = O_PRET + 524288,
                 O_PSC = O_PSSM + 4194304, O_SGDN = O_PSC + 147456, O_SGC = O_SGDN + 16777216, O_SRET = O_SGC + 1179648, O_SSSM = O_SRET + 8388608, O_SSC = O_SSSM + 67108864;
constexpr size_t WS_WINH = 0, WS_WOUTH = WS_WINH + 2ull * NH * 1024 * 2, WS_WINS = WS_WOUTH + 2ull * 1024 * 1024 * 2, WS_WOUTS = WS_WINS + 2ull * NS * 1024 * 2,
                 WS_W1 = WS_WOUTS + 2ull * 1024 * 2048 * 2, WS_W2 = WS_W1 + 4ull * 4096 * 1024 * 2, WS_X = WS_W2 + 4ull * 4096 * 1024 * 2, WS_H = WS_X + (size_t)MP * 1024 * 4,
                 WS_PROJ = WS_H + (size_t)MP * 1024 * 2, WS_YRAW = WS_PROJ + (size_t)MP * NS * 2, WS_MIX = WS_YRAW + (size_t)MP * 2048 * 2, WS_ACT = WS_MIX + (size_t)MP * 2048 * 2,
                 WS_CHK = WS_ACT + (size_t)MP * 4096 * 2;
constexpr int GB_NW = 0, GB_QG = 17408, GB_P = 34816, GB_KDT = 44032, GB_UT = 62464, GB_SC = 80896, GB_SIZE = 80960;
constexpr int RB_QG = 0, RB_P = 9216, RB_KDT = 18432, RB_VT = 27648, RB_SC = 46080, RB_SIZE = 46144;
constexpr int SG_CM = 0, SG_BT = 17408, SG_CB = 35840, SG_SIZE = 45056;
constexpr int SH_XT = 0, SH_SC = 9216, SH_SIZE = 9728;
constexpr size_t CHK_GDN = 0, CHK_RET = 1024ull * GB_SIZE, CHK_SG = 0, CHK_SH = 1024ull * SG_SIZE, CHK_END = 1024ull * GB_SIZE + 1024ull * RB_SIZE;
constexpr size_t WS_END = WS_CHK + (CHK_END > (1024ull * SG_SIZE + 8192ull * SH_SIZE) ? CHK_END : (1024ull * SG_SIZE + 8192ull * SH_SIZE));

struct Params { const float* in[27]; float* out; unsigned char* ws; int ph_lo, ph_hi; };

DI unsigned pk(float a, float b) { f32x2 v = {a, b}; bfv2 r = __builtin_convertvector(v, bfv2); return __builtin_bit_cast(unsigned, r); }
DI bf16_t f2bf(float a) { return (bf16_t)(pk(a, a) & 0xffffu); }
DI float bf2f(bf16_t b) { return __uint_as_float((unsigned)b << 16); }
DI float bflo(unsigned u) { return __uint_as_float(u << 16); }
DI float bfhi(unsigned u) { return __uint_as_float(u & 0xffff0000u); }
DI float wsum(float v) {
#pragma unroll
    for (int o = 32; o >= 1; o >>= 1) v += __shfl_xor(v, o);
    return v; }
DI float siluf(float x) { return x / (1.f + __expf(-x)); }
DI float softplusf(float x) { return fmaxf(x, 0.f) + log1pf(__expf(-fabsf(x))); }
DI bf16x8 lda_nat(const LAS unsigned char* base, int row, int strideB, int k0, int q) { return *(const LAS bf16x8*)(base + row * strideB + (k0 + 8 * q) * 2); }
DI bf16x8 lda_perm(const LAS unsigned char* base, int row, int strideB, int k0, int q) {
    const s16x4 lo = *(const LAS s16x4*)(base + row * strideB + (k0 + 4 * q) * 2);
    const s16x4 hi = *(const LAS s16x4*)(base + row * strideB + (k0 + 16 + 4 * q) * 2);
    return __builtin_shufflevector(lo, hi, 0, 1, 2, 3, 4, 5, 6, 7); }
DI bf16x8 pack2(f32x4 a, f32x4 b) { u32x4 p; p.x = pk(a[0], a[1]); p.y = pk(a[2], a[3]); p.z = pk(b[0], b[1]); p.w = pk(b[2], b[3]); return __builtin_bit_cast(bf16x8, p); }
#define MFMA16(a, b, c) __builtin_amdgcn_mfma_f32_16x16x32_bf16((a), (b), (c), 0, 0, 0)

template <int ACT> struct EpiB {
    static constexpr bool PERM = true, AFTER_DRAIN = false;
    bf16_t* O; int ldc;
    DI void operator()(const f32x4 (&acc)[2][2][4][2], const pg8::Unit& u, int wr, int wc, int fr, int fq) const {
        const int row0 = u.pm * 256 + wr * 64 + fr, col0 = u.pn * 256 + wc * 32 + 8 * fq;
#pragma unroll
        for (int ai = 0; ai < 2; ++ai)
#pragma unroll
            for (int m = 0; m < 4; ++m) { bf16_t* rowp = O + (size_t)(row0 + ai * 128 + m * 16) * ldc + col0;
#pragma unroll
                for (int bj = 0; bj < 2; ++bj) { f32x4 v0 = acc[ai][bj][m][0], v1 = acc[ai][bj][m][1];
                    if (ACT == 1) {
#pragma unroll
                        for (int j = 0; j < 4; ++j) { const float a = fmaxf(v0[j], 0.f), b = fmaxf(v1[j], 0.f); v0[j] = a * a; v1[j] = b * b; } }
                    u32x4 w; w.x = pk(v0[0], v0[1]); w.y = pk(v0[2], v0[3]); w.z = pk(v1[0], v1[1]); w.w = pk(v1[2], v1[3]);
                    *(u32x4*)(rowp + bj * 128) = w; } }
    }
};
struct EpiRes {
    static constexpr bool PERM = false, AFTER_DRAIN = false;
    float* X;
    DI void operator()(const f32x4 (&acc)[2][2][4][2], const pg8::Unit& u, int wr, int wc, int fr, int fq) const {
        const int row0 = u.pm * 256 + wr * 64 + fr, col0 = u.pn * 256 + wc * 32 + 4 * fq;
#pragma unroll
        for (int ai = 0; ai < 2; ++ai)
#pragma unroll
            for (int m = 0; m < 4; ++m) { float* rowp = X + (size_t)(row0 + ai * 128 + m * 16) * D + col0;
#pragma unroll
                for (int bj = 0; bj < 2; ++bj)
#pragma unroll
                    for (int n = 0; n < 2; ++n) { f32x4* p = (f32x4*)(rowp + bj * 128 + n * 16); *p = *p + acc[ai][bj][m][n]; } }
    }
};

DI void transpose_item(const float* W, int K, int N, bf16_t* WT, LAS float* scr, int item, int nblk, int lane) {
    const int kb = item / nblk, nb = item % nblk, k0 = 64 * kb, n0 = 32 * nb;
    const int n = n0 + (lane & 31);
#pragma unroll 8
    for (int i = 0; i < 32; ++i) { const int kk = 2 * i + (lane >> 5); scr[kk * 33 + (lane & 31)] = (n < N) ? W[(size_t)(k0 + kk) * N + n] : 0.f; }
    __builtin_amdgcn_s_waitcnt(0xc07f); asm volatile("" ::: "memory");
    const int c = lane & 7;
#pragma unroll
    for (int j = 0; j < 4; ++j) { const int nn = (lane >> 3) + 8 * j; const LAS float* s = scr + (8 * c) * 33 + nn;
        u32x4 o; o.x = pk(s[0 * 33], s[1 * 33]); o.y = pk(s[2 * 33], s[3 * 33]); o.z = pk(s[4 * 33], s[5 * 33]); o.w = pk(s[6 * 33], s[7 * 33]);
        *(u32x4*)(WT + (size_t)(n0 + nn) * K + k0 + 8 * c) = o; }
    __builtin_amdgcn_s_waitcnt(0xc07f); asm volatile("" ::: "memory");
}
DI void prologue(const Params& p, LAS unsigned char* lds, int gw, int ngw, int wv, int lane) {
    LAS float* scr = (LAS float*)(lds + wv * 8704);
    for (int mat = 0; mat < 6; ++mat) {
        const float* src; int K, N, Np, cnt; size_t dst;
        switch (mat) {
            case 0: src = p.in[10]; K = 1024; N = NHR; Np = NH; cnt = 2; dst = WS_WINH; break;
            case 1: src = p.in[16]; K = 1024; N = 1024; Np = 1024; cnt = 2; dst = WS_WOUTH; break;
            case 2: src = p.in[17]; K = 1024; N = NSR; Np = NS; cnt = 2; dst = WS_WINS; break;
            case 3: src = p.in[24]; K = 2048; N = 1024; Np = 1024; cnt = 2; dst = WS_WOUTS; break;
            case 4: src = p.in[25]; K = 1024; N = FF; Np = FF; cnt = 4; dst = WS_W1; break;
            default: src = p.in[26]; K = FF; N = 1024; Np = 1024; cnt = 4; dst = WS_W2; break;
        }
        const int nblk = Np / 32, per = (K / 64) * nblk, tot = per * cnt;
        for (int it = gw; it < tot; it += ngw) { const int l = it / per, r = it % per;
            transpose_item(src + (size_t)l * K * N, K, N, (bf16_t*)(p.ws + dst) + (size_t)l * Np * K, scr, r, nblk, lane); }
    }
    bf16_t* H = (bf16_t*)(p.ws + WS_H);
    for (int m = TR + gw; m < MP; m += ngw) { u32x4 z = {0u, 0u, 0u, 0u}; *(u32x4*)(H + (size_t)m * D + lane * 8) = z; *(u32x4*)(H + (size_t)m * D + 512 + lane * 8) = z; }
}

DI void norm_rows(const Params& p, const float* w, bool copy, int gw, int ngw, int lane) {
    float* X = (float*)(p.ws + WS_X); bf16_t* H = (bf16_t*)(p.ws + WS_H);
    for (int m = gw; m < TR; m += ngw) {
        const float* src = copy ? (m < TP ? p.in[0] + (size_t)m * D : p.in[1] + (size_t)(m - TP) * D) : X + (size_t)m * D;
        f32x4 v[4]; float ss = 0.f;
#pragma unroll
        for (int j = 0; j < 4; ++j) { v[j] = *(const f32x4*)(src + 4 * lane + 256 * j); ss += v[j][0] * v[j][0] + v[j][1] * v[j][1] + v[j][2] * v[j][2] + v[j][3] * v[j][3]; }
        ss = wsum(ss); const float r = rsqrtf(ss * (1.f / 1024.f) + 1e-6f);
#pragma unroll
        for (int j = 0; j < 4; ++j) { const f32x4 wv = *(const f32x4*)(w + 4 * lane + 256 * j);
            if (copy) *(f32x4*)(X + (size_t)m * D + 4 * lane + 256 * j) = v[j];
            u32x2 o; o.x = pk(v[j][0] * r * wv[0], v[j][1] * r * wv[1]); o.y = pk(v[j][2] * r * wv[2], v[j][3] * r * wv[3]);
            *(u32x2*)(H + (size_t)m * D + 4 * lane + 256 * j) = o; }
    }
}
DI void final_norm(const Params& p, int gw, int ngw, int lane) {
    const float* X = (const float*)(p.ws + WS_X); const float* w = p.in[9];
    for (int m = gw; m < TR; m += ngw) {
        const float* src = X + (size_t)m * D; float* dst = p.out + (m < TP ? O_YP + (size_t)m * D : O_YS + (size_t)(m - TP) * D);
        f32x4 v[4]; float ss = 0.f;
#pragma unroll
        for (int j = 0; j < 4; ++j) { v[j] = *(const f32x4*)(src + 4 * lane + 256 * j); ss += v[j][0] * v[j][0] + v[j][1] * v[j][1] + v[j][2] * v[j][2] + v[j][3] * v[j][3]; }
        ss = wsum(ss); const float r = rsqrtf(ss * (1.f / 1024.f) + 1e-6f);
#pragma unroll
        for (int j = 0; j < 4; ++j) { const f32x4 wv = *(const f32x4*)(w + 4 * lane + 256 * j); *(f32x4*)(dst + 4 * lane + 256 * j) = v[j] * r * wv; }
    }
}

constexpr int P_KN = 0, P_QN = 17408, P_KBT = 34816, P_KDT = 53248, P_VBT = 71680, P_AM = 90112, P_TM = 107520, P_SC = 116736;
DI void gdn_prep_unit(LAS unsigned char* lds, const bf16_t* PROJ, const float* convw, float a_log_h, float dtb_h, unsigned char* blk, int row0, int h, int tid) {
    asm volatile("" : "+v"(tid));
    const int lane = tid & 63, w = tid >> 6, r = lane & 15, q = lane >> 4;
    LAS float* scG = (LAS float*)(lds + P_SC); LAS float* scC = scG + 64; LAS float* scB = scG + 128;
    if (w == 0) {
        const bf16_t* pr = PROJ + (size_t)(row0 + lane) * NH;
        const float braw = bf2f(pr[2048 + h]), araw = bf2f(pr[2052 + h]);
        const float beta = 1.f / (1.f + __expf(-braw));
        const float g = -__expf(a_log_h) * softplusf(araw + dtb_h);
        float c = g;
#pragma unroll
        for (int o = 1; o < 64; o <<= 1) { const float t = __shfl_up(c, o); if (lane >= o) c += t; }
        scG[lane] = g; scC[lane] = c; scB[lane] = beta;
    }
    __syncthreads();
    const float gend = scC[63];
    float cw[3][4][2];
#pragma unroll
    for (int grp = 0; grp < 3; ++grp)
#pragma unroll
        for (int tap = 0; tap < 4; ++tap) { const f32x2 t = *(const f32x2*)(convw + tap * 1536 + grp * 512 + h * 128 + 2 * lane); cw[grp][tap][0] = t[0]; cw[grp][tap][1] = t[1]; }
    LAS bf16_t* kbt = (LAS bf16_t*)(lds + P_KBT); LAS bf16_t* kdt = (LAS bf16_t*)(lds + P_KDT); LAS bf16_t* vbt = (LAS bf16_t*)(lds + P_VBT);
    for (int tt = 0; tt < 8; ++tt) {
        const int i = w * 8 + tt, t = (row0 & (SEQ - 1)) + i;
        float a[3][2] = {{0.f, 0.f}, {0.f, 0.f}, {0.f, 0.f}};
#pragma unroll
        for (int tap = 0; tap < 4; ++tap) { if (t - 3 + tap >= 0) { const bf16_t* pr = PROJ + (size_t)(row0 + i - 3 + tap) * NH + h * 128 + 2 * lane;
#pragma unroll
            for (int grp = 0; grp < 3; ++grp) { const unsigned u = *(const unsigned*)(pr + grp * 512); a[grp][0] += cw[grp][tap][0] * bflo(u); a[grp][1] += cw[grp][tap][1] * bfhi(u); } } }
#pragma unroll
        for (int grp = 0; grp < 3; ++grp) { a[grp][0] = siluf(a[grp][0]); a[grp][1] = siluf(a[grp][1]); }
        const float sq = wsum(a[0][0] * a[0][0] + a[0][1] * a[0][1]), sk = wsum(a[1][0] * a[1][0] + a[1][1] * a[1][1]);
        const float rq = rsqrtf(sq + 1e-6f) * 0.08838834764831845f, rk = rsqrtf(sk + 1e-6f);
        const float q0 = a[0][0] * rq, q1 = a[0][1] * rq, k0 = a[1][0] * rk, k1 = a[1][1] * rk, v0 = a[2][0], v1 = a[2][1];
        const float gc = scC[i], be = scB[i], eg = __expf(gc), ed = __expf(gend - gc);
        *(LAS unsigned*)(lds + P_QN + i * 272 + lane * 4) = pk(q0, q1);
        *(LAS unsigned*)(lds + P_KN + i * 272 + lane * 4) = pk(k0, k1);
        *(unsigned*)(blk + GB_QG + i * 272 + lane * 4) = pk(q0 * eg, q1 * eg);
        kbt[(2 * lane) * 72 + i] = f2bf(k0 * be * eg); kbt[(2 * lane + 1) * 72 + i] = f2bf(k1 * be * eg);
        kdt[(2 * lane) * 72 + i] = f2bf(k0 * ed); kdt[(2 * lane + 1) * 72 + i] = f2bf(k1 * ed);
        vbt[(2 * lane) * 72 + i] = f2bf(v0 * be); vbt[(2 * lane + 1) * 72 + i] = f2bf(v1 * be);
    }
    __syncthreads();
    LAS float* AM = (LAS float*)(lds + P_AM);
    for (int tix = w; tix < 16; tix += 8) { const int mi = tix >> 2, nj = tix & 3;
        f32x4 kk = {0.f, 0.f, 0.f, 0.f}, qk = {0.f, 0.f, 0.f, 0.f};
        if (nj <= mi) {
#pragma unroll
            for (int s = 0; s < 4; ++s) { const bf16x8 bk = lda_nat(lds + P_KN, 16 * nj + r, 272, 32 * s, q), ak = lda_nat(lds + P_KN, 16 * mi + r, 272, 32 * s, q), aq = lda_nat(lds + P_QN, 16 * mi + r, 272, 32 * s, q);
                kk = MFMA16(ak, bk, kk); qk = MFMA16(aq, bk, qk); } }
#pragma unroll
        for (int reg = 0; reg < 4; ++reg) { const int i = 16 * mi + 4 * q + reg, j = 16 * nj + r;
            const float dec = (j <= i) ? __expf(scC[i] - scC[j]) : 0.f;
            AM[i * 68 + j] = (j < i) ? scB[i] * kk[reg] * dec : 0.f;
            *(bf16_t*)(blk + GB_P + (i * 72 + j) * 2) = f2bf(qk[reg] * dec); }
    }
    __syncthreads();
    if (w == 0) {
        LAS bf16_t* TM = (LAS bf16_t*)(lds + P_TM);
        float t[64];
#pragma unroll
        for (int i = 0; i < 64; ++i) { float s = (lane == i) ? 1.f : 0.f;
#pragma unroll
            for (int j = 0; j < i; ++j) s -= AM[i * 68 + j] * t[j];
            t[i] = s; TM[i * 72 + lane] = f2bf(s); }
    } else {
        for (int idx = tid - 64; idx < 1152; idx += 448) *(u32x4*)(blk + GB_KDT + idx * 16) = *(const LAS u32x4*)(lds + P_KDT + idx * 16);
    }
    __syncthreads();
    for (int tix = w; tix < 64; tix += 8) {
        f32x4 acc = {0.f, 0.f, 0.f, 0.f};
        if (tix < 32) { const int mi = tix >> 3, nv = tix & 7;
#pragma unroll
            for (int s = 0; s < 2; ++s) acc = MFMA16(lda_nat(lds + P_TM, 16 * mi + r, 144, 32 * s, q), lda_nat(lds + P_VBT, 16 * nv + r, 144, 32 * s, q), acc);
            u32x2 o; o.x = pk(acc[0], acc[1]); o.y = pk(acc[2], acc[3]);
            *(u32x2*)(blk + GB_UT + ((16 * nv + r) * 72 + 16 * mi + 4 * q) * 2) = o;
        } else { const int t2 = tix - 32, mk = t2 >> 2, ni = t2 & 3;
#pragma unroll
            for (int s = 0; s < 2; ++s) acc = MFMA16(lda_nat(lds + P_KBT, 16 * mk + r, 144, 32 * s, q), lda_nat(lds + P_TM, 16 * ni + r, 144, 32 * s, q), acc);
            u32x2 o; o.x = pk(-acc[0], -acc[1]); o.y = pk(-acc[2], -acc[3]);
            *(u32x2*)(blk + GB_NW + ((16 * ni + r) * 136 + 16 * mk + 4 * q) * 2) = o; }
    }
    if (tid == 0) *(float*)(blk + GB_SC) = __expf(gend);
    __syncthreads();
}

constexpr int R_QR = 0, R_KR = 9216, R_KDT = 18432, R_VT = 27648;
DI void rot_sincos(float pos, int f, float& sn, float& cs) {
    const float inv = exp2f(-(float)f * (13.287712379549449f / 32.f));
    const float ang = pos * inv;
    double rev = (double)ang * 0.15915494309189535; rev -= __builtin_floor(rev);
    const float fr = (float)rev;
    sn = __builtin_amdgcn_sinf(fr); cs = __builtin_amdgcn_cosf(fr);
}
DI void ret_prep_unit(LAS unsigned char* lds, const bf16_t* PROJ, unsigned char* blk, int row0, int h, int tid) {
    asm volatile("" : "+v"(tid));
    const int lane = tid & 63, w = tid >> 6, r = lane & 15, q = lane >> 4;
    const float lg = __logf(1.f - exp2f(-5.f - (float)h));
    const int f = lane & 31, which = lane >> 5;
    LAS bf16_t* qr = (LAS bf16_t*)(lds + R_QR); LAS bf16_t* kr = (LAS bf16_t*)(lds + R_KR); LAS bf16_t* kdt = (LAS bf16_t*)(lds + R_KDT); LAS bf16_t* vt = (LAS bf16_t*)(lds + R_VT);
    for (int tt = 0; tt < 8; ++tt) {
        const int i = w * 8 + tt, t = (row0 & (SEQ - 1)) + i;
        const bf16_t* pr = PROJ + (size_t)(row0 + i) * NH;
        const int base = (which ? 2312 : 2056) + h * 64;
        const float x1 = bf2f(pr[base + f]), x2 = bf2f(pr[base + 32 + f]);
        float sn, cs; rot_sincos((float)t, f, sn, cs);
        float o1 = x1 * cs - x2 * sn, o2 = x2 * cs + x1 * sn;
        if (which == 0) {
            qr[i * 72 + f] = f2bf(o1); qr[i * 72 + 32 + f] = f2bf(o2);
            const float eg = __expf((float)(i + 1) * lg);
            *(bf16_t*)(blk + RB_QG + (i * 72 + f) * 2) = f2bf(o1 * eg); *(bf16_t*)(blk + RB_QG + (i * 72 + 32 + f) * 2) = f2bf(o2 * eg);
        } else {
            o1 *= 0.125f; o2 *= 0.125f;
            kr[i * 72 + f] = f2bf(o1); kr[i * 72 + 32 + f] = f2bf(o2);
            const float ed = __expf((float)(63 - i) * lg);
            kdt[f * 72 + i] = f2bf(o1 * ed); kdt[(32 + f) * 72 + i] = f2bf(o2 * ed);
        }
        const unsigned u = *(const unsigned*)(pr + 2568 + h * 128 + 2 * lane);
        vt[(2 * lane) * 72 + i] = (bf16_t)(u & 0xffffu); vt[(2 * lane + 1) * 72 + i] = (bf16_t)(u >> 16);
    }
    __syncthreads();
    for (int tix = w; tix < 16; tix += 8) { const int mi = tix >> 2, nj = tix & 3;
        f32x4 qk = {0.f, 0.f, 0.f, 0.f};
        if (nj <= mi) {
#pragma unroll
            for (int s = 0; s < 2; ++s) qk = MFMA16(lda_nat(lds + R_QR, 16 * mi + r, 144, 32 * s, q), lda_nat(lds + R_KR, 16 * nj + r, 144, 32 * s, q), qk); }
#pragma unroll
        for (int reg = 0; reg < 4; ++reg) { const int i = 16 * mi + 4 * q + reg, j = 16 * nj + r;
            const float dec = (j <= i) ? __expf((float)(i - j) * lg) : 0.f;
            *(bf16_t*)(blk + RB_P + (i * 72 + j) * 2) = f2bf(qk[reg] * dec); }
    }
    for (int idx = tid; idx < 1728; idx += 512) *(u32x4*)(blk + RB_KDT + idx * 16) = *(const LAS u32x4*)(lds + R_KDT + idx * 16);
    if (tid == 0) *(float*)(blk + RB_SC) = __expf(64.f * lg);
    __syncthreads();
}

constexpr int Q_CM = 0, Q_BM = 17408, Q_BT = 34816, Q_XT = 53248, Q_END = 53248 + 73728;
DI void ssd_prep_unit(LAS unsigned char* lds, const bf16_t* PROJ, const float* convw  , const float* convb, const float* dtb, const float* alog,
                      unsigned char* gblk, unsigned char* hblk0  , int row0, int g, int tid) {
    asm volatile("" : "+v"(tid));
    const int lane = tid & 63, w = tid >> 6, r = lane & 15, q = lane >> 4;
    int ch[6];
#pragma unroll
    for (int j = 0; j < 4; ++j) ch[j] = g * 512 + 128 * j + 2 * lane;
    ch[4] = 2048 + g * 128 + 2 * lane; ch[5] = 2560 + g * 128 + 2 * lane;
    float cw[6][5][2];
#pragma unroll
    for (int j = 0; j < 6; ++j) {
#pragma unroll
        for (int tap = 0; tap < 4; ++tap) { const f32x2 t = *(const f32x2*)(convw + tap * 3072 + ch[j]); cw[j][tap][0] = t[0]; cw[j][tap][1] = t[1]; }
        const f32x2 t = *(const f32x2*)(convb + ch[j]); cw[j][4][0] = t[0]; cw[j][4][1] = t[1]; }
    LAS bf16_t* bt = (LAS bf16_t*)(lds + Q_BT); LAS bf16_t* xt = (LAS bf16_t*)(lds + Q_XT);
    if (w == 0) {
        const bf16_t* pr = PROJ + (size_t)(row0 + lane) * NS + 5120 + g * 8;
#pragma unroll
        for (int hh = 0; hh < 8; ++hh) { const int head = g * 8 + hh;
            const float dt = softplusf(bf2f(pr[hh]) + dtb[head]); const float gg = -__expf(alog[head]) * dt;
            float c = gg;
#pragma unroll
            for (int o = 1; o < 64; o <<= 1) { const float t = __shfl_up(c, o); if (lane >= o) c += t; }
            float* sc = (float*)(hblk0 + (size_t)(hh >> 1) * 32 * 2 * SH_SIZE + (hh & 1) * SH_SIZE + SH_SC);
            sc[lane] = dt; sc[64 + lane] = c; }
    }
    for (int tt = 0; tt < 8; ++tt) {
        const int i = w * 8 + tt, t = (row0 & (SEQ - 1)) + i;
        float a[6][2];
#pragma unroll
        for (int j = 0; j < 6; ++j) { a[j][0] = cw[j][4][0]; a[j][1] = cw[j][4][1]; }
#pragma unroll
        for (int tap = 0; tap < 4; ++tap) { if (t - 3 + tap >= 0) { const bf16_t* pr = PROJ + (size_t)(row0 + i - 3 + tap) * NS + 2048;
#pragma unroll
            for (int j = 0; j < 6; ++j) { const unsigned u = *(const unsigned*)(pr + ch[j]); a[j][0] += cw[j][tap][0] * bflo(u); a[j][1] += cw[j][tap][1] * bfhi(u); } } }
#pragma unroll
        for (int j = 0; j < 6; ++j) { a[j][0] = siluf(a[j][0]); a[j][1] = siluf(a[j][1]); }
#pragma unroll
        for (int j = 0; j < 4; ++j) { xt[(128 * j + 2 * lane) * 72 + i] = f2bf(a[j][0]); xt[(128 * j + 2 * lane + 1) * 72 + i] = f2bf(a[j][1]); }
        *(LAS unsigned*)(lds + Q_BM + i * 272 + lane * 4) = pk(a[4][0], a[4][1]);
        bt[(2 * lane) * 72 + i] = f2bf(a[4][0]); bt[(2 * lane + 1) * 72 + i] = f2bf(a[4][1]);
        const unsigned cu = pk(a[5][0], a[5][1]);
        *(LAS unsigned*)(lds + Q_CM + i * 272 + lane * 4) = cu;
        *(unsigned*)(gblk + SG_CM + i * 272 + lane * 4) = cu;
    }
    __syncthreads();
    for (int tix = w; tix < 16; tix += 8) { const int mi = tix >> 2, nj = tix & 3;
        f32x4 cb = {0.f, 0.f, 0.f, 0.f};
        if (nj <= mi) {
#pragma unroll
            for (int s = 0; s < 4; ++s) cb = MFMA16(lda_nat(lds + Q_CM, 16 * mi + r, 272, 32 * s, q), lda_nat(lds + Q_BM, 16 * nj + r, 272, 32 * s, q), cb); }
#pragma unroll
        for (int reg = 0; reg < 4; ++reg) { const int i = 16 * mi + 4 * q + reg, j = 16 * nj + r; *(bf16_t*)(gblk + SG_CB + (i * 72 + j) * 2) = f2bf(cb[reg]); }
    }
    for (int idx = tid; idx < 1152; idx += 512) *(u32x4*)(gblk + SG_BT + idx * 16) = *(const LAS u32x4*)(lds + Q_BT + idx * 16);
    for (int idx = tid; idx < 4608; idx += 512) { const int hh = idx / 576, o = idx % 576;
        *(u32x4*)(hblk0 + (size_t)(hh >> 1) * 32 * 2 * SH_SIZE + (hh & 1) * SH_SIZE + SH_XT + o * 16) = *(const LAS u32x4*)(lds + Q_XT + idx * 16); }
    __syncthreads();
}

#define PF_LOAD(pf, n, src, nvec) do { _Pragma("unroll") for (int _k = 0; _k < (n); ++_k) { const int _i = tid + _k * 512; if (_i < (nvec)) pf[_k] = ((const u32x4*)(src))[_i]; } } while (0)
#define PF_STORE(pf, n, nvec) do { _Pragma("unroll") for (int _k = 0; _k < (n); ++_k) { const int _i = tid + _k * 512; if (_i < (nvec)) ((LAS u32x4*)lds)[_i] = pf[_k]; } } while (0)

DI void gdn_scan(LAS unsigned char* lds, const unsigned char* blk0, bf16_t* YRAW, int row0, int h, float* sout, int tid) {
    asm volatile("" : "+v"(tid));
    const int lane = tid & 63, w = tid >> 6, r = lane & 15, q = lane >> 4, v0 = 16 * w;
    f32x4 S[8];
#pragma unroll
    for (int k = 0; k < 8; ++k) S[k] = (f32x4){0.f, 0.f, 0.f, 0.f};
    u32x4 pf[10];
    PF_LOAD(pf, 10, blk0, GB_SIZE / 16);
    for (int c = 0; c < 32; ++c) {
        __syncthreads();
        PF_STORE(pf, 10, GB_SIZE / 16);
        __syncthreads();
        if (c + 1 < 32) PF_LOAD(pf, 10, blk0 + (size_t)(c + 1) * GB_SIZE, GB_SIZE / 16);
        const float e = *(const LAS float*)(lds + GB_SC);
        f32x4 Dl[4], Y[4];
#pragma unroll
        for (int m = 0; m < 4; ++m) { const u32x2 u = *(const LAS u32x2*)(lds + GB_UT + ((v0 + r) * 72 + 16 * m + 4 * q) * 2);
            Dl[m] = (f32x4){bflo(u.x), bfhi(u.x), bflo(u.y), bfhi(u.y)}; Y[m] = (f32x4){0.f, 0.f, 0.f, 0.f}; }
#pragma unroll
        for (int s = 0; s < 4; ++s) { const bf16x8 bs = pack2(S[2 * s], S[2 * s + 1]);
#pragma unroll
            for (int m = 0; m < 4; ++m) { Dl[m] = MFMA16(lda_perm(lds + GB_NW, 16 * m + r, 272, 32 * s, q), bs, Dl[m]); Y[m] = MFMA16(lda_perm(lds + GB_QG, 16 * m + r, 272, 32 * s, q), bs, Y[m]); } }
#pragma unroll
        for (int k = 0; k < 8; ++k) S[k] = S[k] * e;
#pragma unroll
        for (int s2 = 0; s2 < 2; ++s2) { const bf16x8 bd = pack2(Dl[2 * s2], Dl[2 * s2 + 1]);
#pragma unroll
            for (int m = 0; m < 4; ++m) Y[m] = MFMA16(lda_perm(lds + GB_P, 16 * m + r, 144, 32 * s2, q), bd, Y[m]);
#pragma unroll
            for (int k = 0; k < 8; ++k) S[k] = MFMA16(lda_perm(lds + GB_KDT, 16 * k + r, 144, 32 * s2, q), bd, S[k]); }
#pragma unroll
        for (int m = 0; m < 4; ++m)
#pragma unroll
            for (int reg = 0; reg < 4; ++reg) YRAW[(size_t)(row0 + c * 64 + 16 * m + 4 * q + reg) * 2048 + h * 128 + v0 + r] = f2bf(Y[m][reg]);
    }
#pragma unroll
    for (int k = 0; k < 8; ++k)
#pragma unroll
        for (int reg = 0; reg < 4; ++reg) sout[(16 * k + 4 * q + reg) * 128 + v0 + r] = S[k][reg];
}

DI void ret_scan(LAS unsigned char* lds, const unsigned char* blk0, bf16_t* YRAW, int row0, int h, float* sout, int tid) {
    asm volatile("" : "+v"(tid));
    const int lane = tid & 63, w = tid >> 6, r = lane & 15, q = lane >> 4, v0 = 16 * w;
    f32x4 S[4];
#pragma unroll
    for (int k = 0; k < 4; ++k) S[k] = (f32x4){0.f, 0.f, 0.f, 0.f};
    u32x4 pf[6];
    PF_LOAD(pf, 6, blk0, RB_SIZE / 16);
    for (int c = 0; c < 32; ++c) {
        __syncthreads();
        PF_STORE(pf, 6, RB_SIZE / 16);
        __syncthreads();
        if (c + 1 < 32) PF_LOAD(pf, 6, blk0 + (size_t)(c + 1) * RB_SIZE, RB_SIZE / 16);
        const float e = *(const LAS float*)(lds + RB_SC);
        f32x4 Y[4];
#pragma unroll
        for (int m = 0; m < 4; ++m) Y[m] = (f32x4){0.f, 0.f, 0.f, 0.f};
#pragma unroll
        for (int s = 0; s < 2; ++s) { const bf16x8 bs = pack2(S[2 * s], S[2 * s + 1]);
#pragma unroll
            for (int m = 0; m < 4; ++m) Y[m] = MFMA16(lda_perm(lds + RB_QG, 16 * m + r, 144, 32 * s, q), bs, Y[m]); }
#pragma unroll
        for (int k = 0; k < 4; ++k) S[k] = S[k] * e;
#pragma unroll
        for (int s2 = 0; s2 < 2; ++s2) { const bf16x8 bv = lda_nat(lds + RB_VT, v0 + r, 144, 32 * s2, q);
#pragma unroll
            for (int m = 0; m < 4; ++m) Y[m] = MFMA16(lda_nat(lds + RB_P, 16 * m + r, 144, 32 * s2, q), bv, Y[m]);
#pragma unroll
            for (int k = 0; k < 4; ++k) S[k] = MFMA16(lda_nat(lds + RB_KDT, 16 * k + r, 144, 32 * s2, q), bv, S[k]); }
#pragma unroll
        for (int m = 0; m < 4; ++m)
#pragma unroll
            for (int reg = 0; reg < 4; ++reg) YRAW[(size_t)(row0 + c * 64 + 16 * m + 4 * q + reg) * 2048 + 512 + h * 128 + v0 + r] = f2bf(Y[m][reg]);
    }
#pragma unroll
    for (int k = 0; k < 4; ++k)
#pragma unroll
        for (int reg = 0; reg < 4; ++reg) sout[(16 * k + 4 * q + reg) * 128 + v0 + r] = S[k][reg];
}

constexpr int SS_HD = SG_SIZE, SS_PP = SG_SIZE + 2 * SH_SIZE, SS_SX = SS_PP + 2 * 9216;
DI void ssd_scan(LAS unsigned char* lds, const unsigned char* gblk0, const unsigned char* hblk0, bf16_t* YRAW, int row0, int u, const float* dsk, float* sout0, int tid) {
    asm volatile("" : "+v"(tid));
    const int lane = tid & 63, w = tid >> 6, r = lane & 15, q = lane >> 4, hs = w >> 2, p0 = 16 * (w & 3), head = 2 * u + hs;
    const float dskip = dsk[head];
    f32x4 S[8];
#pragma unroll
    for (int k = 0; k < 8; ++k) S[k] = (f32x4){0.f, 0.f, 0.f, 0.f};
    u32x4 pf[8];
    constexpr int NG = SG_SIZE / 16, NV = NG + 2 * SH_SIZE / 16;
#define SSD_LOAD(cc) do { _Pragma("unroll") for (int _k = 0; _k < 8; ++_k) { const int _i = tid + _k * 512; if (_i < NG) pf[_k] = ((const u32x4*)(gblk0 + (size_t)(cc) * SG_SIZE))[_i]; \
        else if (_i < NV) pf[_k] = ((const u32x4*)(hblk0 + (size_t)(cc) * 2 * SH_SIZE))[_i - NG]; } } while (0)
    SSD_LOAD(0);
    const LAS unsigned char* hd = lds + SS_HD + hs * SH_SIZE;
    LAS unsigned char* pp = lds + SS_PP + hs * 9216;
    LAS float* sx = (LAS float*)(lds + SS_SX + hs * 512);
    const int tt = tid & 255;
    for (int c = 0; c < 32; ++c) {
        __syncthreads();
        PF_STORE(pf, 8, NV);
        __syncthreads();
        if (c + 1 < 32) SSD_LOAD(c + 1);
        const LAS float* dtv = (const LAS float*)(hd + SH_SC); const LAS float* gcv = dtv + 64;
        const float gend = gcv[63];
#pragma unroll
        for (int e16 = 0; e16 < 16; ++e16) { const int idx = tt + 256 * e16, i = idx >> 6, j = idx & 63;
            float v = 0.f;
            if (j <= i) v = bf2f(*(const LAS bf16_t*)(lds + SG_CB + (i * 72 + j) * 2)) * __expf(gcv[i] - gcv[j]) * dtv[j];
            if (i == j) v += dskip;
            *(LAS bf16_t*)(pp + (i * 72 + j) * 2) = f2bf(v); }
        if (tt < 64) { sx[tt] = dtv[tt] * __expf(gend - gcv[tt]); sx[64 + tt] = __expf(gcv[tt]); }
        __syncthreads();
        const float e = __expf(gend);
        f32x4 Y[4];
#pragma unroll
        for (int m = 0; m < 4; ++m) Y[m] = (f32x4){0.f, 0.f, 0.f, 0.f};
#pragma unroll
        for (int s = 0; s < 4; ++s) { const bf16x8 bs = pack2(S[2 * s], S[2 * s + 1]);
#pragma unroll
            for (int m = 0; m < 4; ++m) Y[m] = MFMA16(lda_perm(lds + SG_CM, 16 * m + r, 272, 32 * s, q), bs, Y[m]); }
#pragma unroll
        for (int m = 0; m < 4; ++m)
#pragma unroll
            for (int reg = 0; reg < 4; ++reg) Y[m][reg] *= sx[64 + 16 * m + 4 * q + reg];
#pragma unroll
        for (int k = 0; k < 8; ++k) S[k] = S[k] * e;
#pragma unroll
        for (int s2 = 0; s2 < 2; ++s2) { const bf16x8 bx = lda_nat(hd + SH_XT, p0 + r, 144, 32 * s2, q);
#pragma unroll
            for (int m = 0; m < 4; ++m) Y[m] = MFMA16(lda_nat(pp, 16 * m + r, 144, 32 * s2, q), bx, Y[m]);
            const u32x4 xu = __builtin_bit_cast(u32x4, bx); u32x4 xs;
            const LAS float* wj = sx + 32 * s2 + 8 * q;
            xs.x = pk(bflo(xu.x) * wj[0], bfhi(xu.x) * wj[1]); xs.y = pk(bflo(xu.y) * wj[2], bfhi(xu.y) * wj[3]);
            xs.z = pk(bflo(xu.z) * wj[4], bfhi(xu.z) * wj[5]); xs.w = pk(bflo(xu.w) * wj[6], bfhi(xu.w) * wj[7]);
            const bf16x8 bx2 = __builtin_bit_cast(bf16x8, xs);
#pragma unroll
            for (int k = 0; k < 8; ++k) S[k] = MFMA16(lda_nat(lds + SG_BT, 16 * k + r, 144, 32 * s2, q), bx2, S[k]); }
#pragma unroll
        for (int m = 0; m < 4; ++m)
#pragma unroll
            for (int reg = 0; reg < 4; ++reg) YRAW[(size_t)(row0 + c * 64 + 16 * m + 4 * q + reg) * 2048 + head * 64 + p0 + r] = f2bf(Y[m][reg]);
    }
    float* so = sout0 + (size_t)hs * 128 * 64;
#pragma unroll
    for (int k = 0; k < 8; ++k)
#pragma unroll
        for (int reg = 0; reg < 4; ++reg) so[(16 * k + 4 * q + reg) * 64 + p0 + r] = S[k][reg];
#undef SSD_LOAD
}

DI void gdn_sample_unit(LAS unsigned char* lds, const Params& p, int li, int s, int h, int tid) {
    asm volatile("" : "+v"(tid));
    const int lane = tid & 63, w = tid >> 6, row = TP + s;
    const bf16_t* pr = (const bf16_t*)(p.ws + WS_PROJ) + (size_t)row * NH;
    LAS float* qkv = (LAS float*)lds; LAS float* red = qkv + 384;
    const float* cbuf = p.in[3] + (size_t)(li * 128 + s) * 3 * 1536; float* cout = p.out + O_SGC + (size_t)(li * 128 + s) * 3 * 1536;
    const float* cwp = p.in[11] + (size_t)li * 4 * 1536;
    if (tid < 384) { const int grp = tid >> 7, cl = tid & 127, ch = grp * 512 + h * 128 + cl;
        const float x = bf2f(pr[ch]), b0 = cbuf[ch], b1 = cbuf[1536 + ch], b2 = cbuf[3072 + ch];
        const float o = b0 * cwp[ch] + b1 * cwp[1536 + ch] + b2 * cwp[3072 + ch] + x * cwp[4608 + ch];
        qkv[tid] = siluf(o); cout[ch] = b1; cout[1536 + ch] = b2; cout[3072 + ch] = x; }
    __syncthreads();
    const float qa = qkv[2 * lane], qb = qkv[2 * lane + 1], ka = qkv[128 + 2 * lane], kb = qkv[128 + 2 * lane + 1];
    const float rq = rsqrtf(wsum(qa * qa + qb * qb) + 1e-6f) * 0.08838834764831845f, rk = rsqrtf(wsum(ka * ka + kb * kb) + 1e-6f);
    const float beta = 1.f / (1.f + __expf(-bf2f(pr[2048 + h])));
    const float g = -__expf(p.in[12][li * 4 + h]) * softplusf(bf2f(pr[2052 + h]) + p.in[13][li * 4 + h]);
    const float e = __expf(g);
    const size_t sidx = ((size_t)(li * 128 + s) * 4 + h) * 128 * 128;
    const float* Sin = p.in[2] + sidx; float* Sout = p.out + O_SGDN + sidx;
    f32x2 Sr[16]; float a0 = 0.f, a1 = 0.f;
#pragma unroll
    for (int rr = 0; rr < 16; ++rr) { Sr[rr] = *(const f32x2*)(Sin + (16 * w + rr) * 128 + 2 * lane) * e; const float kn = qkv[128 + 16 * w + rr] * rk; a0 += kn * Sr[rr][0]; a1 += kn * Sr[rr][1]; }
    red[w * 128 + 2 * lane] = a0; red[w * 128 + 2 * lane + 1] = a1;
    __syncthreads();
    a0 = 0.f; a1 = 0.f;
#pragma unroll
    for (int ww = 0; ww < 8; ++ww) { a0 += red[ww * 128 + 2 * lane]; a1 += red[ww * 128 + 2 * lane + 1]; }
    const float d0 = beta * (qkv[256 + 2 * lane] - a0), d1 = beta * (qkv[256 + 2 * lane + 1] - a1);
    __syncthreads();
    float y0 = 0.f, y1 = 0.f;
#pragma unroll
    for (int rr = 0; rr < 16; ++rr) { const float kn = qkv[128 + 16 * w + rr] * rk, qn = qkv[16 * w + rr] * rq;
        Sr[rr][0] += kn * d0; Sr[rr][1] += kn * d1; y0 += qn * Sr[rr][0]; y1 += qn * Sr[rr][1];
        *(f32x2*)(Sout + (16 * w + rr) * 128 + 2 * lane) = Sr[rr]; }
    red[w * 128 + 2 * lane] = y0; red[w * 128 + 2 * lane + 1] = y1;
    __syncthreads();
    if (w == 0) { y0 = 0.f; y1 = 0.f;
#pragma unroll
        for (int ww = 0; ww < 8; ++ww) { y0 += red[ww * 128 + 2 * lane]; y1 += red[ww * 128 + 2 * lane + 1]; }
        *(unsigned*)((bf16_t*)(p.ws + WS_YRAW) + (size_t)row * 2048 + h * 128 + 2 * lane) = pk(y0, y1); }
    __syncthreads();
}
DI void ret_sample_unit(LAS unsigned char* lds, const Params& p, int li, int s, int h, int tid) {
    asm volatile("" : "+v"(tid));
    const int lane = tid & 63, w = tid >> 6, row = TP + s;
    const bf16_t* pr = (const bf16_t*)(p.ws + WS_PROJ) + (size_t)row * NH;
    LAS float* qk = (LAS float*)lds; LAS float* red = qk + 128;
    if (tid < 64) { const int f = tid & 31, which = tid >> 5, base = (which ? 2312 : 2056) + h * 64;
        const float x1 = bf2f(pr[base + f]), x2 = bf2f(pr[base + 32 + f]);
        float sn, cs; rot_sincos(16384.f, f, sn, cs);
        float o1 = x1 * cs - x2 * sn, o2 = x2 * cs + x1 * sn;
        if (which) { o1 *= 0.125f; o2 *= 0.125f; }
        qk[which * 64 + f] = o1; qk[which * 64 + 32 + f] = o2; }
    __syncthreads();
    const float gam = 1.f - exp2f(-5.f - (float)h);
    const unsigned vu = *(const unsigned*)(pr + 2568 + h * 128 + 2 * lane);
    const float va = bflo(vu), vb = bfhi(vu);
    const size_t sidx = ((size_t)(li * 128 + s) * 4 + h) * 64 * 128;
    const float* Sin = p.in[4] + sidx; float* Sout = p.out + O_SRET + sidx;
    float y0 = 0.f, y1 = 0.f;
#pragma unroll
    for (int rr = 0; rr < 8; ++rr) { const int k = 8 * w + rr; f32x2 sv = *(const f32x2*)(Sin + k * 128 + 2 * lane) * gam; const float kk = qk[64 + k], qq = qk[k];
        sv[0] += kk * va; sv[1] += kk * vb; y0 += qq * sv[0]; y1 += qq * sv[1]; *(f32x2*)(Sout + k * 128 + 2 * lane) = sv; }
    red[w * 128 + 2 * lane] = y0; red[w * 128 + 2 * lane + 1] = y1;
    __syncthreads();
    if (w == 0) { y0 = 0.f; y1 = 0.f;
#pragma unroll
        for (int ww = 0; ww < 8; ++ww) { y0 += red[ww * 128 + 2 * lane]; y1 += red[ww * 128 + 2 * lane + 1]; }
        *(unsigned*)((bf16_t*)(p.ws + WS_YRAW) + (size_t)row * 2048 + 512 + h * 128 + 2 * lane) = pk(y0, y1); }
    __syncthreads();
}
DI void ssd_sample_unit(LAS unsigned char* lds, const Params& p, int li, int s, int g, int tid) {
    asm volatile("" : "+v"(tid));
    const int lane = tid & 63, w = tid >> 6, row = TP + s;
    const bf16_t* pr = (const bf16_t*)(p.ws + WS_PROJ) + (size_t)row * NS;
    LAS float* xs = (LAS float*)lds; LAS float* Bv = xs + 512; LAS float* Cv = xs + 640;
    const float* cbuf = p.in[6] + (size_t)(li * 128 + s) * 3 * 3072; float* cout = p.out + O_SSC + (size_t)(li * 128 + s) * 3 * 3072;
    const float* cwp = p.in[18] + (size_t)li * 4 * 3072; const float* cbp = p.in[19] + (size_t)li * 3072;
    for (int t = tid; t < 768; t += 512) { const int ch = t < 512 ? g * 512 + t : (t < 640 ? 2048 + g * 128 + (t - 512) : 2560 + g * 128 + (t - 640));
        const float x = bf2f(pr[2048 + ch]), b0 = cbuf[ch], b1 = cbuf[3072 + ch], b2 = cbuf[6144 + ch];
        const float o = cbp[ch] + b0 * cwp[ch] + b1 * cwp[3072 + ch] + b2 * cwp[6144 + ch] + x * cwp[9216 + ch];
        xs[t] = siluf(o); cout[ch] = b1; cout[3072 + ch] = b2; cout[6144 + ch] = x; }
    __syncthreads();
    const int head = g * 8 + w;
    const float dt = softplusf(bf2f(pr[5120 + head]) + p.in[20][li * 32 + head]);
    const float e = __expf(-__expf(p.in[21][li * 32 + head]) * dt);
    const float xv = xs[w * 64 + lane], xd = xv * dt;
    const size_t sidx = ((size_t)(li * 128 + s) * 32 + head) * 128 * 64;
    const float* Sin = p.in[5] + sidx; float* Sout = p.out + O_SSSM + sidx;
    float y = p.in[22][li * 32 + head] * xv;
    for (int n0 = 0; n0 < 128; n0 += 16) { float sv[16];
#pragma unroll
        for (int j = 0; j < 16; ++j) sv[j] = Sin[(n0 + j) * 64 + lane];
#pragma unroll
        for (int j = 0; j < 16; ++j) { const float v = sv[j] * e + Bv[n0 + j] * xd; y += Cv[n0 + j] * v; Sout[(n0 + j) * 64 + lane] = v; } }
    ((bf16_t*)(p.ws + WS_YRAW))[(size_t)row * 2048 + head * 64 + lane] = f2bf(y);
    __syncthreads();
}

DI void gate_hyb(const Params& p, int li, int gw, int ngw, int lane) {
    const bf16_t* YR = (const bf16_t*)(p.ws + WS_YRAW); const bf16_t* PROJ = (const bf16_t*)(p.ws + WS_PROJ); bf16_t* MIX = (bf16_t*)(p.ws + WS_MIX);
    const float* gw_ = p.in[14] + li * 128; const float* rw = p.in[15] + li * 512;
    const float gn0 = gw_[2 * lane], gn1 = gw_[2 * lane + 1];
    for (int m = gw; m < TR; m += ngw) {
        const bf16_t* yr = YR + (size_t)m * 2048; const bf16_t* pr = PROJ + (size_t)m * NH; bf16_t* mx = MIX + (size_t)m * 1024;
#pragma unroll
        for (int h = 0; h < 4; ++h) {
            { const unsigned u = *(const unsigned*)(yr + h * 128 + 2 * lane), z = *(const unsigned*)(pr + 1536 + h * 128 + 2 * lane);
              const float a = bflo(u), b = bfhi(u); const float rs = rsqrtf(wsum(a * a + b * b) * (1.f / 128.f) + 1e-6f);
              *(unsigned*)(mx + h * 128 + 2 * lane) = pk(a * rs * gn0 * siluf(bflo(z)), b * rs * gn1 * siluf(bfhi(z))); }
            { const unsigned u = *(const unsigned*)(yr + 512 + h * 128 + 2 * lane), z = *(const unsigned*)(pr + 3080 + h * 128 + 2 * lane);
              float a = bflo(u), b = bfhi(u); const float mean = wsum(a + b) * (1.f / 128.f); a -= mean; b -= mean;
              const float rs = rsqrtf(wsum(a * a + b * b) * (1.f / 128.f) + 1e-6f);
              *(unsigned*)(mx + 512 + h * 128 + 2 * lane) = pk(a * rs * rw[h * 128 + 2 * lane] * siluf(bflo(z)), b * rs * rw[h * 128 + 2 * lane + 1] * siluf(bfhi(z))); }
        }
    }
    for (int idx = gw * 64 + lane; idx < 8 * 3 * 1536; idx += ngw * 64) { const int ch = idx % 1536, rr = (idx / 1536) % 3, b = idx / (3 * 1536);
        p.out[O_PGC + (size_t)(li * 8 + b) * 3 * 1536 + rr * 1536 + ch] = bf2f(PROJ[(size_t)(b * SEQ + SEQ - 3 + rr) * NH + ch]); }
}
DI void gate_ssm(const Params& p, int li, int gw, int ngw, int lane) {
    const bf16_t* YR = (const bf16_t*)(p.ws + WS_YRAW); const bf16_t* PROJ = (const bf16_t*)(p.ws + WS_PROJ); bf16_t* MIX = (bf16_t*)(p.ws + WS_MIX);
    const float* nw = p.in[23] + li * 2048;
    for (int m = gw; m < TR; m += ngw) {
        const bf16_t* yr = YR + (size_t)m * 2048; const bf16_t* pr = PROJ + (size_t)m * NS; bf16_t* mx = MIX + (size_t)m * 2048;
#pragma unroll
        for (int g = 0; g < 4; ++g) {
            const u32x4 u = *(const u32x4*)(yr + g * 512 + 8 * lane), z = *(const u32x4*)(pr + g * 512 + 8 * lane);
            float v[8]; const unsigned uu[4] = {u.x, u.y, u.z, u.w}, zz[4] = {z.x, z.y, z.z, z.w}; float ss = 0.f;
#pragma unroll
            for (int j = 0; j < 4; ++j) { v[2 * j] = bflo(uu[j]) * siluf(bflo(zz[j])); v[2 * j + 1] = bfhi(uu[j]) * siluf(bfhi(zz[j])); ss += v[2 * j] * v[2 * j] + v[2 * j + 1] * v[2 * j + 1]; }
            const float rs = rsqrtf(wsum(ss) * (1.f / 512.f) + 1e-6f);
            const f32x4 w0 = *(const f32x4*)(nw + g * 512 + 8 * lane), w1 = *(const f32x4*)(nw + g * 512 + 8 * lane + 4);
            u32x4 o; o.x = pk(v[0] * rs * w0[0], v[1] * rs * w0[1]); o.y = pk(v[2] * rs * w0[2], v[3] * rs * w0[3]); o.z = pk(v[4] * rs * w1[0], v[5] * rs * w1[1]); o.w = pk(v[6] * rs * w1[2], v[7] * rs * w1[3]);
            *(u32x4*)(mx + g * 512 + 8 * lane) = o;
        }
    }
    for (int idx = gw * 64 + lane; idx < 8 * 3 * 3072; idx += ngw * 64) { const int ch = idx % 3072, rr = (idx / 3072) % 3, b = idx / (3 * 3072);
        p.out[O_PSC + (size_t)(li * 8 + b) * 3 * 3072 + rr * 3072 + ch] = bf2f(PROJ[(size_t)(b * SEQ + SEQ - 3 + rr) * NS + 2048 + ch]); }
}

struct EpiBR {
    static constexpr bool PERM = true, AFTER_DRAIN = false;
    bf16_t* O; int ldc; int act;
    DI void operator()(const f32x4 (&acc)[2][2][4][2], const pg8::Unit& u, int wr, int wc, int fr, int fq) const {
        const int row0 = u.pm * 256 + wr * 64 + fr, col0 = u.pn * 256 + wc * 32 + 8 * fq;
#pragma unroll
        for (int ai = 0; ai < 2; ++ai)
#pragma unroll
            for (int m = 0; m < 4; ++m) { bf16_t* rowp = O + (size_t)(row0 + ai * 128 + m * 16) * ldc + col0;
#pragma unroll
                for (int bj = 0; bj < 2; ++bj) { f32x4 v0 = acc[ai][bj][m][0], v1 = acc[ai][bj][m][1];
                    if (act) {
#pragma unroll
                        for (int j = 0; j < 4; ++j) { const float a = fmaxf(v0[j], 0.f), b = fmaxf(v1[j], 0.f); v0[j] = a * a; v1[j] = b * b; } }
                    u32x4 w; w.x = pk(v0[0], v0[1]); w.y = pk(v0[2], v0[3]); w.z = pk(v1[0], v1[1]); w.w = pk(v1[2], v1[3]);
                    *(u32x4*)(rowp + bj * 128) = w; } }
    }
};
template <int KIND, bool hyb> DI void run_phase(const Params& P, LAS unsigned char* lds, const int L, const int tid, const int bid, const int G) {
    const int lane = tid & 63, wv = tid >> 6, gw = bid * 8 + wv, ngw = G * 8, li = L >> 1;
    unsigned char* ws = P.ws;
    bf16_t* H = (bf16_t*)(ws + WS_H); bf16_t* PROJ = (bf16_t*)(ws + WS_PROJ); bf16_t* YRAW = (bf16_t*)(ws + WS_YRAW); bf16_t* MIX = (bf16_t*)(ws + WS_MIX); bf16_t* ACT = (bf16_t*)(ws + WS_ACT);
    float* X = (float*)(ws + WS_X);
    if constexpr (KIND == 0) prologue(P, lds, gw, ngw, wv, lane);
    if constexpr (KIND == 1) norm_rows(P, P.in[7] + L * D, L == 0, gw, ngw, lane);
    if constexpr (KIND == 7) norm_rows(P, P.in[8] + L * D, false, gw, ngw, lane);
    if constexpr (KIND == 2 || KIND == 8) {
        constexpr bool up = KIND == 8;
        const bf16_t* Bt = up ? (const bf16_t*)(ws + WS_W1) + (size_t)L * FF * 1024 : (hyb ? (const bf16_t*)(ws + WS_WINH) + (size_t)li * NH * 1024 : (const bf16_t*)(ws + WS_WINS) + (size_t)li * NS * 1024);
        const int N = up ? FF : (hyb ? NH : NS);
        pg8::Gemm g{H, Bt, MP, N, 1024}; pg8::StaticOrder S; S.init(MP, N, G, bid); EpiBR E{up ? ACT : PROJ, N, up ? 1 : 0};
        pg8::gemm_phase<EpiBR, pg8::StaticOrder>((PG8_LAS unsigned char*)lds, g, S, E, nullptr, tid);
    }
    if constexpr (KIND == 6 || KIND == 9) {
        constexpr bool dn = KIND == 9;
        const bf16_t* Bt = dn ? (const bf16_t*)(ws + WS_W2) + (size_t)L * 1024 * FF : (hyb ? (const bf16_t*)(ws + WS_WOUTH) + (size_t)li * 1024 * 1024 : (const bf16_t*)(ws + WS_WOUTS) + (size_t)li * 1024 * 2048);
        const int K = dn ? FF : (hyb ? 1024 : 2048);
        pg8::Gemm g{dn ? ACT : MIX, Bt, MP, 1024, K}; pg8::StaticOrder S; S.init(MP, 1024, G, bid); EpiRes E{X};
        pg8::gemm_phase<EpiRes, pg8::StaticOrder>((PG8_LAS unsigned char*)lds, g, S, E, nullptr, tid);
    }
    if constexpr (KIND == 3) {
        if constexpr (hyb) {
#pragma nounroll
            for (int u = bid; u < 1024; u += G) { const int b = u >> 7, c = (u >> 2) & 31, h = u & 3;
                gdn_prep_unit(lds, PROJ, P.in[11] + (size_t)li * 4 * 1536, P.in[12][li * 4 + h], P.in[13][li * 4 + h], ws + WS_CHK + CHK_GDN + (size_t)((b * 4 + h) * 32 + c) * GB_SIZE, b * SEQ + c * 64, h, tid); }
#pragma nounroll
            for (int u2 = bid; u2 < 1024; u2 += G) { const int b = u2 >> 7, c = (u2 >> 2) & 31, h = u2 & 3;
                ret_prep_unit(lds, PROJ, ws + WS_CHK + CHK_RET + (size_t)((b * 4 + h) * 32 + c) * RB_SIZE, b * SEQ + c * 64, h, tid); }
        } else {
            for (int u = bid; u < 1024; u += G) { const int b = u >> 7, c = (u >> 2) & 31, g = u & 3;
                ssd_prep_unit(lds, PROJ, P.in[18] + (size_t)li * 4 * 3072, P.in[19] + (size_t)li * 3072, P.in[20] + li * 32, P.in[21] + li * 32,
                              ws + WS_CHK + CHK_SG + (size_t)((b * 4 + g) * 32 + c) * SG_SIZE, ws + WS_CHK + CHK_SH + (size_t)(((b * 16 + 4 * g) * 32 + c) * 2) * SH_SIZE, b * SEQ + c * 64, g, tid); }
        }
    }
    if constexpr (KIND == 4) {
        if constexpr (hyb) {
            if (bid < 32) { const int b = bid >> 2, h = bid & 3;
                gdn_scan(lds, ws + WS_CHK + CHK_GDN + (size_t)((b * 4 + h) * 32) * GB_SIZE, YRAW, b * SEQ, h, P.out + O_PGDN + (size_t)((li * 8 + b) * 4 + h) * 128 * 128, tid); }
            else if (bid < 64) { const int b = (bid - 32) >> 2, h = bid & 3;
                ret_scan(lds, ws + WS_CHK + CHK_RET + (size_t)((b * 4 + h) * 32) * RB_SIZE, YRAW, b * SEQ, h, P.out + O_PRET + (size_t)((li * 8 + b) * 4 + h) * 64 * 128, tid); }
            else { for (int u = bid - 64; u < 1024; u += G - 64) { if (u < 512) gdn_sample_unit(lds, P, li, u >> 2, u & 3, tid); else ret_sample_unit(lds, P, li, (u - 512) >> 2, u & 3, tid); } }
        } else {
            if (bid < 128) { const int b = bid >> 4, u = bid & 15, g = u >> 2;
                ssd_scan(lds, ws + WS_CHK + CHK_SG + (size_t)((b * 4 + g) * 32) * SG_SIZE, ws + WS_CHK + CHK_SH + (size_t)(((b * 16 + u) * 32) * 2) * SH_SIZE, YRAW, b * SEQ, u, P.in[22] + li * 32,
                         P.out + O_PSSM + (size_t)((li * 8 + b) * 32 + 2 * u) * 128 * 64, tid); }
            else { for (int u = bid - 128; u < 512; u += G - 128) ssd_sample_unit(lds, P, li, u >> 2, u & 3, tid); }
        }
    }
    if constexpr (KIND == 5) { if constexpr (hyb) gate_hyb(P, li, gw, ngw, lane); else gate_ssm(P, li, gw, ngw, lane); }
    if constexpr (KIND == 10) final_norm(P, gw, ngw, lane);
}
template <int KIND, bool hyb> __global__ void __launch_bounds__(512, 2) phase_kernel(Params p, int L) {
    extern __shared__ __attribute__((aligned(16))) unsigned char smem[];
    unsigned lbase = 0; asm volatile("" : "+v"(lbase));
    LAS unsigned char* lds = (LAS unsigned char*)smem + lbase;
    run_phase<KIND, hyb>(p, lds, L, threadIdx.x, blockIdx.x, gridDim.x);
}

template <int KIND, bool hyb> static void launch_phase(const Params& p, int L, hipStream_t stream) {
    static bool attr = false;
    if (!attr) { (void)hipFuncSetAttribute((const void*)phase_kernel<KIND, hyb>, hipFuncAttributeMaxDynamicSharedMemorySize, LDS_BYTES); attr = true; }
    hipLaunchKernelGGL((phase_kernel<KIND, hyb>), dim3(256), dim3(512), LDS_BYTES, stream, p, L);
}
extern "C" void kernel_launch(void* const* d_in, const int* in_sizes, int n_in, void* d_out, int out_size, void* d_ws, size_t ws_size, hipStream_t stream) {
    if (n_in != 27 || ws_size < WS_END) { fprintf(stderr, "kernel_launch: bad inputs n_in=%d ws=%zu need %zu\n", n_in, ws_size, (size_t)WS_END); return; }
    Params p{};
    for (int i = 0; i < 27; ++i) p.in[i] = (const float*)d_in[i];
    p.out = (float*)d_out; p.ws = (unsigned char*)d_ws; p.ph_lo = 0; p.ph_hi = 38;
    launch_phase<0, true>(p, 0, stream);
    for (int L = 0; L < 4; ++L) {
        if ((L & 1) == 0) { launch_phase<1, true>(p, L, stream); launch_phase<2, true>(p, L, stream); launch_phase<3, true>(p, L, stream); launch_phase<4, true>(p, L, stream); launch_phase<5, true>(p, L, stream); launch_phase<6, true>(p, L, stream); }
        else { launch_phase<1, true>(p, L, stream); launch_phase<2, false>(p, L, stream); launch_phase<3, false>(p, L, stream); launch_phase<4, false>(p, L, stream); launch_phase<5, false>(p, L, stream); launch_phase<6, false>(p, L, stream); }
        launch_phase<7, true>(p, L, stream); launch_phase<8, true>(p, L, stream); launch_phase<9, true>(p, L, stream);
    }
    launch_phase<10, true>(p, 0, stream);
}
```

```cpp
#include <hip/hip_runtime.h>
#include <hip/hip_cooperative_groups.h>
#include <cstdio>
#include <utility>
namespace cg = cooperative_groups;
namespace pg8 {
#define PG8_LAS __attribute__((address_space(3)))
typedef unsigned short bf16_t;
typedef short bf16x8 __attribute__((ext_vector_type(8)));
typedef float f32x4 __attribute__((ext_vector_type(4)));
typedef unsigned u32x4 __attribute__((ext_vector_type(4)));
constexpr int BM = 256, BK = 64, HALF = 128, HTB = HALF * BK * 2  , STAGE_BYTES = 8 * HTB, NXCD = 8, WGM = 8;

__host__ __device__ __forceinline__ int lds_byte(int r, int c) { const int st = (r >> 4) * 2 + (c >> 5), rr = r & 15, cc = c & 31, ob = rr * 64 + cc * 2; return st * 1024 + (ob ^ (((ob >> 9) & 1) << 5)); }
__host__ __device__ __forceinline__ void stage_rc(int b, int& R, int& C) { const int st = b / 1024, sb = b % 1024, swz = sb ^ (((sb >> 9) & 1) << 5); R = (st >> 1) * 16 + swz / 64; C = (st & 1) * 32 + (swz % 64) / 2; }
__host__ __device__ __forceinline__ int perm32(int rho) { const int n = rho >> 4, i = rho & 15; return 8 * (i >> 2) + 4 * n + (i & 3); }

struct Unit { int pm, pn; };
struct Gemm { const bf16_t* A; const bf16_t* Bt; int M, N, K; };

struct StaticOrder {
    int nM, nN, nwg, G, c;
    __host__ __device__ void init(int M, int N, int G_, int c_) { nM = M / BM; nN = N / BM; nwg = nM * nN; G = G_; c = c_; }
    __host__ __device__ bool next(int i, Unit& u) const {
        const long L = (long)i * G + c; if (L >= nwg) return false;
        int wgid = (int)L; { const int q = nwg / NXCD, r = nwg % NXCD, xcd = wgid % NXCD, off = wgid / NXCD; wgid = (xcd < r ? xcd * (q + 1) : r * (q + 1) + (xcd - r) * q) + off; }
        const int nig = WGM * nN, gid = wgid / nig, fm = gid * WGM, gsz = (nM - fm) < WGM ? (nM - fm) : WGM;
        u.pm = fm + ((wgid % nig) % gsz); u.pn = (wgid % nig) / gsz; return true;
    }
    __device__ __forceinline__ void a_ready(const Unit&) const {}
    __device__ __forceinline__ void done(const Unit&) const {}
};
template <class Epi, class Sched, bool STAMP = false>
__device__ __forceinline__ void gemm_phase(PG8_LAS unsigned char* lds, const Gemm g, const Sched& S, const Epi& E, unsigned long long* stamps, const int tid_in) {
    const int tid = tid_in, wid = __builtin_amdgcn_readfirstlane(tid >> 6), lane = tid & 63, wr = wid >> 2, wc = wid & 3, fr = lane & 15, fq = lane >> 4;
    const int K = g.K, nt = K / BK;
    int ts_lo = 0, ts_hi = 0, nts = 0; const unsigned long long rt_entry = STAMP ? (unsigned long long)wall_clock64() : 0ull;
#define PG8_STAMP() do { if (STAMP && wid == 0 && nts < 64) { const unsigned long long _c = (unsigned long long)clock64(); \
        ts_lo = (lane == nts) ? (int)(unsigned)_c : ts_lo; ts_hi = (lane == nts) ? (int)(unsigned)(_c >> 32) : ts_hi; ++nts; } } while (0)
    PG8_STAMP();
    unsigned voffA[2], voffB[2];
#pragma unroll
    for (int i = 0; i < 2; ++i) { int R, C; stage_rc(tid * 16 + i * 8192, R, C); const int Rb = Epi::PERM ? ((R & ~31) + perm32(R & 31)) : R;
        voffA[i] = (unsigned)(R * K + C) * 2u; voffB[i] = (unsigned)(Rb * K + C) * 2u; }
    const size_t kstep = (size_t)(BK * 2);
    const size_t hstep = (size_t)HALF * K * 2;
    const size_t tstep = 2 * hstep;
    const unsigned ldsw = (unsigned)wid * 1024u;
    const int aoff = lds_byte(wr * 64 + fr, fq * 8), boff = lds_byte(wc * 32 + fr, fq * 8);
#define PG8_SA(b, h) (((b) * 2 + (h)) * HTB)
#define PG8_SB(b, h) ((4 + (b) * 2 + (h)) * HTB)
#define PG8_STAGE(bufoff, gbase, voff) do { _Pragma("unroll") for (int _i = 0; _i < 2; ++_i) \
        __builtin_amdgcn_global_load_lds((const unsigned*)((const char*)(gbase) + (voff)[_i]), (PG8_LAS unsigned*)(lds + (bufoff) + ldsw + _i * 8192), 16, 0, 0); } while (0)
#define PG8_LDA(dst, b, h) do { _Pragma("unroll") for (int m = 0; m < 4; ++m) _Pragma("unroll") for (int k = 0; k < 2; ++k) dst[m][k] = *(const PG8_LAS bf16x8*)(lds + PG8_SA(b, h) + aoff + m * 2048 + k * 1024); } while (0)
#define PG8_LDB(dst, b, h) do { _Pragma("unroll") for (int n = 0; n < 2; ++n) _Pragma("unroll") for (int k = 0; k < 2; ++k) dst[n][k] = *(const PG8_LAS bf16x8*)(lds + PG8_SB(b, h) + boff + n * 2048 + k * 1024); } while (0)
#define PG8_MMA(ai, bj, At, Bt) do { __builtin_amdgcn_s_setprio(1); _Pragma("unroll") for (int m = 0; m < 4; ++m) _Pragma("unroll") for (int n = 0; n < 2; ++n) _Pragma("unroll") for (int k = 0; k < 2; ++k) \
        acc[ai][bj][m][n] = __builtin_amdgcn_mfma_f32_16x16x32_bf16(Bt[n][k], At[m][k], acc[ai][bj][m][n], 0, 0, 0); __builtin_amdgcn_s_setprio(0); } while (0)
#define PG8_WAIT_V(n) asm volatile("s_waitcnt vmcnt(" #n ")" ::: "memory")
#define PG8_WAIT_L(n) asm volatile("s_waitcnt lgkmcnt(" #n ")" ::: "memory")
#define PG8_BAR __builtin_amdgcn_s_barrier()
#define PG8_SCHED __builtin_amdgcn_sched_barrier(0)
    Unit cur, nxt; int ui = 0;
    if (!S.next(0, cur)) return;
    f32x4 acc[2][2][4][2];
#pragma unroll
    for (int a = 0; a < 2; ++a)
#pragma unroll
        for (int b = 0; b < 2; ++b)
#pragma unroll
            for (int m = 0; m < 4; ++m)
#pragma unroll
                for (int n = 0; n < 2; ++n) acc[a][b][m][n] = (f32x4){0.f, 0.f, 0.f, 0.f};
    bf16x8 At[4][2], B0[2][2], B1[2][2];
    const char* cA = (const char*)g.A + (size_t)cur.pm * tstep; const char* cB = (const char*)g.Bt + (size_t)cur.pn * tstep;
    S.a_ready(cur);
    PG8_STAGE(PG8_SB(0, 0), cB, voffB); PG8_STAGE(PG8_SA(0, 0), cA, voffA); PG8_STAGE(PG8_SB(0, 1), cB + hstep, voffB); PG8_STAGE(PG8_SA(0, 1), cA + hstep, voffA);
    if (wr == 1) PG8_BAR;
    PG8_WAIT_V(4); PG8_BAR;
    PG8_STAGE(PG8_SB(1, 0), cB + kstep, voffB); PG8_STAGE(PG8_SA(1, 0), cA + kstep, voffA); PG8_STAGE(PG8_SB(1, 1), cB + hstep + kstep, voffB);
    PG8_WAIT_V(6); PG8_BAR;
    PG8_STAMP();
    for (;;) {
        const bool has_next = S.next(ui + 1, nxt);
        const char* nA = has_next ? (const char*)g.A + (size_t)nxt.pm * tstep : cA; const char* nB = has_next ? (const char*)g.Bt + (size_t)nxt.pn * tstep : cB;
        for (int t = 0; t < nt; t += 2) {
            const bool last = (t == nt - 2);
            const char* a1 = cA + (size_t)(t + 1) * kstep;
            const char* a2 = last ? nA : cA + (size_t)(t + 2) * kstep; const char* b2 = last ? nB : cB + (size_t)(t + 2) * kstep;
            const char* a3 = a2 + kstep; const char* b3 = b2 + kstep;
            if (last && has_next) S.a_ready(nxt);
            PG8_LDB(B0, 0, 0); PG8_SCHED; PG8_LDA(At, 0, 0); PG8_STAGE(PG8_SA(1, 1), a1 + hstep, voffA);
            PG8_WAIT_L(8); PG8_BAR; PG8_WAIT_L(0); PG8_MMA(0, 0, At, B0); PG8_BAR; PG8_SCHED;
            PG8_LDB(B1, 0, 1); PG8_STAGE(PG8_SB(0, 0), b2, voffB);
            PG8_BAR; PG8_WAIT_L(0); PG8_MMA(0, 1, At, B1); PG8_BAR;
            PG8_LDA(At, 0, 1); PG8_STAGE(PG8_SA(0, 0), a2, voffA);
            PG8_BAR; PG8_WAIT_L(0); PG8_MMA(1, 0, At, B0); PG8_BAR; PG8_SCHED;
            PG8_STAGE(PG8_SB(0, 1), b2 + hstep, voffB);
            PG8_WAIT_V(6); PG8_BAR; PG8_MMA(1, 1, At, B1); PG8_BAR;
            PG8_LDB(B0, 1, 0); PG8_SCHED; PG8_LDA(At, 1, 0); PG8_STAGE(PG8_SA(0, 1), a2 + hstep, voffA);
            PG8_WAIT_L(8); PG8_BAR; PG8_WAIT_L(0); PG8_MMA(0, 0, At, B0); PG8_BAR; PG8_SCHED;
            PG8_LDB(B1, 1, 1); PG8_STAGE(PG8_SB(1, 0), b3, voffB);
            PG8_BAR; PG8_WAIT_L(0); PG8_MMA(0, 1, At, B1); PG8_BAR;
            PG8_LDA(At, 1, 1); PG8_STAGE(PG8_SA(1, 0), a3, voffA);
            PG8_BAR; PG8_WAIT_L(0); PG8_MMA(1, 0, At, B0); PG8_BAR; PG8_SCHED;
            PG8_STAGE(PG8_SB(1, 1), b3 + hstep, voffB);
            PG8_WAIT_V(6); PG8_BAR; PG8_MMA(1, 1, At, B1); PG8_BAR;
        }
        PG8_STAMP();
        if constexpr (!Epi::AFTER_DRAIN) { E(acc, cur, wr, wc, fr, fq); S.done(cur); }
        PG8_STAMP();
        if (!has_next) break;
#pragma unroll
        for (int a = 0; a < 2; ++a)
#pragma unroll
            for (int b = 0; b < 2; ++b)
#pragma unroll
                for (int m = 0; m < 4; ++m)
#pragma unroll
                    for (int n = 0; n < 2; ++n) acc[a][b][m][n] = (f32x4){0.f, 0.f, 0.f, 0.f};
        cur = nxt; cA = nA; cB = nB; ++ui;
    }
    PG8_WAIT_V(0);
    if (wr == 0) PG8_BAR;
    PG8_BAR;
    if constexpr (Epi::AFTER_DRAIN) { E.fused(acc, cur, wr, wc, fr, fq, lds, wid, lane); S.done(cur); }
    PG8_STAMP();
    if (STAMP && wid == 0) { stamps[lane] = lane < nts ? (((unsigned long long)(unsigned)ts_hi << 32) | (unsigned)ts_lo) : 0ull;
        if (lane == 62) stamps[62] = rt_entry; if (lane == 63) stamps[63] = (unsigned long long)wall_clock64(); }
#undef PG8_STAMP
#undef PG8_SA
#undef PG8_SB
#undef PG8_STAGE
#undef PG8_LDA
#undef PG8_LDB
#undef PG8_MMA
#undef PG8_WAIT_V
#undef PG8_WAIT_L
#undef PG8_BAR
#undef PG8_SCHED
}
}

#define DI __device__ __forceinline__
#define LAS __attribute__((address_space(3)))
using pg8::bf16_t; using pg8::bf16x8; using pg8::f32x4; using pg8::u32x4;
typedef short s16x4 __attribute__((ext_vector_type(4)));
typedef unsigned u32x2 __attribute__((ext_vector_type(2)));
typedef float f32x2 __attribute__((ext_vector_type(2)));
typedef __bf16 bfv2 __attribute__((ext_vector_type(2)));

constexpr int D = 1024, TP = 16384, TS = 128, TR = TP + TS, MP = 16640, SEQ = 2048;
constexpr int NH = 3840, NHR = 3592, NS = 5376, NSR = 5152, FF = 4096;
constexpr int LDS_BYTES = 150 * 1024;
constexpr size_t O_YP = 0, O_YS = 16777216, O_PGDN = O_YS + 131072, O_PGC = O_PGDN + 1048576, O_PRET = O_PGC + 73728, O_PSSM = O_PRET + 524288,
                 O_PSC = O_PSSM + 4194304, O_SGDN = O_PSC + 147456, O_SGC = O_SGDN + 16777216, O_SRET = O_SGC + 1179648, O_SSSM = O_SRET + 8388608, O_SSC = O_SSSM + 67108864;
constexpr size_t WS_WINH = 0, WS_WOUTH = WS_WINH + 2ull * NH * 1024 * 2, WS_WINS = WS_WOUTH + 2ull * 1024 * 1024 * 2, WS_WOUTS = WS_WINS + 2ull * NS * 1024 * 2,
                 WS_W1 = WS_WOUTS + 2ull * 1024 * 2048 * 2, WS_W2 = WS_W1 + 4ull * 4096 * 1024 * 2, WS_X = WS_W2 + 4ull * 4096 * 1024 * 2, WS_H = WS_X + (size_t)MP * 1024 * 4,
                 WS_PROJ = WS_H + (size_t)MP * 1024 * 2, WS_YRAW = WS_PROJ + (size_t)MP * NS * 2, WS_MIX = WS_YRAW + (size_t)MP * 2048 * 2, WS_ACT = WS_MIX + (size_t)MP * 2048 * 2,
                 WS_CHK = WS_ACT + (size_t)MP * 4096 * 2;
constexpr int GB_NW = 0, GB_QG = 17408, GB_P = 34816, GB_KDT = 44032, GB_UT = 62464, GB_SC = 80896, GB_SIZE = 80960;
constexpr int RB_QG = 0, RB_P = 9216, RB_KDT = 18432, RB_VT = 27648, RB_SC = 46080, RB_SIZE = 46144;
constexpr int SG_CM = 0, SG_BT = 17408, SG_SIZE = 35840;
constexpr int SH_XT = 0, SH_PP = 9216, SH_SC = 18432, SH_SIZE = 19456;
constexpr size_t CHK_GDN = 0, CHK_RET = 1024ull * GB_SIZE, CHK_SG = 0, CHK_SH = 1024ull * SG_SIZE, CHK_END = 1024ull * GB_SIZE + 1024ull * RB_SIZE;
constexpr size_t WS_BAR = WS_CHK + (CHK_END > (1024ull * SG_SIZE + 8192ull * SH_SIZE) ? CHK_END : (1024ull * SG_SIZE + 8192ull * SH_SIZE));
constexpr size_t WS_END = WS_BAR + 16384;

struct Params { const float* in[27]; float* out; unsigned char* ws; int ph_lo, ph_hi; };

DI unsigned pk(float a, float b) { f32x2 v = {a, b}; bfv2 r = __builtin_convertvector(v, bfv2); return __builtin_bit_cast(unsigned, r); }
DI bf16_t f2bf(float a) { return (bf16_t)(pk(a, a) & 0xffffu); }
DI float bf2f(bf16_t b) { return __uint_as_float((unsigned)b << 16); }
DI float bflo(unsigned u) { return __uint_as_float(u << 16); }
DI float bfhi(unsigned u) { return __uint_as_float(u & 0xffff0000u); }
DI float wsum(float v) {
#pragma unroll
    for (int o = 32; o >= 1; o >>= 1) v += __shfl_xor(v, o);
    return v; }
DI float siluf(float x) { return x / (1.f + __expf(-x)); }
DI float softplusf(float x) { return fmaxf(x, 0.f) + log1pf(__expf(-fabsf(x))); }
DI bf16x8 lda_nat(const LAS unsigned char* base, int row, int strideB, int k0, int q) { return *(const LAS bf16x8*)(base + row * strideB + (k0 + 8 * q) * 2); }
DI bf16x8 lda_perm(const LAS unsigned char* base, int row, int strideB, int k0, int q) {
    const s16x4 lo = *(const LAS s16x4*)(base + row * strideB + (k0 + 4 * q) * 2);
    const s16x4 hi = *(const LAS s16x4*)(base + row * strideB + (k0 + 16 + 4 * q) * 2);
    return __builtin_shufflevector(lo, hi, 0, 1, 2, 3, 4, 5, 6, 7); }
DI bf16x8 pack2(f32x4 a, f32x4 b) { u32x4 p; p.x = pk(a[0], a[1]); p.y = pk(a[2], a[3]); p.z = pk(b[0], b[1]); p.w = pk(b[2], b[3]); return __builtin_bit_cast(bf16x8, p); }
#define MFMA16(a, b, c) __builtin_amdgcn_mfma_f32_16x16x32_bf16((a), (b), (c), 0, 0, 0)

template <int ACT> struct EpiB {
    static constexpr bool PERM = true, AFTER_DRAIN = false;
    bf16_t* O; int ldc;
    DI void operator()(const f32x4 (&acc)[2][2][4][2], const pg8::Unit& u, int wr, int wc, int fr, int fq) const {
        const int row0 = u.pm * 256 + wr * 64 + fr, col0 = u.pn * 256 + wc * 32 + 8 * fq;
#pragma unroll
        for (int ai = 0; ai < 2; ++ai)
#pragma unroll
            for (int m = 0; m < 4; ++m) { bf16_t* rowp = O + (size_t)(row0 + ai * 128 + m * 16) * ldc + col0;
#pragma unroll
                for (int bj = 0; bj < 2; ++bj) { f32x4 v0 = acc[ai][bj][m][0], v1 = acc[ai][bj][m][1];
                    if (ACT == 1) {
#pragma unroll
                        for (int j = 0; j < 4; ++j) { const float a = fmaxf(v0[j], 0.f), b = fmaxf(v1[j], 0.f); v0[j] = a * a; v1[j] = b * b; } }
                    u32x4 w; w.x = pk(v0[0], v0[1]); w.y = pk(v0[2], v0[3]); w.z = pk(v1[0], v1[1]); w.w = pk(v1[2], v1[3]);
                    *(u32x4*)(rowp + bj * 128) = w; } }
    }
};
struct EpiRes {
    static constexpr bool PERM = true, AFTER_DRAIN = false;
    bf16_t* X;
    DI void operator()(const f32x4 (&acc)[2][2][4][2], const pg8::Unit& u, int wr, int wc, int fr, int fq) const {
        const int row0 = u.pm * 256 + wr * 64 + fr, col0 = u.pn * 256 + wc * 32 + 8 * fq;
#pragma unroll
        for (int ai = 0; ai < 2; ++ai)
#pragma unroll
            for (int m = 0; m < 4; ++m) { bf16_t* rowp = X + (size_t)(row0 + ai * 128 + m * 16) * D + col0;
#pragma unroll
                for (int bj = 0; bj < 2; ++bj) { u32x4* p = (u32x4*)(rowp + bj * 128); const u32x4 o = *p; const f32x4 a = acc[ai][bj][m][0], b = acc[ai][bj][m][1];
                    u32x4 w; w.x = pk(bflo(o.x) + a[0], bfhi(o.x) + a[1]); w.y = pk(bflo(o.y) + a[2], bfhi(o.y) + a[3]);
                    w.z = pk(bflo(o.z) + b[0], bfhi(o.z) + b[1]); w.w = pk(bflo(o.w) + b[2], bfhi(o.w) + b[3]); *p = w; } }
    }
};

DI void tload(const float* W, int N, int item, int nblk, int lane, f32x4 (&tv)[8]) {
    const int kb = item / nblk, nb = item % nblk, k0 = 64 * kb, n0 = 32 * nb;
    const int n4 = (lane & 7) * 4, kr = lane >> 3; const bool ok = n0 + n4 < N;
#pragma unroll
    for (int i = 0; i < 8; ++i) tv[i] = ok ? __builtin_nontemporal_load((const f32x4*)(W + (size_t)(k0 + 8 * i + kr) * N + n0 + n4)) : (f32x4){0.f, 0.f, 0.f, 0.f};
}
DI void tstore(const f32x4 (&tv)[8], int K, bf16_t* WT, LAS float* scr, int item, int nblk, int lane) {
    const int kb = item / nblk, nb = item % nblk, k0 = 64 * kb, n0 = 32 * nb;
    const int n4 = (lane & 7) * 4, kr = lane >> 3;
#pragma unroll
    for (int i = 0; i < 8; ++i) { LAS float* d = scr + (8 * i + kr) * 33 + n4; d[0] = tv[i][0]; d[1] = tv[i][1]; d[2] = tv[i][2]; d[3] = tv[i][3]; }
    __builtin_amdgcn_s_waitcnt(0xc07f); asm volatile("" ::: "memory");
    const int c = lane & 7;
#pragma unroll
    for (int j = 0; j < 4; ++j) { const int nn = (lane >> 3) + 8 * j; const LAS float* s = scr + (8 * c) * 33 + nn;
        u32x4 o; o.x = pk(s[0 * 33], s[1 * 33]); o.y = pk(s[2 * 33], s[3 * 33]); o.z = pk(s[4 * 33], s[5 * 33]); o.w = pk(s[6 * 33], s[7 * 33]);
        *(u32x4*)(WT + (size_t)(n0 + nn) * K + k0 + 8 * c) = o; }
    __builtin_amdgcn_s_waitcnt(0xc07f); asm volatile("" ::: "memory");
}
DI void prologue(const Params& p, LAS unsigned char* lds, int gw, int ngw, int wv, int lane) {
    LAS float* scr = (LAS float*)(lds + wv * 8704);
    for (int mat = 0; mat < 6; ++mat) {
        const float* src; int K, N, Np, cnt; size_t dst;
        switch (mat) {
            case 0: src = p.in[10]; K = 1024; N = NHR; Np = NH; cnt = 2; dst = WS_WINH; break;
            case 1: src = p.in[16]; K = 1024; N = 1024; Np = 1024; cnt = 2; dst = WS_WOUTH; break;
            case 2: src = p.in[17]; K = 1024; N = NSR; Np = NS; cnt = 2; dst = WS_WINS; break;
            case 3: src = p.in[24]; K = 2048; N = 1024; Np = 1024; cnt = 2; dst = WS_WOUTS; break;
            case 4: src = p.in[25]; K = 1024; N = FF; Np = FF; cnt = 4; dst = WS_W1; break;
            default: src = p.in[26]; K = FF; N = 1024; Np = 1024; cnt = 4; dst = WS_W2; break;
        }
        const int nblk = Np / 32, per = (K / 64) * nblk, tot = per * cnt;
        f32x4 ta[8], tb[8];
        int it = gw;
        if (it < tot) tload(src + (size_t)(it / per) * K * N, N, it % per, nblk, lane, ta);
#pragma nounroll
        for (; it < tot; it += 2 * ngw) {
            const int it2 = it + ngw;
            if (it2 < tot) tload(src + (size_t)(it2 / per) * K * N, N, it2 % per, nblk, lane, tb);
            tstore(ta, K, (bf16_t*)(p.ws + dst) + (size_t)(it / per) * Np * K, scr, it % per, nblk, lane);
            const int it3 = it2 + ngw;
            if (it3 < tot) tload(src + (size_t)(it3 / per) * K * N, N, it3 % per, nblk, lane, ta);
            if (it2 < tot) tstore(tb, K, (bf16_t*)(p.ws + dst) + (size_t)(it2 / per) * Np * K, scr, it2 % per, nblk, lane);
        }
    }
    bf16_t* H = (bf16_t*)(p.ws + WS_H);
    for (int m = TR + gw; m < MP; m += ngw) { u32x4 z = {0u, 0u, 0u, 0u}; *(u32x4*)(H + (size_t)m * D + lane * 8) = z; *(u32x4*)(H + (size_t)m * D + 512 + lane * 8) = z; }
}

constexpr size_t WS_XS = WS_X + (size_t)MP * 1024 * 2;
DI void norm_rows(const Params& p, const float* w, bool copy, int gw, int ngw, int lane) {
    bf16_t* X16 = (bf16_t*)(p.ws + WS_X); float* Xs = (float*)(p.ws + WS_XS); bf16_t* H = (bf16_t*)(p.ws + WS_H);
    f32x4 wv[4];
#pragma unroll
    for (int j = 0; j < 2; ++j) { wv[2 * j] = *(const f32x4*)(w + 8 * lane + 512 * j); wv[2 * j + 1] = *(const f32x4*)(w + 8 * lane + 512 * j + 4); }
    for (int m0 = gw * 2; m0 < TP; m0 += ngw * 2) {
        f32x4 v[2][4];
#pragma unroll
        for (int rr = 0; rr < 2; ++rr) { const int m = m0 + rr;
            if (copy) {
#pragma unroll
                for (int j = 0; j < 2; ++j) { v[rr][2 * j] = __builtin_nontemporal_load((const f32x4*)(p.in[0] + (size_t)m * D + 8 * lane + 512 * j)); v[rr][2 * j + 1] = __builtin_nontemporal_load((const f32x4*)(p.in[0] + (size_t)m * D + 8 * lane + 512 * j + 4)); }
            } else {
#pragma unroll
                for (int j = 0; j < 2; ++j) { const u32x4 u = *(const u32x4*)(X16 + (size_t)m * D + 8 * lane + 512 * j);
                    v[rr][2 * j] = (f32x4){bflo(u.x), bfhi(u.x), bflo(u.y), bfhi(u.y)}; v[rr][2 * j + 1] = (f32x4){bflo(u.z), bfhi(u.z), bflo(u.w), bfhi(u.w)}; }
            } }
#pragma unroll
        for (int rr = 0; rr < 2; ++rr) { const int m = m0 + rr; float ss = 0.f;
#pragma unroll
            for (int j = 0; j < 4; ++j) ss += v[rr][j][0] * v[rr][j][0] + v[rr][j][1] * v[rr][j][1] + v[rr][j][2] * v[rr][j][2] + v[rr][j][3] * v[rr][j][3];
            ss = wsum(ss); const float r = rsqrtf(ss * (1.f / 1024.f) + 1e-6f);
#pragma unroll
            for (int j = 0; j < 2; ++j) { const f32x4 a = v[rr][2 * j], b = v[rr][2 * j + 1];
                if (copy) { u32x4 xo; xo.x = pk(a[0], a[1]); xo.y = pk(a[2], a[3]); xo.z = pk(b[0], b[1]); xo.w = pk(b[2], b[3]); *(u32x4*)(X16 + (size_t)m * D + 8 * lane + 512 * j) = xo; }
                u32x4 o; o.x = pk(a[0] * r * wv[2 * j][0], a[1] * r * wv[2 * j][1]); o.y = pk(a[2] * r * wv[2 * j][2], a[3] * r * wv[2 * j][3]);
                o.z = pk(b[0] * r * wv[2 * j + 1][0], b[1] * r * wv[2 * j + 1][1]); o.w = pk(b[2] * r * wv[2 * j + 1][2], b[3] * r * wv[2 * j + 1][3]);
                *(u32x4*)(H + (size_t)m * D + 8 * lane + 512 * j) = o; } }
    }
    for (int m = TP + gw; m < TR; m += ngw) {
        const float* src = copy ? p.in[1] + (size_t)(m - TP) * D : Xs + (size_t)(m - TP) * D;
        f32x4 v[4]; float ss = 0.f;
#pragma unroll
        for (int j = 0; j < 4; ++j) { v[j] = *(const f32x4*)(src + 4 * lane + 256 * j); ss += v[j][0] * v[j][0] + v[j][1] * v[j][1] + v[j][2] * v[j][2] + v[j][3] * v[j][3]; }
        ss = wsum(ss); const float r = rsqrtf(ss * (1.f / 1024.f) + 1e-6f);
#pragma unroll
        for (int j = 0; j < 4; ++j) { const f32x4 ww = *(const f32x4*)(w + 4 * lane + 256 * j);
            if (copy) *(f32x4*)(Xs + (size_t)(m - TP) * D + 4 * lane + 256 * j) = v[j];
            u32x2 o; o.x = pk(v[j][0] * r * ww[0], v[j][1] * r * ww[1]); o.y = pk(v[j][2] * r * ww[2], v[j][3] * r * ww[3]);
            *(u32x2*)(H + (size_t)m * D + 4 * lane + 256 * j) = o; }
    }
}
DI void final_norm(const Params& p, int gw, int ngw, int lane) {
    const bf16_t* X16 = (const bf16_t*)(p.ws + WS_X); const float* Xs = (const float*)(p.ws + WS_XS); const float* w = p.in[9];
    f32x4 wv[4];
#pragma unroll
    for (int j = 0; j < 2; ++j) { wv[2 * j] = *(const f32x4*)(w + 8 * lane + 512 * j); wv[2 * j + 1] = *(const f32x4*)(w + 8 * lane + 512 * j + 4); }
    for (int m0 = gw * 2; m0 < TP; m0 += ngw * 2) {
        f32x4 v[2][4];
#pragma unroll
        for (int rr = 0; rr < 2; ++rr)
#pragma unroll
            for (int j = 0; j < 2; ++j) { const u32x4 u = __builtin_nontemporal_load((const u32x4*)(X16 + (size_t)(m0 + rr) * D + 8 * lane + 512 * j));
                v[rr][2 * j] = (f32x4){bflo(u.x), bfhi(u.x), bflo(u.y), bfhi(u.y)}; v[rr][2 * j + 1] = (f32x4){bflo(u.z), bfhi(u.z), bflo(u.w), bfhi(u.w)}; }
#pragma unroll
        for (int rr = 0; rr < 2; ++rr) { const int m = m0 + rr; float ss = 0.f; float* dst = p.out + O_YP + (size_t)m * D;
#pragma unroll
            for (int j = 0; j < 4; ++j) ss += v[rr][j][0] * v[rr][j][0] + v[rr][j][1] * v[rr][j][1] + v[rr][j][2] * v[rr][j][2] + v[rr][j][3] * v[rr][j][3];
            ss = wsum(ss); const float r = rsqrtf(ss * (1.f / 1024.f) + 1e-6f);
#pragma unroll
            for (int j = 0; j < 2; ++j) { __builtin_nontemporal_store(v[rr][2 * j] * r * wv[2 * j], (f32x4*)(dst + 8 * lane + 512 * j)); __builtin_nontemporal_store(v[rr][2 * j + 1] * r * wv[2 * j + 1], (f32x4*)(dst + 8 * lane + 512 * j + 4)); } }
    }
    for (int m = TP + gw; m < TR; m += ngw) {
        const float* src = Xs + (size_t)(m - TP) * D; float* dst = p.out + O_YS + (size_t)(m - TP) * D;
        f32x4 v[4]; float ss = 0.f;
#pragma unroll
        for (int j = 0; j < 4; ++j) { v[j] = *(const f32x4*)(src + 4 * lane + 256 * j); ss += v[j][0] * v[j][0] + v[j][1] * v[j][1] + v[j][2] * v[j][2] + v[j][3] * v[j][3]; }
        ss = wsum(ss); const float r = rsqrtf(ss * (1.f / 1024.f) + 1e-6f);
#pragma unroll
        for (int j = 0; j < 4; ++j) { const f32x4 ww = *(const f32x4*)(w + 4 * lane + 256 * j); *(f32x4*)(dst + 4 * lane + 256 * j) = v[j] * r * ww; }
    }
}

constexpr int P_KN = 0, P_QN = 17408, P_KBT = 34816, P_KDT = 53248, P_VBT = 71680, P_AM = 90112, P_TM = 107520, P_SC = 116736, P_TF = 117760;
DI void gdn_prep_unit(LAS unsigned char* lds, const bf16_t* PROJ, const float* convw, float a_log_h, float dtb_h, unsigned char* blk, int row0, int h, int tid) {
    asm volatile("" : "+v"(tid));
    const int lane = tid & 63, w = tid >> 6, r = lane & 15, q = lane >> 4;
    LAS float* scG = (LAS float*)(lds + P_SC); LAS float* scC = scG + 64; LAS float* scB = scG + 128;
    if (w == 0) {
        const bf16_t* pr = PROJ + (size_t)(row0 + lane) * NH;
        const float braw = bf2f(pr[2048 + h]), araw = bf2f(pr[2052 + h]);
        const float beta = 1.f / (1.f + __expf(-braw));
        const float g = -__expf(a_log_h) * softplusf(araw + dtb_h);
        float c = g;
#pragma unroll
        for (int o = 1; o < 64; o <<= 1) { const float t = __shfl_up(c, o); if (lane >= o) c += t; }
        scG[lane] = g; scC[lane] = c; scB[lane] = beta;
    }
    __syncthreads();
    const float gend = scC[63];
    float cw[3][4][2];
#pragma unroll
    for (int grp = 0; grp < 3; ++grp)
#pragma unroll
        for (int tap = 0; tap < 4; ++tap) { const f32x2 t = *(const f32x2*)(convw + tap * 1536 + grp * 512 + h * 128 + 2 * lane); cw[grp][tap][0] = t[0]; cw[grp][tap][1] = t[1]; }
    LAS bf16_t* kbt = (LAS bf16_t*)(lds + P_KBT); LAS bf16_t* kdt = (LAS bf16_t*)(lds + P_KDT); LAS bf16_t* vbt = (LAS bf16_t*)(lds + P_VBT);
    unsigned xr[11][3];
#pragma unroll
    for (int j = 0; j < 11; ++j) { const int t = (row0 & (SEQ - 1)) + w * 8 - 3 + j; const bf16_t* pr = PROJ + (size_t)(row0 + w * 8 - 3 + j) * NH + h * 128 + 2 * lane;
#pragma unroll
        for (int grp = 0; grp < 3; ++grp) xr[j][grp] = (t >= 0) ? *(const unsigned*)(pr + grp * 512) : 0u; }
#pragma unroll
    for (int tt = 0; tt < 8; ++tt) {
        const int i = w * 8 + tt;
        float a[3][2] = {{0.f, 0.f}, {0.f, 0.f}, {0.f, 0.f}};
#pragma unroll
        for (int tap = 0; tap < 4; ++tap)
#pragma unroll
            for (int grp = 0; grp < 3; ++grp) { const unsigned u = xr[tt + tap][grp]; a[grp][0] += cw[grp][tap][0] * bflo(u); a[grp][1] += cw[grp][tap][1] * bfhi(u); }
#pragma unroll
        for (int grp = 0; grp < 3; ++grp) { a[grp][0] = siluf(a[grp][0]); a[grp][1] = siluf(a[grp][1]); }
        const float sq = wsum(a[0][0] * a[0][0] + a[0][1] * a[0][1]), sk = wsum(a[1][0] * a[1][0] + a[1][1] * a[1][1]);
        const float rq = rsqrtf(sq + 1e-6f) * 0.08838834764831845f, rk = rsqrtf(sk + 1e-6f);
        const float q0 = a[0][0] * rq, q1 = a[0][1] * rq, k0 = a[1][0] * rk, k1 = a[1][1] * rk, v0 = a[2][0], v1 = a[2][1];
        const float gc = scC[i], be = scB[i], eg = __expf(gc), ed = __expf(gend - gc);
        *(LAS unsigned*)(lds + P_QN + i * 272 + lane * 4) = pk(q0, q1);
        *(LAS unsigned*)(lds + P_KN + i * 272 + lane * 4) = pk(k0, k1);
        *(unsigned*)(blk + GB_QG + i * 272 + lane * 4) = pk(q0 * eg, q1 * eg);
        kbt[(2 * lane) * 72 + i] = f2bf(k0 * be * eg); kbt[(2 * lane + 1) * 72 + i] = f2bf(k1 * be * eg);
        kdt[(2 * lane) * 72 + i] = f2bf(k0 * ed); kdt[(2 * lane + 1) * 72 + i] = f2bf(k1 * ed);
        vbt[(2 * lane) * 72 + i] = f2bf(v0 * be); vbt[(2 * lane + 1) * 72 + i] = f2bf(v1 * be);
    }
    __syncthreads();
    LAS float* AM = (LAS float*)(lds + P_AM);
    for (int tix = w; tix < 16; tix += 8) { const int mi = tix >> 2, nj = tix & 3;
        f32x4 kk = {0.f, 0.f, 0.f, 0.f}, qk = {0.f, 0.f, 0.f, 0.f};
        if (nj <= mi) {
#pragma unroll
            for (int s = 0; s < 4; ++s) { const bf16x8 bk = lda_nat(lds + P_KN, 16 * nj + r, 272, 32 * s, q), ak = lda_nat(lds + P_KN, 16 * mi + r, 272, 32 * s, q), aq = lda_nat(lds + P_QN, 16 * mi + r, 272, 32 * s, q);
                kk = MFMA16(ak, bk, kk); qk = MFMA16(aq, bk, qk); } }
#pragma unroll
        for (int reg = 0; reg < 4; ++reg) { const int i = 16 * mi + 4 * q + reg, j = 16 * nj + r;
            const float dec = (j <= i) ? __expf(scC[i] - scC[j]) : 0.f;
            AM[j * 68 + i] = (j < i) ? scB[i] * kk[reg] * dec : 0.f;
            *(bf16_t*)(blk + GB_P + (i * 72 + j) * 2) = f2bf(qk[reg] * dec); }
    }
    __syncthreads();
    if (w == 0) {
        LAS bf16_t* TM = (LAS bf16_t*)(lds + P_TM);
        float t[64];
#pragma unroll
        for (int i = 0; i < 64; ++i) t[i] = (lane == i) ? 1.f : 0.f;
#pragma unroll
        for (int j = 0; j < 63; ++j) { const float tj = t[j];
#pragma unroll
            for (int i = j + 1; i < 64; ++i) t[i] -= AM[j * 68 + i] * tj; }
#pragma unroll
        for (int i = 0; i < 64; ++i) TM[i * 72 + lane] = f2bf(t[i]);
    } else {
        for (int idx = tid - 64; idx < 1152; idx += 448) *(u32x4*)(blk + GB_KDT + idx * 16) = *(const LAS u32x4*)(lds + P_KDT + idx * 16);
    }
    __syncthreads();
    for (int tix = w; tix < 64; tix += 8) {
        f32x4 acc = {0.f, 0.f, 0.f, 0.f};
        if (tix < 32) { const int mi = tix >> 3, nv = tix & 7;
#pragma unroll
            for (int s = 0; s < 2; ++s) acc = MFMA16(lda_nat(lds + P_TM, 16 * mi + r, 144, 32 * s, q), lda_nat(lds + P_VBT, 16 * nv + r, 144, 32 * s, q), acc);
            u32x2 o; o.x = pk(acc[0], acc[1]); o.y = pk(acc[2], acc[3]);
            *(u32x2*)(blk + GB_UT + ((16 * nv + r) * 72 + 16 * mi + 4 * q) * 2) = o;
        } else { const int t2 = tix - 32, mk = t2 >> 2, ni = t2 & 3;
#pragma unroll
            for (int s = 0; s < 2; ++s) acc = MFMA16(lda_nat(lds + P_KBT, 16 * mk + r, 144, 32 * s, q), lda_nat(lds + P_TM, 16 * ni + r, 144, 32 * s, q), acc);
            u32x2 o; o.x = pk(-acc[0], -acc[1]); o.y = pk(-acc[2], -acc[3]);
            *(u32x2*)(blk + GB_NW + ((16 * ni + r) * 136 + 16 * mk + 4 * q) * 2) = o; }
    }
    if (tid == 0) *(float*)(blk + GB_SC) = __expf(gend);
    __syncthreads();
}

constexpr int R_QR = 0, R_KR = 9216, R_KDT = 18432, R_VT = 27648;
DI void rot_sincos(float pos, int f, float& sn, float& cs) {
    const float inv = exp2f(-(float)f * (13.287712379549449f / 32.f));
    const float ang = pos * inv;
    double rev = (double)ang * 0.15915494309189535; rev -= __builtin_floor(rev);
    const float fr = (float)rev;
    sn = __builtin_amdgcn_sinf(fr); cs = __builtin_amdgcn_cosf(fr);
}
DI void ret_prep_unit(LAS unsigned char* lds, const bf16_t* PROJ, unsigned char* blk, int row0, int h, int tid) {
    asm volatile("" : "+v"(tid));
    const int lane = tid & 63, w = tid >> 6, r = lane & 15, q = lane >> 4;
    const float lg = __logf(1.f - exp2f(-5.f - (float)h));
    const int f = lane & 31, which = lane >> 5;
    LAS bf16_t* qr = (LAS bf16_t*)(lds + R_QR); LAS bf16_t* kr = (LAS bf16_t*)(lds + R_KR); LAS bf16_t* kdt = (LAS bf16_t*)(lds + R_KDT); LAS bf16_t* vt = (LAS bf16_t*)(lds + R_VT);
#pragma unroll
    for (int tt = 0; tt < 8; ++tt) {
        const int i = w * 8 + tt, t = (row0 & (SEQ - 1)) + i;
        const bf16_t* pr = PROJ + (size_t)(row0 + i) * NH;
        const int base = (which ? 2312 : 2056) + h * 64;
        const float x1 = bf2f(pr[base + f]), x2 = bf2f(pr[base + 32 + f]);
        float sn, cs; rot_sincos((float)t, f, sn, cs);
        float o1 = x1 * cs - x2 * sn, o2 = x2 * cs + x1 * sn;
        if (which == 0) {
            qr[i * 72 + f] = f2bf(o1); qr[i * 72 + 32 + f] = f2bf(o2);
            const float eg = __expf((float)(i + 1) * lg);
            *(bf16_t*)(blk + RB_QG + (i * 72 + f) * 2) = f2bf(o1 * eg); *(bf16_t*)(blk + RB_QG + (i * 72 + 32 + f) * 2) = f2bf(o2 * eg);
        } else {
            o1 *= 0.125f; o2 *= 0.125f;
            kr[i * 72 + f] = f2bf(o1); kr[i * 72 + 32 + f] = f2bf(o2);
            const float ed = __expf((float)(63 - i) * lg);
            kdt[f * 72 + i] = f2bf(o1 * ed); kdt[(32 + f) * 72 + i] = f2bf(o2 * ed);
        }
        const unsigned u = *(const unsigned*)(pr + 2568 + h * 128 + 2 * lane);
        vt[(2 * lane) * 72 + i] = (bf16_t)(u & 0xffffu); vt[(2 * lane + 1) * 72 + i] = (bf16_t)(u >> 16);
    }
    __syncthreads();
    for (int tix = w; tix < 16; tix += 8) { const int mi = tix >> 2, nj = tix & 3;
        f32x4 qk = {0.f, 0.f, 0.f, 0.f};
        if (nj <= mi) {
#pragma unroll
            for (int s = 0; s < 2; ++s) qk = MFMA16(lda_nat(lds + R_QR, 16 * mi + r, 144, 32 * s, q), lda_nat(lds + R_KR, 16 * nj + r, 144, 32 * s, q), qk); }
#pragma unroll
        for (int reg = 0; reg < 4; ++reg) { const int i = 16 * mi + 4 * q + reg, j = 16 * nj + r;
            const float dec = (j <= i) ? __expf((float)(i - j) * lg) : 0.f;
            *(bf16_t*)(blk + RB_P + (i * 72 + j) * 2) = f2bf(qk[reg] * dec); }
    }
    for (int idx = tid; idx < 1728; idx += 512) *(u32x4*)(blk + RB_KDT + idx * 16) = *(const LAS u32x4*)(lds + R_KDT + idx * 16);
    if (tid == 0) *(float*)(blk + RB_SC) = __expf(64.f * lg);
    __syncthreads();
}

constexpr int Q_CM = 0, Q_BM = 17408, Q_BT = 34816, Q_XT = 53248, Q_END = 53248 + 73728;
DI void ssd_prep_unit(LAS unsigned char* lds, const bf16_t* PROJ, const float* convw  , const float* convb, const float* dtb, const float* alog, const float* dsk,
                      unsigned char* gblk, unsigned char* hblk0  , int row0, int g, int tid) {
    asm volatile("" : "+v"(tid));
    const int lane = tid & 63, w = tid >> 6, r = lane & 15, q = lane >> 4;
    int ch[6];
#pragma unroll
    for (int j = 0; j < 4; ++j) ch[j] = g * 512 + 128 * j + 2 * lane;
    ch[4] = 2048 + g * 128 + 2 * lane; ch[5] = 2560 + g * 128 + 2 * lane;
    float cw[6][5][2];
#pragma unroll
    for (int j = 0; j < 6; ++j) {
#pragma unroll
        for (int tap = 0; tap < 4; ++tap) { const f32x2 t = *(const f32x2*)(convw + tap * 3072 + ch[j]); cw[j][tap][0] = t[0]; cw[j][tap][1] = t[1]; }
        const f32x2 t = *(const f32x2*)(convb + ch[j]); cw[j][4][0] = t[0]; cw[j][4][1] = t[1]; }
    LAS bf16_t* bt = (LAS bf16_t*)(lds + Q_BT); LAS bf16_t* xt = (LAS bf16_t*)(lds + Q_XT);
    if (w == 0) {
        const bf16_t* pr = PROJ + (size_t)(row0 + lane) * NS + 5120 + g * 8;
#pragma unroll
        for (int hh = 0; hh < 8; ++hh) { const int head = g * 8 + hh;
            const float dt = softplusf(bf2f(pr[hh]) + dtb[head]); const float gg = -__expf(alog[head]) * dt;
            float c = gg;
#pragma unroll
            for (int o = 1; o < 64; o <<= 1) { const float t = __shfl_up(c, o); if (lane >= o) c += t; }
            const float gend = __shfl(c, 63);
            float* sc = (float*)(hblk0 + (size_t)(hh >> 1) * 32 * 2 * SH_SIZE + (hh & 1) * SH_SIZE + SH_SC);
            sc[lane] = dt * __expf(gend - c); sc[64 + lane] = __expf(c);
            LAS float* ls = (LAS float*)(lds + Q_END) + hh * 128; ls[lane] = dt; ls[64 + lane] = c; }
    }
    unsigned xr[11][6];
#pragma unroll
    for (int jr = 0; jr < 11; ++jr) { const int t = (row0 & (SEQ - 1)) + w * 8 - 3 + jr; const bf16_t* pr = PROJ + (size_t)(row0 + w * 8 - 3 + jr) * NS + 2048;
#pragma unroll
        for (int j = 0; j < 6; ++j) xr[jr][j] = (t >= 0) ? *(const unsigned*)(pr + ch[j]) : 0u; }
#pragma unroll
    for (int tt = 0; tt < 8; ++tt) {
        const int i = w * 8 + tt;
        float a[6][2];
#pragma unroll
        for (int j = 0; j < 6; ++j) { a[j][0] = cw[j][4][0]; a[j][1] = cw[j][4][1]; }
#pragma unroll
        for (int tap = 0; tap < 4; ++tap)
#pragma unroll
            for (int j = 0; j < 6; ++j) { const unsigned u = xr[tt + tap][j]; a[j][0] += cw[j][tap][0] * bflo(u); a[j][1] += cw[j][tap][1] * bfhi(u); }
#pragma unroll
        for (int j = 0; j < 6; ++j) { a[j][0] = siluf(a[j][0]); a[j][1] = siluf(a[j][1]); }
#pragma unroll
        for (int j = 0; j < 4; ++j) { xt[(128 * j + 2 * lane) * 72 + i] = f2bf(a[j][0]); xt[(128 * j + 2 * lane + 1) * 72 + i] = f2bf(a[j][1]); }
        *(LAS unsigned*)(lds + Q_BM + i * 272 + lane * 4) = pk(a[4][0], a[4][1]);
        bt[(2 * lane) * 72 + i] = f2bf(a[4][0]); bt[(2 * lane + 1) * 72 + i] = f2bf(a[4][1]);
        const unsigned cu = pk(a[5][0], a[5][1]);
        *(LAS unsigned*)(lds + Q_CM + i * 272 + lane * 4) = cu;
        *(unsigned*)(gblk + SG_CM + i * 272 + lane * 4) = cu;
    }
    __syncthreads();
    for (int tix = w; tix < 16; tix += 8) { const int mi = tix >> 2, nj = tix & 3;
        f32x4 cb = {0.f, 0.f, 0.f, 0.f};
        if (nj <= mi) {
#pragma unroll
            for (int s = 0; s < 4; ++s) cb = MFMA16(lda_nat(lds + Q_CM, 16 * mi + r, 272, 32 * s, q), lda_nat(lds + Q_BM, 16 * nj + r, 272, 32 * s, q), cb); }
#pragma unroll
        for (int hh = 0; hh < 8; ++hh) { const LAS float* ls = (const LAS float*)(lds + Q_END) + hh * 128; const float dj = ls[16 * nj + r], gj = ls[64 + 16 * nj + r], dk = dsk[g * 8 + hh];
            unsigned char* pb = hblk0 + (size_t)(hh >> 1) * 32 * 2 * SH_SIZE + (hh & 1) * SH_SIZE + SH_PP;
#pragma unroll
            for (int reg = 0; reg < 4; ++reg) { const int i = 16 * mi + 4 * q + reg, j = 16 * nj + r;
                float v = (j <= i) ? cb[reg] * __expf(ls[64 + i] - gj) * dj : 0.f; if (i == j) v += dk;
                *(bf16_t*)(pb + (i * 72 + j) * 2) = f2bf(v); } }
    }
    for (int idx = tid; idx < 1152; idx += 512) *(u32x4*)(gblk + SG_BT + idx * 16) = *(const LAS u32x4*)(lds + Q_BT + idx * 16);
    for (int idx = tid; idx < 4608; idx += 512) { const int hh = idx / 576, o = idx % 576;
        *(u32x4*)(hblk0 + (size_t)(hh >> 1) * 32 * 2 * SH_SIZE + (hh & 1) * SH_SIZE + SH_XT + o * 16) = *(const LAS u32x4*)(lds + Q_XT + idx * 16); }
    __syncthreads();
}
#define XB_T0(wid) ((wid) == 0 && __builtin_amdgcn_mbcnt_hi(~0u, __builtin_amdgcn_mbcnt_lo(~0u, 0u)) == 0u)
#define XB_TMO      128
#define XB_XCNT(j)  (256  + 64 * (j))
#define XB_XSUB(j)  (1280 + 64 * (j))
#define XB_XGEN(j)  (2304 + 64 * (j))
#define XB_TOP      3328
#define XB_TOPGEN   3392
#define XCD_BAR_WORDS 3456
#define XB_SPIN_CAP (1u << 18)

__device__ __forceinline__ unsigned xb_ld(unsigned* p)              { return __hip_atomic_load(p, __ATOMIC_RELAXED, __HIP_MEMORY_SCOPE_AGENT); }
__device__ __forceinline__ unsigned xb_add(unsigned* p, unsigned v) { return __hip_atomic_fetch_add(p, v, __ATOMIC_RELAXED, __HIP_MEMORY_SCOPE_AGENT); }
__device__ __forceinline__ unsigned xb_xcc_id() { return (unsigned)__builtin_amdgcn_s_getreg((3 << 11) | 20) & 0xFu; }
#define XB_SPIN(cond, bar) do { unsigned _sp = 0; while (cond) { __builtin_amdgcn_s_sleep(1); \
    if ((++_sp & 255u) == 0u) { if (xb_ld(&(bar)[XB_TMO])) break; if (_sp > XB_SPIN_CAP) { atomicAdd(&(bar)[XB_TMO], 1u); break; } } } } while (0)

struct XcdBarrier {
    unsigned* bar; unsigned x; int wid;
    volatile LAS unsigned* st;
};

__device__ __forceinline__ XcdBarrier xcd_barrier_post(unsigned* bar, volatile LAS unsigned* st, int wid) {
    XcdBarrier b; b.bar = bar; b.x = xb_xcc_id(); b.st = st; b.wid = wid;
    if (XB_T0(wid)) (void)xb_add(&bar[XB_XCNT(b.x)], 1u);
    return b;
}
__device__ __forceinline__ void xcd_barrier_complete(unsigned* bar, unsigned x, unsigned& nloc, unsigned& nx) {
    const unsigned G = gridDim.x * gridDim.y * gridDim.z;
    unsigned sum, cnt, mine, sp = 0u;
    for (;;) {
        sum = 0u; cnt = 0u; mine = 0u;
#pragma unroll
        for (unsigned j = 0; j < 16; ++j) { const unsigned c = xb_ld(&bar[XB_XCNT(j)]); sum += c; cnt += (c > 0u) ? 1u : 0u; mine = (j == x) ? c : mine; }
        if (sum == G) break;
        __builtin_amdgcn_s_sleep(1);
        if ((++sp & 255u) == 0u) { if (xb_ld(&bar[XB_TMO])) break; if (sp > XB_SPIN_CAP) { atomicAdd(&bar[XB_TMO], 1u); break; } }
    }
    nloc = mine > 0u ? mine : 1u; nx = cnt > 0u ? cnt : 1u;
}

__device__ __forceinline__ void xcd_barrier(const XcdBarrier& b) {
    asm volatile("s_waitcnt vmcnt(0)" ::: "memory");
    __syncthreads();
    if (XB_T0(b.wid)) {
        unsigned* bar = b.bar;
        __builtin_amdgcn_s_waitcnt(0);
        unsigned nloc = b.st[0], nx = b.st[1];
        if (nloc == 0u) { xcd_barrier_complete(bar, b.x, nloc, nx); b.st[0] = nloc; b.st[1] = nx; }
        const unsigned old = xb_add(&bar[XB_XSUB(b.x)], 1u);
        const unsigned gen = old / nloc;
        if (old + 1u == (gen + 1u) * nloc) {
            __builtin_amdgcn_fence(__ATOMIC_RELEASE, "agent");
            asm volatile("s_waitcnt vmcnt(0)" ::: "memory");
            const unsigned og = xb_add(&bar[XB_TOP], 1u);
            const unsigned tg = og / nx;
            if (og + 1u == (tg + 1u) * nx) xb_add(&bar[XB_TOPGEN], 1u);
            else XB_SPIN(xb_ld(&bar[XB_TOPGEN]) == tg, bar);
            __builtin_amdgcn_fence(__ATOMIC_ACQUIRE, "agent");
            xb_add(&bar[XB_XGEN(b.x)], 1u);
            asm volatile("s_waitcnt vmcnt(0)" ::: "memory");
        } else {
            XB_SPIN(xb_ld(&bar[XB_XGEN(b.x)]) == gen, bar);
            __builtin_amdgcn_fence(__ATOMIC_ACQUIRE, "agent");
            asm volatile("s_waitcnt vmcnt(0)" ::: "memory");
        }
    }
    __syncthreads();
}


#define PF_LOAD(pf, n, src, nvec) do { _Pragma("unroll") for (int _k = 0; _k < (n); ++_k) { const int _i = tid + _k * 512; if (_i < (nvec)) pf[_k] = ((const u32x4*)(src))[_i]; } } while (0)
#define PF_STORE(pf, n, nvec) do { _Pragma("unroll") for (int _k = 0; _k < (n); ++_k) { const int _i = tid + _k * 512; if (_i < (nvec)) ((LAS u32x4*)lds)[_i] = pf[_k]; } } while (0)

constexpr int GL_UT = 62464, GL_SC = 67072, GL_SIZE = 67136, GL_NV = GL_SIZE / 16;
constexpr int GS_SF = 2 * GL_SIZE, GS_DF = GS_SF + 8192;
static_assert(GS_DF + 4096 <= LDS_BYTES - 32, "GDN scan LDS budget");
DI void gdn_scan(LAS unsigned char* lds, const unsigned char* blk0, bf16_t* YRAW, int row0, int h, float* sout, int tid, const int vs) {
    asm volatile("" : "+v"(tid));
    const int lane = tid & 63, w = tid >> 6, r = lane & 15, q = lane >> 4, ct = w & 1, rg = w >> 1, v0 = 32 * vs + 16 * ct;
    f32x4 S0 = (f32x4){0.f, 0.f, 0.f, 0.f}, S1 = S0;
    u32x4 pfA[9], pfB[9];
#define GDN_LOAD(pf, cc) do { const u32x4* _s = (const u32x4*)(blk0 + (size_t)(cc) * GB_SIZE); _Pragma("unroll") for (int _k = 0; _k < 9; ++_k) { const int _i = tid + _k * 512; \
        if (_i < GL_NV) pf[_k] = _s[_i < 3904 ? _i : (_i < 4192 ? _i + vs * 288 : _i + 864)]; } } while (0)
#define GDN_STORE(pf, boff) do { _Pragma("unroll") for (int _k = 0; _k < 9; ++_k) { const int _i = tid + _k * 512; if (_i < GL_NV) ((LAS u32x4*)(lds + (boff)))[_i] = pf[_k]; } } while (0)
    GDN_LOAD(pfA, 0);
    GDN_STORE(pfA, 0);
    GDN_LOAD(pfA, 1); GDN_LOAD(pfB, 2);
    LAS u32x4* SF = (LAS u32x4*)(lds + GS_SF) + ct * 4 * 64;
    LAS unsigned char* DF = lds + GS_DF + ct * 2 * 1024;
    SF[rg * 64 + lane] = (u32x4){0u, 0u, 0u, 0u};
    __syncthreads();
    auto step = [&](auto BC, const int c, u32x4 (&pf)[9]) __attribute__((always_inline)) {
        constexpr int BUFC = decltype(BC)::value ? GL_SIZE : 0, BUFN = GL_SIZE - BUFC;
        const LAS unsigned char* bc = lds + BUFC;
        const float e = *(const LAS float*)(bc + GL_SC);
        const u32x2 uu = *(const LAS u32x2*)(bc + GL_UT + ((16 * ct + r) * 72 + 16 * rg + 4 * q) * 2);
        f32x4 Dl = (f32x4){bflo(uu.x), bfhi(uu.x), bflo(uu.y), bfhi(uu.y)}, Y = (f32x4){0.f, 0.f, 0.f, 0.f};
#pragma unroll
        for (int s = 0; s < 4; ++s) { const bf16x8 bs = __builtin_bit_cast(bf16x8, SF[s * 64 + lane]);
            Dl = MFMA16(lda_perm(bc + GB_NW, 16 * rg + r, 272, 32 * s, q), bs, Dl); Y = MFMA16(lda_perm(bc + GB_QG, 16 * rg + r, 272, 32 * s, q), bs, Y); }
        { u32x2 dd; dd.x = pk(Dl[0], Dl[1]); dd.y = pk(Dl[2], Dl[3]); *(LAS u32x2*)(DF + (rg >> 1) * 1024 + lane * 16 + (rg & 1) * 8) = dd; }
        __syncthreads();
        if (c + 1 < 32) GDN_STORE(pf, BUFN);
        if (c + 3 < 32) GDN_LOAD(pf, c + 3);
        S0 = S0 * e; S1 = S1 * e;
#pragma unroll
        for (int s2 = 0; s2 < 2; ++s2) { const bf16x8 bd = *(const LAS bf16x8*)(DF + s2 * 1024 + lane * 16);
            Y = MFMA16(lda_perm(bc + GB_P, 16 * rg + r, 144, 32 * s2, q), bd, Y);
            S0 = MFMA16(lda_perm(bc + GB_KDT, 16 * (2 * rg) + r, 144, 32 * s2, q), bd, S0);
            S1 = MFMA16(lda_perm(bc + GB_KDT, 16 * (2 * rg + 1) + r, 144, 32 * s2, q), bd, S1); }
#pragma unroll
        for (int reg = 0; reg < 4; ++reg) YRAW[(size_t)(row0 + c * 64 + 16 * rg + 4 * q + reg) * 2048 + h * 128 + v0 + r] = f2bf(Y[reg]);
        SF[rg * 64 + lane] = __builtin_bit_cast(u32x4, pack2(S0, S1));
        __syncthreads();
    };
#pragma nounroll
    for (int c = 0; c < 32; c += 2) { step(std::integral_constant<int, 0>{}, c, pfA); step(std::integral_constant<int, 1>{}, c + 1, pfB); }
#pragma unroll
    for (int reg = 0; reg < 4; ++reg) { sout[(16 * (2 * rg) + 4 * q + reg) * 128 + v0 + r] = S0[reg]; sout[(16 * (2 * rg + 1) + 4 * q + reg) * 128 + v0 + r] = S1[reg]; }
#undef GDN_LOAD
#undef GDN_STORE
}

DI void ret_scan(LAS unsigned char* lds, const unsigned char* blk0, bf16_t* YRAW, int row0, int h, float* sout, int tid) {
    asm volatile("" : "+v"(tid));
    const int lane = tid & 63, w = tid >> 6, r = lane & 15, q = lane >> 4, v0 = 16 * w;
    constexpr int RL = 46208;
    f32x4 S[4];
#pragma unroll
    for (int k = 0; k < 4; ++k) S[k] = (f32x4){0.f, 0.f, 0.f, 0.f};
    u32x4 pfA[6], pfB[6];
#define RET_STORE(pf, boff) do { _Pragma("unroll") for (int _k = 0; _k < 6; ++_k) { const int _i = tid + _k * 512; if (_i < RB_SIZE / 16) ((LAS u32x4*)(lds + (boff)))[_i] = pf[_k]; } } while (0)
    PF_LOAD(pfA, 6, blk0, RB_SIZE / 16);
    RET_STORE(pfA, 0);
    PF_LOAD(pfA, 6, blk0 + RB_SIZE, RB_SIZE / 16);
    PF_LOAD(pfB, 6, blk0 + 2 * (size_t)RB_SIZE, RB_SIZE / 16);
    __syncthreads();
    auto step = [&](auto BC, const int c, u32x4 (&pf)[6]) __attribute__((always_inline)) {
        constexpr int BUFC = decltype(BC)::value ? RL : 0, BUFN = RL - BUFC;
        const LAS unsigned char* bc = lds + BUFC;
        if (c + 1 < 32) RET_STORE(pf, BUFN);
        if (c + 3 < 32) PF_LOAD(pf, 6, blk0 + (size_t)(c + 3) * RB_SIZE, RB_SIZE / 16);
        const float e = *(const LAS float*)(bc + RB_SC);
        f32x4 Y[4];
#pragma unroll
        for (int m = 0; m < 4; ++m) Y[m] = (f32x4){0.f, 0.f, 0.f, 0.f};
#pragma unroll
        for (int s = 0; s < 2; ++s) { const bf16x8 bs = pack2(S[2 * s], S[2 * s + 1]);
#pragma unroll
            for (int m = 0; m < 4; ++m) Y[m] = MFMA16(lda_perm(bc + RB_QG, 16 * m + r, 144, 32 * s, q), bs, Y[m]); }
#pragma unroll
        for (int k = 0; k < 4; ++k) S[k] = S[k] * e;
#pragma unroll
        for (int s2 = 0; s2 < 2; ++s2) { const bf16x8 bv = lda_nat(bc + RB_VT, v0 + r, 144, 32 * s2, q);
#pragma unroll
            for (int m = 0; m < 4; ++m) Y[m] = MFMA16(lda_nat(bc + RB_P, 16 * m + r, 144, 32 * s2, q), bv, Y[m]);
#pragma unroll
            for (int k = 0; k < 4; ++k) S[k] = MFMA16(lda_nat(bc + RB_KDT, 16 * k + r, 144, 32 * s2, q), bv, S[k]); }
#pragma unroll
        for (int m = 0; m < 4; ++m)
#pragma unroll
            for (int reg = 0; reg < 4; ++reg) YRAW[(size_t)(row0 + c * 64 + 16 * m + 4 * q + reg) * 2048 + 512 + h * 128 + v0 + r] = f2bf(Y[m][reg]);
        __syncthreads();
    };
#pragma nounroll
    for (int c = 0; c < 32; c += 2) { step(std::integral_constant<int, 0>{}, c, pfA); step(std::integral_constant<int, 1>{}, c + 1, pfB); }
#pragma unroll
    for (int k = 0; k < 4; ++k)
#pragma unroll
        for (int reg = 0; reg < 4; ++reg) sout[(16 * k + 4 * q + reg) * 128 + v0 + r] = S[k][reg];
#undef RET_STORE
}

constexpr int SL_SIZE = SG_SIZE + SH_SIZE, SS_SF = 2 * SL_SIZE;
static_assert(SS_SF + 32768 <= LDS_BYTES - 32, "SSD scan LDS budget");
DI void ssd_scan(LAS unsigned char* lds, const unsigned char* gblk0, const unsigned char* hblk0, bf16_t* YRAW, int row0, int head, float* so, int tid) {
    asm volatile("" : "+v"(tid));
    const int lane = tid & 63, w = tid >> 6, r = lane & 15, q = lane >> 4, ct = w & 3, rh = w >> 2, p0 = 16 * ct;
    f32x4 S[4];
#pragma unroll
    for (int k = 0; k < 4; ++k) S[k] = (f32x4){0.f, 0.f, 0.f, 0.f};
    u32x4 pfA[7], pfB[7];
    constexpr int NG = SG_SIZE / 16, NV = NG + SH_SIZE / 16; static_assert(NV <= 7 * 512, "ssd staging");
#define SSD_LOAD(pf, cc) do { _Pragma("unroll") for (int _k = 0; _k < 7; ++_k) { const int _i = tid + _k * 512; if (_i < NG) pf[_k] = ((const u32x4*)(gblk0 + (size_t)(cc) * SG_SIZE))[_i]; \
        else if (_i < NV) pf[_k] = ((const u32x4*)(hblk0 + (size_t)(cc) * 2 * SH_SIZE))[_i - NG]; } } while (0)
#define SSD_STORE(pf, boff) do { _Pragma("unroll") for (int _k = 0; _k < 7; ++_k) { const int _i = tid + _k * 512; if (_i < NV) ((LAS u32x4*)(lds + (boff)))[_i] = pf[_k]; } } while (0)
    SSD_LOAD(pfA, 0);
    SSD_STORE(pfA, 0);
    SSD_LOAD(pfA, 1); SSD_LOAD(pfB, 2);
    LAS u32x4* SF = (LAS u32x4*)(lds + SS_SF) + ct * 4 * 64;
    SF[(2 * rh) * 64 + lane] = (u32x4){0u, 0u, 0u, 0u}; SF[(2 * rh + 1) * 64 + lane] = (u32x4){0u, 0u, 0u, 0u};
    __syncthreads();
    auto step = [&](auto BC, const int c, u32x4 (&pf)[7]) __attribute__((always_inline)) {
        constexpr int PAR = decltype(BC)::value, BUFC = PAR ? SL_SIZE : 0, BUFN = SL_SIZE - BUFC;
        const LAS unsigned char* bc = lds + BUFC;
        const LAS unsigned char* hd = bc + SG_SIZE;
        const LAS unsigned char* pp = hd + SH_PP;
        const LAS float* sx = (const LAS float*)(hd + SH_SC);
        LAS u32x4* SFc = SF + PAR * 1024; LAS u32x4* SFn = SF + (1 - PAR) * 1024;
        if (c + 1 < 32) SSD_STORE(pf, BUFN);
        if (c + 3 < 32) SSD_LOAD(pf, c + 3);
        const float e = sx[64 + 63];
        f32x4 Y[2];
#pragma unroll
        for (int mm = 0; mm < 2; ++mm) Y[mm] = (f32x4){0.f, 0.f, 0.f, 0.f};
#pragma unroll
        for (int s = 0; s < 4; ++s) { const bf16x8 bs = __builtin_bit_cast(bf16x8, SFc[s * 64 + lane]);
#pragma unroll
            for (int mm = 0; mm < 2; ++mm) Y[mm] = MFMA16(lda_perm(bc + SG_CM, 16 * (2 * rh + mm) + r, 272, 32 * s, q), bs, Y[mm]); }
#pragma unroll
        for (int mm = 0; mm < 2; ++mm)
#pragma unroll
            for (int reg = 0; reg < 4; ++reg) Y[mm][reg] *= sx[64 + 16 * (2 * rh + mm) + 4 * q + reg];
#pragma unroll
        for (int k = 0; k < 4; ++k) S[k] = S[k] * e;
#pragma unroll
        for (int s2 = 0; s2 < 2; ++s2) { const bf16x8 bx = lda_nat(hd + SH_XT, p0 + r, 144, 32 * s2, q);
#pragma unroll
            for (int mm = 0; mm < 2; ++mm) Y[mm] = MFMA16(lda_nat(pp, 16 * (2 * rh + mm) + r, 144, 32 * s2, q), bx, Y[mm]);
            const u32x4 xu = __builtin_bit_cast(u32x4, bx); u32x4 xs;
            const LAS float* wj = sx + 32 * s2 + 8 * q;
            xs.x = pk(bflo(xu.x) * wj[0], bfhi(xu.x) * wj[1]); xs.y = pk(bflo(xu.y) * wj[2], bfhi(xu.y) * wj[3]);
            xs.z = pk(bflo(xu.z) * wj[4], bfhi(xu.z) * wj[5]); xs.w = pk(bflo(xu.w) * wj[6], bfhi(xu.w) * wj[7]);
            const bf16x8 bx2 = __builtin_bit_cast(bf16x8, xs);
#pragma unroll
            for (int k = 0; k < 4; ++k) S[k] = MFMA16(lda_nat(bc + SG_BT, 16 * (4 * rh + k) + r, 144, 32 * s2, q), bx2, S[k]); }
#pragma unroll
        for (int mm = 0; mm < 2; ++mm)
#pragma unroll
            for (int reg = 0; reg < 4; ++reg) YRAW[(size_t)(row0 + c * 64 + 16 * (2 * rh + mm) + 4 * q + reg) * 2048 + head * 64 + p0 + r] = f2bf(Y[mm][reg]);
        SFn[(2 * rh) * 64 + lane] = __builtin_bit_cast(u32x4, pack2(S[0], S[1])); SFn[(2 * rh + 1) * 64 + lane] = __builtin_bit_cast(u32x4, pack2(S[2], S[3]));
        __syncthreads();
    };
#pragma nounroll
    for (int c = 0; c < 32; c += 2) { step(std::integral_constant<int, 0>{}, c, pfA); step(std::integral_constant<int, 1>{}, c + 1, pfB); }
#pragma unroll
    for (int k = 0; k < 4; ++k)
#pragma unroll
        for (int reg = 0; reg < 4; ++reg) so[(16 * (4 * rh + k) + 4 * q + reg) * 64 + p0 + r] = S[k][reg];
#undef SSD_LOAD
#undef SSD_STORE
}

constexpr int XB_STEAL = 3520;
DI int steal_unit(unsigned* ctr, LAS unsigned char* lds, int tid) {
    __syncthreads();
    if (tid == 0) *(LAS int*)(lds + LDS_BYTES - 32) = (int)__hip_atomic_fetch_add(ctr, 1u, __ATOMIC_RELAXED, __HIP_MEMORY_SCOPE_AGENT);
    __syncthreads();
    return *(const LAS int*)(lds + LDS_BYTES - 32);
}
DI void gdn_sample_unit(LAS unsigned char* lds, const Params& p, int li, int s, int h, int tid) {
    asm volatile("" : "+v"(tid));
    const int lane = tid & 63, w = tid >> 6, row = TP + s;
    const bf16_t* pr = (const bf16_t*)(p.ws + WS_PROJ) + (size_t)row * NH;
    LAS float* qkv = (LAS float*)lds; LAS float* red = qkv + 384;
    const float* cbuf = p.in[3] + (size_t)(li * 128 + s) * 3 * 1536; float* cout = p.out + O_SGC + (size_t)(li * 128 + s) * 3 * 1536;
    const float* cwp = p.in[11] + (size_t)li * 4 * 1536;
    if (tid < 384) { const int grp = tid >> 7, cl = tid & 127, ch = grp * 512 + h * 128 + cl;
        const float x = bf2f(pr[ch]), b0 = cbuf[ch], b1 = cbuf[1536 + ch], b2 = cbuf[3072 + ch];
        const float o = b0 * cwp[ch] + b1 * cwp[1536 + ch] + b2 * cwp[3072 + ch] + x * cwp[4608 + ch];
        qkv[tid] = siluf(o); cout[ch] = b1; cout[1536 + ch] = b2; cout[3072 + ch] = x; }
    __syncthreads();
    const float qa = qkv[2 * lane], qb = qkv[2 * lane + 1], ka = qkv[128 + 2 * lane], kb = qkv[128 + 2 * lane + 1];
    const float rq = rsqrtf(wsum(qa * qa + qb * qb) + 1e-6f) * 0.08838834764831845f, rk = rsqrtf(wsum(ka * ka + kb * kb) + 1e-6f);
    const float beta = 1.f / (1.f + __expf(-bf2f(pr[2048 + h])));
    const float g = -__expf(p.in[12][li * 4 + h]) * softplusf(bf2f(pr[2052 + h]) + p.in[13][li * 4 + h]);
    const float e = __expf(g);
    const size_t sidx = ((size_t)(li * 128 + s) * 4 + h) * 128 * 128;
    const float* Sin = p.in[2] + sidx; float* Sout = p.out + O_SGDN + sidx;
    f32x2 Sr[16]; float a0 = 0.f, a1 = 0.f;
#pragma unroll
    for (int rr = 0; rr < 16; ++rr) { Sr[rr] = __builtin_nontemporal_load((const f32x2*)(Sin + (16 * w + rr) * 128 + 2 * lane)) * e; const float kn = qkv[128 + 16 * w + rr] * rk; a0 += kn * Sr[rr][0]; a1 += kn * Sr[rr][1]; }
    red[w * 128 + 2 * lane] = a0; red[w * 128 + 2 * lane + 1] = a1;
    __syncthreads();
    a0 = 0.f; a1 = 0.f;
#pragma unroll
    for (int ww = 0; ww < 8; ++ww) { a0 += red[ww * 128 + 2 * lane]; a1 += red[ww * 128 + 2 * lane + 1]; }
    const float d0 = beta * (qkv[256 + 2 * lane] - a0), d1 = beta * (qkv[256 + 2 * lane + 1] - a1);
    __syncthreads();
    float y0 = 0.f, y1 = 0.f;
#pragma unroll
    for (int rr = 0; rr < 16; ++rr) { const float kn = qkv[128 + 16 * w + rr] * rk, qn = qkv[16 * w + rr] * rq;
        Sr[rr][0] += kn * d0; Sr[rr][1] += kn * d1; y0 += qn * Sr[rr][0]; y1 += qn * Sr[rr][1];
        __builtin_nontemporal_store(Sr[rr], (f32x2*)(Sout + (16 * w + rr) * 128 + 2 * lane)); }
    red[w * 128 + 2 * lane] = y0; red[w * 128 + 2 * lane + 1] = y1;
    __syncthreads();
    if (w == 0) { y0 = 0.f; y1 = 0.f;
#pragma unroll
        for (int ww = 0; ww < 8; ++ww) { y0 += red[ww * 128 + 2 * lane]; y1 += red[ww * 128 + 2 * lane + 1]; }
        *(unsigned*)((bf16_t*)(p.ws + WS_YRAW) + (size_t)row * 2048 + h * 128 + 2 * lane) = pk(y0, y1); }
    __syncthreads();
}
DI void ret_sample_unit(LAS unsigned char* lds, const Params& p, int li, int s, int h, int tid) {
    asm volatile("" : "+v"(tid));
    const int lane = tid & 63, w = tid >> 6, row = TP + s;
    const bf16_t* pr = (const bf16_t*)(p.ws + WS_PROJ) + (size_t)row * NH;
    LAS float* qk = (LAS float*)lds; LAS float* red = qk + 128;
    if (tid < 64) { const int f = tid & 31, which = tid >> 5, base = (which ? 2312 : 2056) + h * 64;
        const float x1 = bf2f(pr[base + f]), x2 = bf2f(pr[base + 32 + f]);
        float sn, cs; rot_sincos(16384.f, f, sn, cs);
        float o1 = x1 * cs - x2 * sn, o2 = x2 * cs + x1 * sn;
        if (which) { o1 *= 0.125f; o2 *= 0.125f; }
        qk[which * 64 + f] = o1; qk[which * 64 + 32 + f] = o2; }
    __syncthreads();
    const float gam = 1.f - exp2f(-5.f - (float)h);
    const unsigned vu = *(const unsigned*)(pr + 2568 + h * 128 + 2 * lane);
    const float va = bflo(vu), vb = bfhi(vu);
    const size_t sidx = ((size_t)(li * 128 + s) * 4 + h) * 64 * 128;
    const float* Sin = p.in[4] + sidx; float* Sout = p.out + O_SRET + sidx;
    float y0 = 0.f, y1 = 0.f;
#pragma unroll
    for (int rr = 0; rr < 8; ++rr) { const int k = 8 * w + rr; f32x2 sv = __builtin_nontemporal_load((const f32x2*)(Sin + k * 128 + 2 * lane)) * gam; const float kk = qk[64 + k], qq = qk[k];
        sv[0] += kk * va; sv[1] += kk * vb; y0 += qq * sv[0]; y1 += qq * sv[1]; __builtin_nontemporal_store(sv, (f32x2*)(Sout + k * 128 + 2 * lane)); }
    red[w * 128 + 2 * lane] = y0; red[w * 128 + 2 * lane + 1] = y1;
    __syncthreads();
    if (w == 0) { y0 = 0.f; y1 = 0.f;
#pragma unroll
        for (int ww = 0; ww < 8; ++ww) { y0 += red[ww * 128 + 2 * lane]; y1 += red[ww * 128 + 2 * lane + 1]; }
        *(unsigned*)((bf16_t*)(p.ws + WS_YRAW) + (size_t)row * 2048 + 512 + h * 128 + 2 * lane) = pk(y0, y1); }
    __syncthreads();
}
DI void ssd_sample_unit(LAS unsigned char* lds, const Params& p, int li, int s, int g, int tid) {
    asm volatile("" : "+v"(tid));
    const int lane = tid & 63, w = tid >> 6, row = TP + s, pq = lane & 15, nq = lane >> 4;
    const bf16_t* pr = (const bf16_t*)(p.ws + WS_PROJ) + (size_t)row * NS;
    LAS float* xs = (LAS float*)lds; LAS float* Bv = xs + 512; LAS float* Cv = xs + 640;
    const float* cbuf = p.in[6] + (size_t)(li * 128 + s) * 3 * 3072; float* cout = p.out + O_SSC + (size_t)(li * 128 + s) * 3 * 3072;
    const float* cwp = p.in[18] + (size_t)li * 4 * 3072; const float* cbp = p.in[19] + (size_t)li * 3072;
    const int head = g * 8 + w;
    const size_t sidx = ((size_t)(li * 128 + s) * 32 + head) * 128 * 64;
    const f32x4* Sin4 = (const f32x4*)(p.in[5] + sidx); f32x4* Sout4 = (f32x4*)(p.out + O_SSSM + sidx);
    f32x4 sb[2][8];
#pragma unroll
    for (int j = 0; j < 8; ++j) sb[0][j] = __builtin_nontemporal_load(Sin4 + j * 64 + lane);
    {
        float xv_[2], b0_[2], b1_[2], b2_[2], w_[2][5]; int ch_[2];
#pragma unroll
        for (int it = 0; it < 2; ++it) { const int t = tid + it * 512; const bool ok = t < 768; const int tc = ok ? t : 0;
            const int ch = tc < 512 ? g * 512 + tc : (tc < 640 ? 2048 + g * 128 + (tc - 512) : 2560 + g * 128 + (tc - 640)); ch_[it] = ch;
            xv_[it] = bf2f(pr[2048 + ch]); b0_[it] = cbuf[ch]; b1_[it] = cbuf[3072 + ch]; b2_[it] = cbuf[6144 + ch];
            w_[it][0] = cwp[ch]; w_[it][1] = cwp[3072 + ch]; w_[it][2] = cwp[6144 + ch]; w_[it][3] = cwp[9216 + ch]; w_[it][4] = cbp[ch]; }
#pragma unroll
        for (int it = 0; it < 2; ++it) { const int t = tid + it * 512; if (t < 768) { const int ch = ch_[it];
            const float o = w_[it][4] + b0_[it] * w_[it][0] + b1_[it] * w_[it][1] + b2_[it] * w_[it][2] + xv_[it] * w_[it][3];
            xs[t] = siluf(o); cout[ch] = b1_[it]; cout[3072 + ch] = b2_[it]; cout[6144 + ch] = xv_[it]; } }
    }
    __syncthreads();
    const float dt = softplusf(bf2f(pr[5120 + head]) + p.in[20][li * 32 + head]);
    const float e = __expf(-__expf(p.in[21][li * 32 + head]) * dt);
    const f32x4 xv = *(const LAS f32x4*)(xs + w * 64 + 4 * pq), xd = xv * dt;
    f32x4 y = (f32x4){0.f, 0.f, 0.f, 0.f};
#pragma unroll
    for (int b = 0; b < 4; ++b) {
        if (b < 3) {
#pragma unroll
            for (int j = 0; j < 8; ++j) sb[(b + 1) & 1][j] = __builtin_nontemporal_load(Sin4 + ((b + 1) * 8 + j) * 64 + lane); }
#pragma unroll
        for (int j = 0; j < 8; ++j) { const int n = 4 * (b * 8 + j) + nq; const f32x4 v = sb[b & 1][j] * e + xd * Bv[n]; y = y + v * Cv[n]; __builtin_nontemporal_store(v, Sout4 + (b * 8 + j) * 64 + lane); }
    }
#pragma unroll
    for (int j = 0; j < 4; ++j) { y[j] += __shfl_xor(y[j], 16); y[j] += __shfl_xor(y[j], 32); }
    y = y + xv * p.in[22][li * 32 + head];
    if (nq == 0) { u32x2 o; o.x = pk(y[0], y[1]); o.y = pk(y[2], y[3]); *(u32x2*)((bf16_t*)(p.ws + WS_YRAW) + (size_t)row * 2048 + head * 64 + 4 * pq) = o; }
    __syncthreads();
}

DI void gate_hyb(const Params& p, int li, int gw, int ngw, int lane) {
    const bf16_t* YR = (const bf16_t*)(p.ws + WS_YRAW); const bf16_t* PROJ = (const bf16_t*)(p.ws + WS_PROJ); bf16_t* MIX = (bf16_t*)(p.ws + WS_MIX);
    const int cl = 8 * (lane & 15), h = lane >> 4;
    f32x4 ga[2], ra[2];
    ga[0] = *(const f32x4*)(p.in[14] + li * 128 + cl); ga[1] = *(const f32x4*)(p.in[14] + li * 128 + cl + 4);
    ra[0] = *(const f32x4*)(p.in[15] + li * 512 + h * 128 + cl); ra[1] = *(const f32x4*)(p.in[15] + li * 512 + h * 128 + cl + 4);
    for (int it0 = gw * 2; it0 < TR * 2; it0 += ngw * 2) {
        u32x4 ya[2], za[2];
#pragma unroll
        for (int rr = 0; rr < 2; ++rr) { const int it = it0 + rr, m = it >> 1, half = it & 1;
            ya[rr] = __builtin_nontemporal_load((const u32x4*)(YR + (size_t)m * 2048 + half * 512 + h * 128 + cl));
            za[rr] = __builtin_nontemporal_load((const u32x4*)(PROJ + (size_t)m * NH + (half ? 3080 : 1536) + h * 128 + cl)); }
#pragma unroll
        for (int rr = 0; rr < 2; ++rr) { const int it = it0 + rr, m = it >> 1, half = it & 1;
            const unsigned yu[4] = {ya[rr].x, ya[rr].y, ya[rr].z, ya[rr].w}, zu[4] = {za[rr].x, za[rr].y, za[rr].z, za[rr].w};
            float v[8], z[8]; float s1 = 0.f;
#pragma unroll
            for (int j = 0; j < 4; ++j) { v[2 * j] = bflo(yu[j]); v[2 * j + 1] = bfhi(yu[j]); z[2 * j] = bflo(zu[j]); z[2 * j + 1] = bfhi(zu[j]); s1 += v[2 * j] + v[2 * j + 1]; }
            float mean = 0.f;
            if (half) { s1 += __shfl_xor(s1, 1); s1 += __shfl_xor(s1, 2); s1 += __shfl_xor(s1, 4); s1 += __shfl_xor(s1, 8); mean = s1 * (1.f / 128.f); }
            float ss = 0.f;
#pragma unroll
            for (int j = 0; j < 8; ++j) { v[j] -= mean; ss += v[j] * v[j]; }
            ss += __shfl_xor(ss, 1); ss += __shfl_xor(ss, 2); ss += __shfl_xor(ss, 4); ss += __shfl_xor(ss, 8);
            const float rs = rsqrtf(ss * (1.f / 128.f) + 1e-6f);
            float o[8];
#pragma unroll
            for (int j = 0; j < 8; ++j) { const float gn = half ? ra[j >> 2][j & 3] : ga[j >> 2][j & 3]; o[j] = v[j] * rs * gn * siluf(z[j]); }
            u32x4 w; w.x = pk(o[0], o[1]); w.y = pk(o[2], o[3]); w.z = pk(o[4], o[5]); w.w = pk(o[6], o[7]);
            *(u32x4*)(MIX + (size_t)m * 1024 + half * 512 + h * 128 + cl) = w; }
    }
    for (int idx = gw * 64 + lane; idx < 8 * 3 * 1536; idx += ngw * 64) { const int ch = idx % 1536, rr = (idx / 1536) % 3, b = idx / (3 * 1536);
        p.out[O_PGC + (size_t)(li * 8 + b) * 3 * 1536 + rr * 1536 + ch] = bf2f(PROJ[(size_t)(b * SEQ + SEQ - 3 + rr) * NH + ch]); }
}
DI void gate_ssm(const Params& p, int li, int gw, int ngw, int lane) {
    const bf16_t* YR = (const bf16_t*)(p.ws + WS_YRAW); const bf16_t* PROJ = (const bf16_t*)(p.ws + WS_PROJ); bf16_t* MIX = (bf16_t*)(p.ws + WS_MIX);
    const float* nw = p.in[23] + li * 2048;
    for (int m = gw; m < TR; m += ngw) {
        const bf16_t* yr = YR + (size_t)m * 2048; const bf16_t* pr = PROJ + (size_t)m * NS; bf16_t* mx = MIX + (size_t)m * 2048;
        u32x4 ua[4], za[4];
#pragma unroll
        for (int g = 0; g < 4; ++g) { ua[g] = __builtin_nontemporal_load((const u32x4*)(yr + g * 512 + 8 * lane)); za[g] = __builtin_nontemporal_load((const u32x4*)(pr + g * 512 + 8 * lane)); }
#pragma unroll
        for (int g = 0; g < 4; ++g) {
            const u32x4 u = ua[g], z = za[g];
            float v[8]; const unsigned uu[4] = {u.x, u.y, u.z, u.w}, zz[4] = {z.x, z.y, z.z, z.w}; float ss = 0.f;
#pragma unroll
            for (int j = 0; j < 4; ++j) { v[2 * j] = bflo(uu[j]) * siluf(bflo(zz[j])); v[2 * j + 1] = bfhi(uu[j]) * siluf(bfhi(zz[j])); ss += v[2 * j] * v[2 * j] + v[2 * j + 1] * v[2 * j + 1]; }
            const float rs = rsqrtf(wsum(ss) * (1.f / 512.f) + 1e-6f);
            const f32x4 w0 = *(const f32x4*)(nw + g * 512 + 8 * lane), w1 = *(const f32x4*)(nw + g * 512 + 8 * lane + 4);
            u32x4 o; o.x = pk(v[0] * rs * w0[0], v[1] * rs * w0[1]); o.y = pk(v[2] * rs * w0[2], v[3] * rs * w0[3]); o.z = pk(v[4] * rs * w1[0], v[5] * rs * w1[1]); o.w = pk(v[6] * rs * w1[2], v[7] * rs * w1[3]);
            *(u32x4*)(mx + g * 512 + 8 * lane) = o;
        }
    }
    for (int idx = gw * 64 + lane; idx < 8 * 3 * 3072; idx += ngw * 64) { const int ch = idx % 3072, rr = (idx / 3072) % 3, b = idx / (3 * 3072);
        p.out[O_PSC + (size_t)(li * 8 + b) * 3 * 3072 + rr * 3072 + ch] = bf2f(PROJ[(size_t)(b * SEQ + SEQ - 3 + rr) * NS + 2048 + ch]); }
}

struct EpiBR {
    static constexpr bool PERM = true, AFTER_DRAIN = false;
    bf16_t* O; int ldc; int act;
    DI void operator()(const f32x4 (&acc)[2][2][4][2], const pg8::Unit& u, int wr, int wc, int fr, int fq) const {
        const int row0 = u.pm * 256 + wr * 64 + fr, col0 = u.pn * 256 + wc * 32 + 8 * fq;
#pragma unroll
        for (int ai = 0; ai < 2; ++ai)
#pragma unroll
            for (int m = 0; m < 4; ++m) { bf16_t* rowp = O + (size_t)(row0 + ai * 128 + m * 16) * ldc + col0;
#pragma unroll
                for (int bj = 0; bj < 2; ++bj) { f32x4 v0 = acc[ai][bj][m][0], v1 = acc[ai][bj][m][1];
                    if (act) {
#pragma unroll
                        for (int j = 0; j < 4; ++j) { const float a = fmaxf(v0[j], 0.f), b = fmaxf(v1[j], 0.f); v0[j] = a * a; v1[j] = b * b; } }
                    u32x4 w; w.x = pk(v0[0], v0[1]); w.y = pk(v0[2], v0[3]); w.z = pk(v1[0], v1[1]); w.w = pk(v1[2], v1[3]);
                    *(u32x4*)(rowp + bj * 128) = w; } }
    }
};
template <int EPI> DI void skinny_tile(LAS unsigned char* lds, const bf16_t* A, const bf16_t* Bt, const int Kext, void* outp, const int ldc, int tid, const int lda = 0) {
    asm volatile("" : "+v"(tid));
    const int lane = tid & 63, w = tid >> 6, r = lane & 15, q = lane >> 4;
    const int K = lda ? lda : Kext;
    constexpr int kw = 128; (void)Kext;
    f32x4 acc[8];
#pragma unroll
    for (int m = 0; m < 8; ++m) acc[m] = (f32x4){0.f, 0.f, 0.f, 0.f};
    const bf16_t* ap = A + (size_t)r * K + w * kw + 8 * q; const bf16_t* bp = Bt + (size_t)r * K + w * kw + 8 * q;
#pragma unroll
    for (int k0 = 0; k0 < kw; k0 += 32) {
        const bf16x8 b = *(const bf16x8*)(bp + k0);
#pragma unroll
        for (int m = 0; m < 8; ++m) acc[m] = MFMA16(*(const bf16x8*)(ap + (size_t)(16 * m) * K + k0), b, acc[m]);
    }
    LAS float* part = (LAS float*)lds;
#pragma unroll
    for (int m = 0; m < 8; ++m)
#pragma unroll
        for (int reg = 0; reg < 4; ++reg) part[(w * 128 + 16 * m + 4 * q + reg) * 16 + r] = acc[m][reg];
    __syncthreads();
    const int row = tid >> 2, c4 = (tid & 3) * 4;
    f32x4 sum = (f32x4){0.f, 0.f, 0.f, 0.f};
#pragma unroll
    for (int ww = 0; ww < 8; ++ww) sum = sum + *(const LAS f32x4*)(part + (ww * 128 + row) * 16 + c4);
    if (EPI == 2) { f32x4* o = (f32x4*)((float*)outp + (size_t)row * ldc + c4); *o = *o + sum; }
    else if (EPI == 3) { float* o = (float*)outp + (size_t)row * ldc + c4;
#pragma unroll
        for (int j = 0; j < 4; ++j) (void)__hip_atomic_fetch_add(o + j, sum[j], __ATOMIC_RELAXED, __HIP_MEMORY_SCOPE_AGENT); }
    else { if (EPI == 1) {
#pragma unroll
            for (int j = 0; j < 4; ++j) { const float a = fmaxf(sum[j], 0.f); sum[j] = a * a; } }
        u32x2 o; o.x = pk(sum[0], sum[1]); o.y = pk(sum[2], sum[3]); *(u32x2*)((bf16_t*)outp + (size_t)row * ldc + c4) = o; }
    __syncthreads();
}

template <int KIND, bool hyb> DI void run_phase(const Params& P, LAS unsigned char* lds, const int L, const int tid, const int bid, const int G) {
    const int lane = tid & 63, wv = tid >> 6, gw = bid * 8 + wv, ngw = G * 8, li = L >> 1;
    unsigned char* ws = P.ws;
    bf16_t* H = (bf16_t*)(ws + WS_H); bf16_t* PROJ = (bf16_t*)(ws + WS_PROJ); bf16_t* YRAW = (bf16_t*)(ws + WS_YRAW); bf16_t* MIX = (bf16_t*)(ws + WS_MIX); bf16_t* ACT = (bf16_t*)(ws + WS_ACT);
    float* X = (float*)(ws + WS_X);
    if constexpr (KIND == 0) prologue(P, lds, gw, ngw, wv, lane);
    if constexpr (KIND == 1) norm_rows(P, P.in[7] + L * D, L == 0, gw, ngw, lane);
    if constexpr (KIND == 7) norm_rows(P, P.in[8] + L * D, false, gw, ngw, lane);
    if constexpr (KIND == 2 || KIND == 8) {
        constexpr bool up = KIND == 8;
        const bf16_t* Bt = up ? (const bf16_t*)(ws + WS_W1) + (size_t)L * FF * 1024 : (hyb ? (const bf16_t*)(ws + WS_WINH) + (size_t)li * NH * 1024 : (const bf16_t*)(ws + WS_WINS) + (size_t)li * NS * 1024);
        constexpr int N = up ? FF : (hyb ? NH : NS), NMAIN = up ? FF : (hyb ? NH : 5120);
        pg8::Gemm g{H, Bt, TP, NMAIN, 1024}; pg8::StaticOrder S; S.init(TP, NMAIN, G, bid); EpiB<up ? 1 : 0> E{up ? ACT : PROJ, N};
        pg8::gemm_phase<EpiB<up ? 1 : 0>, pg8::StaticOrder>((PG8_LAS unsigned char*)lds, g, S, E, nullptr, tid);
        constexpr int NCB = up ? FF / 16 : (hyb ? (NHR + 15) / 16 : NSR / 16);
        constexpr int NT = NCB + ((!up && !hyb) ? 256 : 0);
        const int nw = (!up && hyb) ? 64 : G;
        const int first = G - 1 - bid;
        if (first < nw) {
#pragma nounroll
            for (int t = first; t < NT; t += nw) {
                if (t < NCB) skinny_tile<up ? 1 : 0>(lds, H + (size_t)TP * 1024, Bt + (size_t)t * 16 * 1024, 1024, (up ? ACT : PROJ) + (size_t)TP * N + t * 16, N, tid);
                else { const int t2 = t - NCB, rb = t2 >> 1, cb = t2 & 1;
                    skinny_tile<0>(lds, H + (size_t)rb * 128 * 1024, Bt + (size_t)(5120 + cb * 16) * 1024, 1024, PROJ + (size_t)rb * 128 * N + 5120 + cb * 16, N, tid); }
            }
        }
    }
    if constexpr (KIND == 6 || KIND == 9) {
        constexpr bool dn = KIND == 9;
        const bf16_t* Bt = dn ? (const bf16_t*)(ws + WS_W2) + (size_t)L * 1024 * FF : (hyb ? (const bf16_t*)(ws + WS_WOUTH) + (size_t)li * 1024 * 1024 : (const bf16_t*)(ws + WS_WOUTS) + (size_t)li * 1024 * 2048);
        constexpr int K = dn ? FF : (hyb ? 1024 : 2048);
        pg8::Gemm g{dn ? ACT : MIX, Bt, TP, 1024, K}; pg8::StaticOrder S; S.init(TP, 1024, G, bid); EpiRes E{(bf16_t*)(ws + WS_X)};
        pg8::gemm_phase<EpiRes, pg8::StaticOrder>((PG8_LAS unsigned char*)lds, g, S, E, nullptr, tid);
        const int first = G - 1 - bid;
        constexpr int KS = K / 1024;
#pragma nounroll
        for (int t = first; t < 64 * KS; t += G) { const int ct = t / KS, ks = t % KS;
            skinny_tile<3>(lds, (dn ? ACT : MIX) + (size_t)TP * K + ks * 1024, Bt + (size_t)ct * 16 * K + ks * 1024, 1024, (float*)(ws + WS_XS) + ct * 16, 1024, tid, K); }
    }
    if constexpr (KIND == 3) {
        if constexpr (hyb) {
#pragma nounroll
            for (int u = bid; u < 1024; u += G) { const int b = u >> 7, c = (u >> 2) & 31, h = u & 3;
                gdn_prep_unit(lds, PROJ, P.in[11] + (size_t)li * 4 * 1536, P.in[12][li * 4 + h], P.in[13][li * 4 + h], ws + WS_CHK + CHK_GDN + (size_t)((b * 4 + h) * 32 + c) * GB_SIZE, b * SEQ + c * 64, h, tid); }
#ifdef PROBE_GDNPREP
#pragma nounroll
            for (int u = bid; u < 1024; u += G) { const int b = u >> 7, c = (u >> 2) & 31, h = u & 3;
                gdn_prep_unit(lds, PROJ, P.in[11] + (size_t)li * 4 * 1536, P.in[12][li * 4 + h], P.in[13][li * 4 + h], ws + WS_CHK + CHK_GDN + (size_t)((b * 4 + h) * 32 + c) * GB_SIZE, b * SEQ + c * 64, h, tid); }
#endif
#pragma nounroll
            for (int u2 = bid; u2 < 1024; u2 += G) { const int b = u2 >> 7, c = (u2 >> 2) & 31, h = u2 & 3;
                ret_prep_unit(lds, PROJ, ws + WS_CHK + CHK_RET + (size_t)((b * 4 + h) * 32 + c) * RB_SIZE, b * SEQ + c * 64, h, tid); }
        } else {
            for (int u = bid; u < 1024; u += G) { const int b = u >> 7, c = (u >> 2) & 31, g = u & 3;
                ssd_prep_unit(lds, PROJ, P.in[18] + (size_t)li * 4 * 3072, P.in[19] + (size_t)li * 3072, P.in[20] + li * 32, P.in[21] + li * 32, P.in[22] + li * 32,
                              ws + WS_CHK + CHK_SG + (size_t)((b * 4 + g) * 32 + c) * SG_SIZE, ws + WS_CHK + CHK_SH + (size_t)(((b * 16 + 4 * g) * 32 + c) * 2) * SH_SIZE, b * SEQ + c * 64, g, tid); }
        }
    }
    if constexpr (KIND == 4) {
        if constexpr (hyb) {
            if (bid < 128) { const int bh = bid >> 2, b = bh >> 2, h = bh & 3;
                gdn_scan(lds, ws + WS_CHK + CHK_GDN + (size_t)((b * 4 + h) * 32) * GB_SIZE, YRAW, b * SEQ, h, P.out + O_PGDN + (size_t)((li * 8 + b) * 4 + h) * 128 * 128, tid, bid & 3); }
            else if (bid < 160) { const int b = (bid - 128) >> 2, h = bid & 3;
                ret_scan(lds, ws + WS_CHK + CHK_RET + (size_t)((b * 4 + h) * 32) * RB_SIZE, YRAW, b * SEQ, h, P.out + O_PRET + (size_t)((li * 8 + b) * 4 + h) * 64 * 128, tid); }
            for (;;) { const int u = steal_unit((unsigned*)(ws + WS_BAR) + XB_STEAL + 64 * L, lds, tid); if (u >= 1024) break;
                if (u < 512) gdn_sample_unit(lds, P, li, u >> 2, u & 3, tid); else ret_sample_unit(lds, P, li, (u - 512) >> 2, u & 3, tid); }
        } else {
#pragma nounroll
            for (int unit = bid; unit < 256; unit += G) { const int b = unit >> 5, head = unit & 31, g = head >> 3, u = head >> 1;
                ssd_scan(lds, ws + WS_CHK + CHK_SG + (size_t)((b * 4 + g) * 32) * SG_SIZE, ws + WS_CHK + CHK_SH + (size_t)(((b * 16 + u) * 32) * 2 + (head & 1)) * SH_SIZE, YRAW, b * SEQ, head,
                         P.out + O_PSSM + (size_t)((li * 8 + b) * 32 + head) * 128 * 64, tid); }
            for (;;) { const int u = steal_unit((unsigned*)(ws + WS_BAR) + XB_STEAL + 64 * L, lds, tid); if (u >= 512) break; ssd_sample_unit(lds, P, li, u >> 2, u & 3, tid); }
        }
    }
    if constexpr (KIND == 5) { if constexpr (hyb) gate_hyb(P, li, gw, ngw, lane); else gate_ssm(P, li, gw, ngw, lane); }
    if constexpr (KIND == 10) final_norm(P, gw, ngw, lane);
}
constexpr int LDS_ST = LDS_BYTES - 16;
template <int PH> DI void do_phase(const Params& p, cg::grid_group& grid, const int wid_s) {
    constexpr int kind = PH == 37 ? 10 : (PH == 0 ? 0 : 1 + (PH - 1) % 9), L = (PH == 0 || PH == 37) ? 0 : (PH - 1) / 9;
    constexpr bool hyb = (L & 1) == 0, hsel = (kind == 2 || kind == 3 || kind == 4 || kind == 5 || kind == 6) ? hyb : true;
    extern __shared__ __attribute__((aligned(16))) unsigned char smem[];
    int tid; asm volatile("v_mbcnt_lo_u32_b32 %0, -1, 0\n\tv_mbcnt_hi_u32_b32 %0, -1, %0" : "=v"(tid)); tid += wid_s * 64;
    unsigned lbase = 0; asm volatile("" : "+v"(lbase));
    LAS unsigned char* lds = (LAS unsigned char*)smem + lbase;
    int bid = blockIdx.x; asm volatile("" : "+s"(bid));
    int Gr = (int)gridDim.x; asm volatile("" : "+s"(Gr));
    run_phase<kind, hsel>(p, lds, L, tid, bid, Gr);
#ifdef PROBE_DUP
    if constexpr ((((PROBE_DUP) >> kind) & 1) && (PROBE_HYB == 2 || (PROBE_HYB == 1) == hyb)) { __syncthreads(); asm volatile("" : "+v"(tid)); run_phase<kind, hsel>(p, lds, L, tid, bid, Gr); }
#endif
    if (PH == 0) grid.sync();
    else if (PH < 37) { XcdBarrier b; b.bar = (unsigned*)(p.ws + WS_BAR); b.x = xb_xcc_id(); b.wid = wid_s; b.st = (volatile LAS unsigned*)((LAS unsigned char*)smem + LDS_ST); xcd_barrier(b); }
}
template <int... PH> DI void all_phases(const Params& p, cg::grid_group& grid, const int wid_s, std::integer_sequence<int, PH...>) { (do_phase<PH>(p, grid, wid_s), ...); }
__global__ void __launch_bounds__(512, 2) fwd_megakernel(Params p) {
    extern __shared__ __attribute__((aligned(16))) unsigned char smem[];
    cg::grid_group grid = cg::this_grid();
    const int wid_s = __builtin_amdgcn_readfirstlane(threadIdx.x >> 6);
    if (threadIdx.x == 0) { volatile LAS unsigned* st = (volatile LAS unsigned*)((LAS unsigned char*)smem + LDS_ST); st[0] = 0u; st[1] = 0u; }
    __syncthreads();
    (void)xcd_barrier_post((unsigned*)(p.ws + WS_BAR), (volatile LAS unsigned*)((LAS unsigned char*)smem + LDS_ST), wid_s);
    all_phases(p, grid, wid_s, std::make_integer_sequence<int, 38>{});
}

extern "C" void kernel_launch(void* const* d_in, const int* in_sizes, int n_in, void* d_out, int out_size, void* d_ws, size_t ws_size, hipStream_t stream) {
    static int grid = 0;
    if (grid == 0) {
        if (n_in != 27 || ws_size < WS_END) { fprintf(stderr, "kernel_launch: bad inputs n_in=%d ws=%zu need %zu\n", n_in, ws_size, (size_t)WS_END); grid = -1; return; }
        int dev = 0, cus = 0, per_cu = 0;
        (void)hipGetDevice(&dev); (void)hipDeviceGetAttribute(&cus, hipDeviceAttributeMultiprocessorCount, dev);
        if (hipFuncSetAttribute((const void*)fwd_megakernel, hipFuncAttributeMaxDynamicSharedMemorySize, LDS_BYTES) != hipSuccess) { fprintf(stderr, "kernel_launch: hipFuncSetAttribute failed\n"); grid = -1; return; }
        (void)hipOccupancyMaxActiveBlocksPerMultiprocessor(&per_cu, (const void*)fwd_megakernel, 512, LDS_BYTES);
        if (per_cu < 1) { fprintf(stderr, "kernel_launch: occupancy query says %d blocks/CU\n", per_cu); per_cu = 1; }
        (void)hipGetLastError();
        grid = cus;
        if (grid < 192) fprintf(stderr, "kernel_launch: only %d CUs\n", grid);
    }
    if (grid < 0) return;
    Params p{};
    for (int i = 0; i < 27; ++i) p.in[i] = (const float*)d_in[i];
    p.out = (float*)d_out; p.ws = (unsigned char*)d_ws; p.ph_lo = 0; p.ph_hi = 38;
    if (hipMemsetAsync((char*)d_ws + WS_BAR, 0, 16384, stream) != hipSuccess) { fprintf(stderr, "kernel_launch: memset failed\n"); return; }
    void* args[] = {&p};
    hipError_t e = hipLaunchCooperativeKernel((const void*)fwd_megakernel, dim3(grid), dim3(512), args, LDS_BYTES, stream);
    if (e != hipSuccess) fprintf(stderr, "cooperative launch failed: %s (grid %d)\n", hipGetErrorString(e), grid);
}
```

```cpp
#include <hip/hip_runtime.h>
#include <hip/hip_cooperative_groups.h>
#include <cstdio>
#include <utility>
namespace cg = cooperative_groups;
namespace pg8 {
#define PG8_LAS __attribute__((address_space(3)))
typedef unsigned short bf16_t;
typedef short bf16x8 __attribute__((ext_vector_type(8)));
typedef float f32x4 __attribute__((ext_vector_type(4)));
typedef unsigned u32x4 __attribute__((ext_vector_type(4)));
constexpr int BM = 256, BK = 64, HALF = 128, HTB = HALF * BK * 2  , STAGE_BYTES = 8 * HTB, NXCD = 8, WGM = 8;

__host__ __device__ __forceinline__ int lds_byte(int r, int c) { const int st = (r >> 4) * 2 + (c >> 5), rr = r & 15, cc = c & 31, ob = rr * 64 + cc * 2; return st * 1024 + (ob ^ (((ob >> 9) & 1) << 5)); }
__host__ __device__ __forceinline__ void stage_rc(int b, int& R, int& C) { const int st = b / 1024, sb = b % 1024, swz = sb ^ (((sb >> 9) & 1) << 5); R = (st >> 1) * 16 + swz / 64; C = (st & 1) * 32 + (swz % 64) / 2; }
__host__ __device__ __forceinline__ int perm32(int rho) { const int n = rho >> 4, i = rho & 15; return 8 * (i >> 2) + 4 * n + (i & 3); }

struct Unit { int pm, pn; };
struct Gemm { const bf16_t* A; const bf16_t* Bt; int M, N, K; };

struct StaticOrder {
    int nM, nN, nwg, G, c;
    __host__ __device__ void init(int M, int N, int G_, int c_) { nM = M / BM; nN = N / BM; nwg = nM * nN; G = G_; c = c_; }
    __host__ __device__ bool next(int i, Unit& u) const {
        const long L = (long)i * G + c; if (L >= nwg) return false;
        int wgid = (int)L; { const int q = nwg / NXCD, r = nwg % NXCD, xcd = wgid % NXCD, off = wgid / NXCD; wgid = (xcd < r ? xcd * (q + 1) : r * (q + 1) + (xcd - r) * q) + off; }
        const int nig = WGM * nN, gid = wgid / nig, fm = gid * WGM, gsz = (nM - fm) < WGM ? (nM - fm) : WGM;
        u.pm = fm + ((wgid % nig) % gsz); u.pn = (wgid % nig) / gsz; return true;
    }
    __device__ __forceinline__ void a_ready(const Unit&) const {}
    __device__ __forceinline__ void done(const Unit&) const {}
};
template <class Epi, class Sched, bool STAMP = false>
__device__ __forceinline__ void gemm_phase(PG8_LAS unsigned char* lds, const Gemm g, const Sched& S, const Epi& E, unsigned long long* stamps, const int tid_in) {
    const int tid = tid_in, wid = __builtin_amdgcn_readfirstlane(tid >> 6), lane = tid & 63, wr = wid >> 2, wc = wid & 3, fr = lane & 15, fq = lane >> 4;
    const int K = g.K, nt = K / BK;
    int ts_lo = 0, ts_hi = 0, nts = 0; const unsigned long long rt_entry = STAMP ? (unsigned long long)wall_clock64() : 0ull;
#define PG8_STAMP() do { if (STAMP && wid == 0 && nts < 64) { const unsigned long long _c = (unsigned long long)clock64(); \
        ts_lo = (lane == nts) ? (int)(unsigned)_c : ts_lo; ts_hi = (lane == nts) ? (int)(unsigned)(_c >> 32) : ts_hi; ++nts; } } while (0)
    PG8_STAMP();
    unsigned voffA[2], voffB[2];
#pragma unroll
    for (int i = 0; i < 2; ++i) { int R, C; stage_rc(tid * 16 + i * 8192, R, C); const int Rb = Epi::PERM ? ((R & ~31) + perm32(R & 31)) : R;
        voffA[i] = (unsigned)(R * K + C) * 2u; voffB[i] = (unsigned)(Rb * K + C) * 2u; }
    const size_t kstep = (size_t)(BK * 2);
    const size_t hstep = (size_t)HALF * K * 2;
    const size_t tstep = 2 * hstep;
    const unsigned ldsw = (unsigned)wid * 1024u;
    const int aoff = lds_byte(wr * 64 + fr, fq * 8), boff = lds_byte(wc * 32 + fr, fq * 8);
#define PG8_SA(b, h) (((b) * 2 + (h)) * HTB)
#define PG8_SB(b, h) ((4 + (b) * 2 + (h)) * HTB)
#define PG8_STAGE(bufoff, gbase, voff) do { _Pragma("unroll") for (int _i = 0; _i < 2; ++_i) \
        __builtin_amdgcn_global_load_lds((const unsigned*)((const char*)(gbase) + (voff)[_i]), (PG8_LAS unsigned*)(lds + (bufoff) + ldsw + _i * 8192), 16, 0, 0); } while (0)
#define PG8_LDA(dst, b, h) do { _Pragma("unroll") for (int m = 0; m < 4; ++m) _Pragma("unroll") for (int k = 0; k < 2; ++k) dst[m][k] = *(const PG8_LAS bf16x8*)(lds + PG8_SA(b, h) + aoff + m * 2048 + k * 1024); } while (0)
#define PG8_LDB(dst, b, h) do { _Pragma("unroll") for (int n = 0; n < 2; ++n) _Pragma("unroll") for (int k = 0; k < 2; ++k) dst[n][k] = *(const PG8_LAS bf16x8*)(lds + PG8_SB(b, h) + boff + n * 2048 + k * 1024); } while (0)
#define PG8_MMA(ai, bj, At, Bt) do { __builtin_amdgcn_s_setprio(1); _Pragma("unroll") for (int m = 0; m < 4; ++m) _Pragma("unroll") for (int n = 0; n < 2; ++n) _Pragma("unroll") for (int k = 0; k < 2; ++k) \
        acc[ai][bj][m][n] = __builtin_amdgcn_mfma_f32_16x16x32_bf16(Bt[n][k], At[m][k], acc[ai][bj][m][n], 0, 0, 0); __builtin_amdgcn_s_setprio(0); } while (0)
#define PG8_WAIT_V(n) asm volatile("s_waitcnt vmcnt(" #n ")" ::: "memory")
#define PG8_WAIT_L(n) asm volatile("s_waitcnt lgkmcnt(" #n ")" ::: "memory")
#define PG8_BAR __builtin_amdgcn_s_barrier()
#define PG8_SCHED __builtin_amdgcn_sched_barrier(0)
    Unit cur, nxt; int ui = 0;
    if (!S.next(0, cur)) return;
    f32x4 acc[2][2][4][2];
#pragma unroll
    for (int a = 0; a < 2; ++a)
#pragma unroll
        for (int b = 0; b < 2; ++b)
#pragma unroll
            for (int m = 0; m < 4; ++m)
#pragma unroll
                for (int n = 0; n < 2; ++n) acc[a][b][m][n] = (f32x4){0.f, 0.f, 0.f, 0.f};
    bf16x8 At[4][2], B0[2][2], B1[2][2];
    const char* cA = (const char*)g.A + (size_t)cur.pm * tstep; const char* cB = (const char*)g.Bt + (size_t)cur.pn * tstep;
    S.a_ready(cur);
    PG8_STAGE(PG8_SB(0, 0), cB, voffB); PG8_STAGE(PG8_SA(0, 0), cA, voffA); PG8_STAGE(PG8_SB(0, 1), cB + hstep, voffB); PG8_STAGE(PG8_SA(0, 1), cA + hstep, voffA);
    if (wr == 1) PG8_BAR;
    PG8_WAIT_V(4); PG8_BAR;
    PG8_STAGE(PG8_SB(1, 0), cB + kstep, voffB); PG8_STAGE(PG8_SA(1, 0), cA + kstep, voffA); PG8_STAGE(PG8_SB(1, 1), cB + hstep + kstep, voffB);
    PG8_WAIT_V(6); PG8_BAR;
    PG8_STAMP();
    for (;;) {
        const bool has_next = S.next(ui + 1, nxt);
        const char* nA = has_next ? (const char*)g.A + (size_t)nxt.pm * tstep : cA; const char* nB = has_next ? (const char*)g.Bt + (size_t)nxt.pn * tstep : cB;
        for (int t = 0; t < nt; t += 2) {
            const bool last = (t == nt - 2);
            const char* a1 = cA + (size_t)(t + 1) * kstep;
            const char* a2 = last ? nA : cA + (size_t)(t + 2) * kstep; const char* b2 = last ? nB : cB + (size_t)(t + 2) * kstep;
            const char* a3 = a2 + kstep; const char* b3 = b2 + kstep;
            if (last && has_next) S.a_ready(nxt);
            PG8_LDB(B0, 0, 0); PG8_SCHED; PG8_LDA(At, 0, 0); PG8_STAGE(PG8_SA(1, 1), a1 + hstep, voffA);
            PG8_WAIT_L(8); PG8_BAR; PG8_WAIT_L(0); PG8_MMA(0, 0, At, B0); PG8_BAR; PG8_SCHED;
            PG8_LDB(B1, 0, 1); PG8_STAGE(PG8_SB(0, 0), b2, voffB);
            PG8_BAR; PG8_WAIT_L(0); PG8_MMA(0, 1, At, B1); PG8_BAR;
            PG8_LDA(At, 0, 1); PG8_STAGE(PG8_SA(0, 0), a2, voffA);
            PG8_BAR; PG8_WAIT_L(0); PG8_MMA(1, 0, At, B0); PG8_BAR; PG8_SCHED;
            PG8_STAGE(PG8_SB(0, 1), b2 + hstep, voffB);
            PG8_WAIT_V(6); PG8_BAR; PG8_MMA(1, 1, At, B1); PG8_BAR;
            PG8_LDB(B0, 1, 0); PG8_SCHED; PG8_LDA(At, 1, 0); PG8_STAGE(PG8_SA(0, 1), a2 + hstep, voffA);
            PG8_WAIT_L(8); PG8_BAR; PG8_WAIT_L(0); PG8_MMA(0, 0, At, B0); PG8_BAR; PG8_SCHED;
            PG8_LDB(B1, 1, 1); PG8_STAGE(PG8_SB(1, 0), b3, voffB);
            PG8_BAR; PG8_WAIT_L(0); PG8_MMA(0, 1, At, B1); PG8_BAR;
            PG8_LDA(At, 1, 1); PG8_STAGE(PG8_SA(1, 0), a3, voffA);
            PG8_BAR; PG8_WAIT_L(0); PG8_MMA(1, 0, At, B0); PG8_BAR; PG8_SCHED;
            PG8_STAGE(PG8_SB(1, 1), b3 + hstep, voffB);
            PG8_WAIT_V(6); PG8_BAR; PG8_MMA(1, 1, At, B1); PG8_BAR;
        }
        PG8_STAMP();
        if constexpr (!Epi::AFTER_DRAIN) { E(acc, cur, wr, wc, fr, fq); S.done(cur); }
        PG8_STAMP();
        if (!has_next) break;
#pragma unroll
        for (int a = 0; a < 2; ++a)
#pragma unroll
            for (int b = 0; b < 2; ++b)
#pragma unroll
                for (int m = 0; m < 4; ++m)
#pragma unroll
                    for (int n = 0; n < 2; ++n) acc[a][b][m][n] = (f32x4){0.f, 0.f, 0.f, 0.f};
        cur = nxt; cA = nA; cB = nB; ++ui;
    }
    PG8_WAIT_V(0);
    if (wr == 0) PG8_BAR;
    PG8_BAR;
    if constexpr (Epi::AFTER_DRAIN) { E.fused(acc, cur, wr, wc, fr, fq, lds, wid, lane); S.done(cur); }
    PG8_STAMP();
    if (STAMP && wid == 0) { stamps[lane] = lane < nts ? (((unsigned long long)(unsigned)ts_hi << 32) | (unsigned)ts_lo) : 0ull;
        if (lane == 62) stamps[62] = rt_entry; if (lane == 63) stamps[63] = (unsigned long long)wall_clock64(); }
#undef PG8_STAMP
#undef PG8_SA
#undef PG8_SB
#undef PG8_STAGE
#undef PG8_LDA
#undef PG8_LDB
#undef PG8_MMA
#undef PG8_WAIT_V
#undef PG8_WAIT_L
#undef PG8_BAR
#undef PG8_SCHED
}
}

#define DI __device__ __forceinline__
#define LAS __attribute__((address_space(3)))
using pg8::bf16_t; using pg8::bf16x8; using pg8::f32x4; using pg8::u32x4;
typedef short s16x4 __attribute__((ext_vector_type(4)));
typedef unsigned u32x2 __attribute__((ext_vector_type(2)));
typedef float f32x2 __attribute__((ext_vector_type(2)));
typedef __bf16 bfv2 __attribute__((ext_vector_type(2)));

constexpr int D = 1024, TP = 16384, TS = 128, TR = TP + TS, MP = 16640, SEQ = 2048;
constexpr int NH = 3840, NHR = 3592, NS = 5376, NSR = 5152, FF = 4096;
constexpr int LDS_BYTES = 150 * 1024;
constexpr size_t O_YP = 0, O_YS = 16777216, O_PGDN = O_YS + 131072, O_PGC = O_PGDN + 1048576, O_PRET = O_PGC + 73728, O_PSSM = O_PRET + 524288,
                 O_PSC = O_PSSM + 4194304, O_SGDN = O_PSC + 147456, O_SGC = O_SGDN + 16777216, O_SRET = O_SGC + 1179648, O_SSSM = O_SRET + 8388608, O_SSC = O_SSSM + 67108864;
constexpr size_t WS_WINH = 0, WS_WOUTH = WS_WINH + 2ull * NH * 1024 * 2, WS_WINS = WS_WOUTH + 2ull * 1024 * 1024 * 2, WS_WOUTS = WS_WINS + 2ull * NS * 1024 * 2,
                 WS_W1 = WS_WOUTS + 2ull * 1024 * 2048 * 2, WS_W2 = WS_W1 + 4ull * 4096 * 1024 * 2, WS_X = WS_W2 + 4ull * 4096 * 1024 * 2, WS_H = WS_X + (size_t)MP * 1024 * 4,
                 WS_PROJ = WS_H + (size_t)MP * 1024 * 2, WS_YRAW = WS_PROJ + (size_t)MP * NS * 2, WS_MIX = WS_YRAW + (size_t)MP * 2048 * 2, WS_ACT = WS_MIX + (size_t)MP * 2048 * 2,
                 WS_CHK = WS_ACT + (size_t)MP * 4096 * 2;
constexpr int GB_NW = 0, GB_QG = 17408, GB_P = 34816, GB_KDT = 44032, GB_UT = 62464, GB_SC = 80896, GB_SIZE = 80960;
constexpr int RB_QG = 0, RB_P = 9216, RB_KDT = 18432, RB_VT = 27648, RB_SC = 46080, RB_SIZE = 46144;
constexpr int SG_CM = 0, SG_BT = 17408, SG_SIZE = 35840;
constexpr int SH_XT = 0, SH_PP = 9216, SH_SC = 18432, SH_SIZE = 19456;
constexpr size_t CHK_GDN = 0, CHK_RET = 1024ull * GB_SIZE, CHK_SG = 0, CHK_SH = 1024ull * SG_SIZE, CHK_END = 1024ull * GB_SIZE + 1024ull * RB_SIZE;
constexpr size_t WS_BAR = WS_CHK + (CHK_END > (1024ull * SG_SIZE + 8192ull * SH_SIZE) ? CHK_END : (1024ull * SG_SIZE + 8192ull * SH_SIZE));
constexpr size_t WS_END = WS_BAR + 16384;

struct Params { const float* in[27]; float* out; unsigned char* ws; int ph_lo, ph_hi; };

DI unsigned pk(float a, float b) { f32x2 v = {a, b}; bfv2 r = __builtin_convertvector(v, bfv2); return __builtin_bit_cast(unsigned, r); }
DI bf16_t f2bf(float a) { return (bf16_t)(pk(a, a) & 0xffffu); }
DI float bf2f(bf16_t b) { return __uint_as_float((unsigned)b << 16); }
DI float bflo(unsigned u) { return __uint_as_float(u << 16); }
DI float bfhi(unsigned u) { return __uint_as_float(u & 0xffff0000u); }
DI float wsum(float v) {
#pragma unroll
    for (int o = 32; o >= 1; o >>= 1) v += __shfl_xor(v, o);
    return v; }
DI float siluf(float x) { return x / (1.f + __expf(-x)); }
DI float softplusf(float x) { return fmaxf(x, 0.f) + log1pf(__expf(-fabsf(x))); }
DI bf16x8 lda_nat(const LAS unsigned char* base, int row, int strideB, int k0, int q) { return *(const LAS bf16x8*)(base + row * strideB + (k0 + 8 * q) * 2); }
DI bf16x8 lda_perm(const LAS unsigned char* base, int row, int strideB, int k0, int q) {
    const s16x4 lo = *(const LAS s16x4*)(base + row * strideB + (k0 + 4 * q) * 2);
    const s16x4 hi = *(const LAS s16x4*)(base + row * strideB + (k0 + 16 + 4 * q) * 2);
    return __builtin_shufflevector(lo, hi, 0, 1, 2, 3, 4, 5, 6, 7); }
DI bf16x8 pack2(f32x4 a, f32x4 b) { u32x4 p; p.x = pk(a[0], a[1]); p.y = pk(a[2], a[3]); p.z = pk(b[0], b[1]); p.w = pk(b[2], b[3]); return __builtin_bit_cast(bf16x8, p); }
#define MFMA16(a, b, c) __builtin_amdgcn_mfma_f32_16x16x32_bf16((a), (b), (c), 0, 0, 0)

template <int ACT> struct EpiB {
    static constexpr bool PERM = true, AFTER_DRAIN = false;
    bf16_t* O; int ldc;
    DI void operator()(const f32x4 (&acc)[2][2][4][2], const pg8::Unit& u, int wr, int wc, int fr, int fq) const {
        const int row0 = u.pm * 256 + wr * 64 + fr, col0 = u.pn * 256 + wc * 32 + 8 * fq;
#pragma unroll
        for (int ai = 0; ai < 2; ++ai)
#pragma unroll
            for (int m = 0; m < 4; ++m) { bf16_t* rowp = O + (size_t)(row0 + ai * 128 + m * 16) * ldc + col0;
#pragma unroll
                for (int bj = 0; bj < 2; ++bj) { f32x4 v0 = acc[ai][bj][m][0], v1 = acc[ai][bj][m][1];
                    if (ACT == 1) {
#pragma unroll
                        for (int j = 0; j < 4; ++j) { const float a = fmaxf(v0[j], 0.f), b = fmaxf(v1[j], 0.f); v0[j] = a * a; v1[j] = b * b; } }
                    u32x4 w; w.x = pk(v0[0], v0[1]); w.y = pk(v0[2], v0[3]); w.z = pk(v1[0], v1[1]); w.w = pk(v1[2], v1[3]);
                    *(u32x4*)(rowp + bj * 128) = w; } }
    }
};
struct EpiRes {
    static constexpr bool PERM = true, AFTER_DRAIN = false;
    bf16_t* X;
    DI void operator()(const f32x4 (&acc)[2][2][4][2], const pg8::Unit& u, int wr, int wc, int fr, int fq) const {
        const int row0 = u.pm * 256 + wr * 64 + fr, col0 = u.pn * 256 + wc * 32 + 8 * fq;
#pragma unroll
        for (int ai = 0; ai < 2; ++ai)
#pragma unroll
            for (int m = 0; m < 4; ++m) { bf16_t* rowp = X + (size_t)(row0 + ai * 128 + m * 16) * D + col0;
#pragma unroll
                for (int bj = 0; bj < 2; ++bj) { u32x4* p = (u32x4*)(rowp + bj * 128); const u32x4 o = *p; const f32x4 a = acc[ai][bj][m][0], b = acc[ai][bj][m][1];
                    u32x4 w; w.x = pk(bflo(o.x) + a[0], bfhi(o.x) + a[1]); w.y = pk(bflo(o.y) + a[2], bfhi(o.y) + a[3]);
                    w.z = pk(bflo(o.z) + b[0], bfhi(o.z) + b[1]); w.w = pk(bflo(o.w) + b[2], bfhi(o.w) + b[3]); *p = w; } }
    }
};

DI void tload(const float* W, int N, int item, int nblk, int lane, f32x4 (&tv)[8]) {
    const int kb = item / nblk, nb = item % nblk, k0 = 64 * kb, n0 = 32 * nb;
    const int n4 = (lane & 7) * 4, kr = lane >> 3; const bool ok = n0 + n4 < N;
#pragma unroll
    for (int i = 0; i < 8; ++i) tv[i] = ok ? __builtin_nontemporal_load((const f32x4*)(W + (size_t)(k0 + 8 * i + kr) * N + n0 + n4)) : (f32x4){0.f, 0.f, 0.f, 0.f};
}
DI void tstore(const f32x4 (&tv)[8], int K, bf16_t* WT, LAS float* scr, int item, int nblk, int lane) {
    const int kb = item / nblk, nb = item % nblk, k0 = 64 * kb, n0 = 32 * nb;
    const int n4 = (lane & 7) * 4, kr = lane >> 3;
#pragma unroll
    for (int i = 0; i < 8; ++i) { LAS float* d = scr + (8 * i + kr) * 33 + n4; d[0] = tv[i][0]; d[1] = tv[i][1]; d[2] = tv[i][2]; d[3] = tv[i][3]; }
    __builtin_amdgcn_s_waitcnt(0xc07f); asm volatile("" ::: "memory");
    const int c = lane & 7;
#pragma unroll
    for (int j = 0; j < 4; ++j) { const int nn = (lane >> 3) + 8 * j; const LAS float* s = scr + (8 * c) * 33 + nn;
        u32x4 o; o.x = pk(s[0 * 33], s[1 * 33]); o.y = pk(s[2 * 33], s[3 * 33]); o.z = pk(s[4 * 33], s[5 * 33]); o.w = pk(s[6 * 33], s[7 * 33]);
        *(u32x4*)(WT + (size_t)(n0 + nn) * K + k0 + 8 * c) = o; }
    __builtin_amdgcn_s_waitcnt(0xc07f); asm volatile("" ::: "memory");
}
DI void prologue(const Params& p, LAS unsigned char* lds, int gw, int ngw, int wv, int lane) {
    LAS float* scr = (LAS float*)(lds + wv * 8704);
    for (int mat = 0; mat < 6; ++mat) {
        const float* src; int K, N, Np, cnt; size_t dst;
        switch (mat) {
            case 0: src = p.in[10]; K = 1024; N = NHR; Np = NH; cnt = 2; dst = WS_WINH; break;
            case 1: src = p.in[16]; K = 1024; N = 1024; Np = 1024; cnt = 2; dst = WS_WOUTH; break;
            case 2: src = p.in[17]; K = 1024; N = NSR; Np = NS; cnt = 2; dst = WS_WINS; break;
            case 3: src = p.in[24]; K = 2048; N = 1024; Np = 1024; cnt = 2; dst = WS_WOUTS; break;
            case 4: src = p.in[25]; K = 1024; N = FF; Np = FF; cnt = 4; dst = WS_W1; break;
            default: src = p.in[26]; K = FF; N = 1024; Np = 1024; cnt = 4; dst = WS_W2; break;
        }
        const int nblk = Np / 32, per = (K / 64) * nblk, tot = per * cnt;
        f32x4 ta[8], tb[8];
        int it = gw;
        if (it < tot) tload(src + (size_t)(it / per) * K * N, N, it % per, nblk, lane, ta);
#pragma nounroll
        for (; it < tot; it += 2 * ngw) {
            const int it2 = it + ngw;
            if (it2 < tot) tload(src + (size_t)(it2 / per) * K * N, N, it2 % per, nblk, lane, tb);
            tstore(ta, K, (bf16_t*)(p.ws + dst) + (size_t)(it / per) * Np * K, scr, it % per, nblk, lane);
            const int it3 = it2 + ngw;
            if (it3 < tot) tload(src + (size_t)(it3 / per) * K * N, N, it3 % per, nblk, lane, ta);
            if (it2 < tot) tstore(tb, K, (bf16_t*)(p.ws + dst) + (size_t)(it2 / per) * Np * K, scr, it2 % per, nblk, lane);
        }
    }
    bf16_t* H = (bf16_t*)(p.ws + WS_H);
    for (int m = TR + gw; m < MP; m += ngw) { u32x4 z = {0u, 0u, 0u, 0u}; *(u32x4*)(H + (size_t)m * D + lane * 8) = z; *(u32x4*)(H + (size_t)m * D + 512 + lane * 8) = z; }
}

constexpr size_t WS_XS = WS_X + (size_t)MP * 1024 * 2;
DI void norm_rows(const Params& p, const float* w, bool copy, int gw, int ngw, int lane) {
    bf16_t* X16 = (bf16_t*)(p.ws + WS_X); float* Xs = (float*)(p.ws + WS_XS); bf16_t* H = (bf16_t*)(p.ws + WS_H);
    f32x4 wv[4];
#pragma unroll
    for (int j = 0; j < 2; ++j) { wv[2 * j] = *(const f32x4*)(w + 8 * lane + 512 * j); wv[2 * j + 1] = *(const f32x4*)(w + 8 * lane + 512 * j + 4); }
    for (int m0 = gw * 2; m0 < TP; m0 += ngw * 2) {
        f32x4 v[2][4];
#pragma unroll
        for (int rr = 0; rr < 2; ++rr) { const int m = m0 + rr;
            if (copy) {
#pragma unroll
                for (int j = 0; j < 2; ++j) { v[rr][2 * j] = __builtin_nontemporal_load((const f32x4*)(p.in[0] + (size_t)m * D + 8 * lane + 512 * j)); v[rr][2 * j + 1] = __builtin_nontemporal_load((const f32x4*)(p.in[0] + (size_t)m * D + 8 * lane + 512 * j + 4)); }
            } else {
#pragma unroll
                for (int j = 0; j < 2; ++j) { const u32x4 u = *(const u32x4*)(X16 + (size_t)m * D + 8 * lane + 512 * j);
                    v[rr][2 * j] = (f32x4){bflo(u.x), bfhi(u.x), bflo(u.y), bfhi(u.y)}; v[rr][2 * j + 1] = (f32x4){bflo(u.z), bfhi(u.z), bflo(u.w), bfhi(u.w)}; }
            } }
#pragma unroll
        for (int rr = 0; rr < 2; ++rr) { const int m = m0 + rr; float ss = 0.f;
#pragma unroll
            for (int j = 0; j < 4; ++j) ss += v[rr][j][0] * v[rr][j][0] + v[rr][j][1] * v[rr][j][1] + v[rr][j][2] * v[rr][j][2] + v[rr][j][3] * v[rr][j][3];
            ss = wsum(ss); const float r = rsqrtf(ss * (1.f / 1024.f) + 1e-6f);
#pragma unroll
            for (int j = 0; j < 2; ++j) { const f32x4 a = v[rr][2 * j], b = v[rr][2 * j + 1];
                if (copy) { u32x4 xo; xo.x = pk(a[0], a[1]); xo.y = pk(a[2], a[3]); xo.z = pk(b[0], b[1]); xo.w = pk(b[2], b[3]); *(u32x4*)(X16 + (size_t)m * D + 8 * lane + 512 * j) = xo; }
                u32x4 o; o.x = pk(a[0] * r * wv[2 * j][0], a[1] * r * wv[2 * j][1]); o.y = pk(a[2] * r * wv[2 * j][2], a[3] * r * wv[2 * j][3]);
                o.z = pk(b[0] * r * wv[2 * j + 1][0], b[1] * r * wv[2 * j + 1][1]); o.w = pk(b[2] * r * wv[2 * j + 1][2], b[3] * r * wv[2 * j + 1][3]);
                *(u32x4*)(H + (size_t)m * D + 8 * lane + 512 * j) = o; } }
    }
    for (int m = TP + gw; m < TR; m += ngw) {
        const float* src = copy ? p.in[1] + (size_t)(m - TP) * D : Xs + (size_t)(m - TP) * D;
        f32x4 v[4]; float ss = 0.f;
#pragma unroll
        for (int j = 0; j < 4; ++j) { v[j] = *(const f32x4*)(src + 4 * lane + 256 * j); ss += v[j][0] * v[j][0] + v[j][1] * v[j][1] + v[j][2] * v[j][2] + v[j][3] * v[j][3]; }
        ss = wsum(ss); const float r = rsqrtf(ss * (1.f / 1024.f) + 1e-6f);
#pragma unroll
        for (int j = 0; j < 4; ++j) { const f32x4 ww = *(const f32x4*)(w + 4 * lane + 256 * j);
            if (copy) *(f32x4*)(Xs + (size_t)(m - TP) * D + 4 * lane + 256 * j) = v[j];
            u32x2 o; o.x = pk(v[j][0] * r * ww[0], v[j][1] * r * ww[1]); o.y = pk(v[j][2] * r * ww[2], v[j][3] * r * ww[3]);
            *(u32x2*)(H + (size_t)m * D + 4 * lane + 256 * j) = o; }
    }
}
DI void final_norm(const Params& p, int gw, int ngw, int lane) {
    const bf16_t* X16 = (const bf16_t*)(p.ws + WS_X); const float* Xs = (const float*)(p.ws + WS_XS); const float* w = p.in[9];
    f32x4 wv[4];
#pragma unroll
    for (int j = 0; j < 2; ++j) { wv[2 * j] = *(const f32x4*)(w + 8 * lane + 512 * j); wv[2 * j + 1] = *(const f32x4*)(w + 8 * lane + 512 * j + 4); }
    for (int m0 = gw * 2; m0 < TP; m0 += ngw * 2) {
        f32x4 v[2][4];
#pragma unroll
        for (int rr = 0; rr < 2; ++rr)
#pragma unroll
            for (int j = 0; j < 2; ++j) { const u32x4 u = *(const u32x4*)(X16 + (size_t)(m0 + rr) * D + 8 * lane + 512 * j);
                v[rr][2 * j] = (f32x4){bflo(u.x), bfhi(u.x), bflo(u.y), bfhi(u.y)}; v[rr][2 * j + 1] = (f32x4){bflo(u.z), bfhi(u.z), bflo(u.w), bfhi(u.w)}; }
#pragma unroll
        for (int rr = 0; rr < 2; ++rr) { const int m = m0 + rr; float ss = 0.f; float* dst = p.out + O_YP + (size_t)m * D;
#pragma unroll
            for (int j = 0; j < 4; ++j) ss += v[rr][j][0] * v[rr][j][0] + v[rr][j][1] * v[rr][j][1] + v[rr][j][2] * v[rr][j][2] + v[rr][j][3] * v[rr][j][3];
            ss = wsum(ss); const float r = rsqrtf(ss * (1.f / 1024.f) + 1e-6f);
#pragma unroll
            for (int j = 0; j < 2; ++j) { __builtin_nontemporal_store(v[rr][2 * j] * r * wv[2 * j], (f32x4*)(dst + 8 * lane + 512 * j)); __builtin_nontemporal_store(v[rr][2 * j + 1] * r * wv[2 * j + 1], (f32x4*)(dst + 8 * lane + 512 * j + 4)); } }
    }
    for (int m = TP + gw; m < TR; m += ngw) {
        const float* src = Xs + (size_t)(m - TP) * D; float* dst = p.out + O_YS + (size_t)(m - TP) * D;
        f32x4 v[4]; float ss = 0.f;
#pragma unroll
        for (int j = 0; j < 4; ++j) { v[j] = *(const f32x4*)(src + 4 * lane + 256 * j); ss += v[j][0] * v[j][0] + v[j][1] * v[j][1] + v[j][2] * v[j][2] + v[j][3] * v[j][3]; }
        ss = wsum(ss); const float r = rsqrtf(ss * (1.f / 1024.f) + 1e-6f);
#pragma unroll
        for (int j = 0; j < 4; ++j) { const f32x4 ww = *(const f32x4*)(w + 4 * lane + 256 * j); *(f32x4*)(dst + 4 * lane + 256 * j) = v[j] * r * ww; }
    }
}

constexpr int P_KN = 0, P_QN = 17408, P_KBT = 34816, P_KDT = 53248, P_VBT = 71680, P_AM = 90112, P_TM = 107520, P_SC = 116736, P_TF = 117760;
DI void gdn_prep_unit(LAS unsigned char* lds, const bf16_t* PROJ, const float* convw, float a_log_h, float dtb_h, unsigned char* blk, int row0, int h, int tid) {
    asm volatile("" : "+v"(tid));
    const int lane = tid & 63, w = tid >> 6, r = lane & 15, q = lane >> 4;
    LAS float* scG = (LAS float*)(lds + P_SC); LAS float* scC = scG + 64; LAS float* scB = scG + 128;
    if (w == 0) {
        const bf16_t* pr = PROJ + (size_t)(row0 + lane) * NH;
        const float braw = bf2f(pr[2048 + h]), araw = bf2f(pr[2052 + h]);
        const float beta = 1.f / (1.f + __expf(-braw));
        const float g = -__expf(a_log_h) * softplusf(araw + dtb_h);
        float c = g;
#pragma unroll
        for (int o = 1; o < 64; o <<= 1) { const float t = __shfl_up(c, o); if (lane >= o) c += t; }
        scG[lane] = g; scC[lane] = c; scB[lane] = beta;
    }
    __syncthreads();
    const float gend = scC[63];
    float cw[3][4][2];
#pragma unroll
    for (int grp = 0; grp < 3; ++grp)
#pragma unroll
        for (int tap = 0; tap < 4; ++tap) { const f32x2 t = *(const f32x2*)(convw + tap * 1536 + grp * 512 + h * 128 + 2 * lane); cw[grp][tap][0] = t[0]; cw[grp][tap][1] = t[1]; }
    LAS bf16_t* kbt = (LAS bf16_t*)(lds + P_KBT); LAS bf16_t* kdt = (LAS bf16_t*)(lds + P_KDT); LAS bf16_t* vbt = (LAS bf16_t*)(lds + P_VBT);
    unsigned xr[11][3];
#pragma unroll
    for (int j = 0; j < 11; ++j) { const int t = (row0 & (SEQ - 1)) + w * 8 - 3 + j; const bf16_t* pr = PROJ + (size_t)(row0 + w * 8 - 3 + j) * NH + h * 128 + 2 * lane;
#pragma unroll
        for (int grp = 0; grp < 3; ++grp) xr[j][grp] = (t >= 0) ? *(const unsigned*)(pr + grp * 512) : 0u; }
#pragma unroll
    for (int tt = 0; tt < 8; ++tt) {
        const int i = w * 8 + tt;
        float a[3][2] = {{0.f, 0.f}, {0.f, 0.f}, {0.f, 0.f}};
#pragma unroll
        for (int tap = 0; tap < 4; ++tap)
#pragma unroll
            for (int grp = 0; grp < 3; ++grp) { const unsigned u = xr[tt + tap][grp]; a[grp][0] += cw[grp][tap][0] * bflo(u); a[grp][1] += cw[grp][tap][1] * bfhi(u); }
#pragma unroll
        for (int grp = 0; grp < 3; ++grp) { a[grp][0] = siluf(a[grp][0]); a[grp][1] = siluf(a[grp][1]); }
        const float sq = wsum(a[0][0] * a[0][0] + a[0][1] * a[0][1]), sk = wsum(a[1][0] * a[1][0] + a[1][1] * a[1][1]);
        const float rq = rsqrtf(sq + 1e-6f) * 0.08838834764831845f, rk = rsqrtf(sk + 1e-6f);
        const float q0 = a[0][0] * rq, q1 = a[0][1] * rq, k0 = a[1][0] * rk, k1 = a[1][1] * rk, v0 = a[2][0], v1 = a[2][1];
        const float gc = scC[i], be = scB[i], eg = __expf(gc), ed = __expf(gend - gc);
        *(LAS unsigned*)(lds + P_QN + i * 272 + lane * 4) = pk(q0, q1);
        *(LAS unsigned*)(lds + P_KN + i * 272 + lane * 4) = pk(k0, k1);
        *(unsigned*)(blk + GB_QG + i * 272 + lane * 4) = pk(q0 * eg, q1 * eg);
        kbt[(2 * lane) * 72 + i] = f2bf(k0 * be * eg); kbt[(2 * lane + 1) * 72 + i] = f2bf(k1 * be * eg);
        kdt[(2 * lane) * 72 + i] = f2bf(k0 * ed); kdt[(2 * lane + 1) * 72 + i] = f2bf(k1 * ed);
        vbt[(2 * lane) * 72 + i] = f2bf(v0 * be); vbt[(2 * lane + 1) * 72 + i] = f2bf(v1 * be);
    }
    __syncthreads();
    LAS float* AM = (LAS float*)(lds + P_AM);
    for (int tix = w; tix < 16; tix += 8) { const int mi = tix >> 2, nj = tix & 3;
        f32x4 kk = {0.f, 0.f, 0.f, 0.f}, qk = {0.f, 0.f, 0.f, 0.f};
        if (nj <= mi) {
#pragma unroll
            for (int s = 0; s < 4; ++s) { const bf16x8 bk = lda_nat(lds + P_KN, 16 * nj + r, 272, 32 * s, q), ak = lda_nat(lds + P_KN, 16 * mi + r, 272, 32 * s, q), aq = lda_nat(lds + P_QN, 16 * mi + r, 272, 32 * s, q);
                kk = MFMA16(ak, bk, kk); qk = MFMA16(aq, bk, qk); } }
#pragma unroll
        for (int reg = 0; reg < 4; ++reg) { const int i = 16 * mi + 4 * q + reg, j = 16 * nj + r;
            const float dec = (j <= i) ? __expf(scC[i] - scC[j]) : 0.f;
            AM[j * 68 + i] = (j < i) ? scB[i] * kk[reg] * dec : 0.f;
            *(bf16_t*)(blk + GB_P + (i * 72 + j) * 2) = f2bf(qk[reg] * dec); }
    }
    __syncthreads();
    if (w == 0) {
        LAS bf16_t* TM = (LAS bf16_t*)(lds + P_TM);
        float t[64];
#pragma unroll
        for (int i = 0; i < 64; ++i) t[i] = (lane == i) ? 1.f : 0.f;
#pragma unroll
        for (int j = 0; j < 63; ++j) { const float tj = t[j];
#pragma unroll
            for (int i = j + 1; i < 64; ++i) t[i] -= AM[j * 68 + i] * tj; }
#pragma unroll
        for (int i = 0; i < 64; ++i) TM[i * 72 + lane] = f2bf(t[i]);
    } else {
        for (int idx = tid - 64; idx < 1152; idx += 448) *(u32x4*)(blk + GB_KDT + idx * 16) = *(const LAS u32x4*)(lds + P_KDT + idx * 16);
    }
    __syncthreads();
    for (int tix = w; tix < 64; tix += 8) {
        f32x4 acc = {0.f, 0.f, 0.f, 0.f};
        if (tix < 32) { const int mi = tix >> 3, nv = tix & 7;
#pragma unroll
            for (int s = 0; s < 2; ++s) acc = MFMA16(lda_nat(lds + P_TM, 16 * mi + r, 144, 32 * s, q), lda_nat(lds + P_VBT, 16 * nv + r, 144, 32 * s, q), acc);
            u32x2 o; o.x = pk(acc[0], acc[1]); o.y = pk(acc[2], acc[3]);
            *(u32x2*)(blk + GB_UT + ((16 * nv + r) * 72 + 16 * mi + 4 * q) * 2) = o;
        } else { const int t2 = tix - 32, mk = t2 >> 2, ni = t2 & 3;
#pragma unroll
            for (int s = 0; s < 2; ++s) acc = MFMA16(lda_nat(lds + P_KBT, 16 * mk + r, 144, 32 * s, q), lda_nat(lds + P_TM, 16 * ni + r, 144, 32 * s, q), acc);
            u32x2 o; o.x = pk(-acc[0], -acc[1]); o.y = pk(-acc[2], -acc[3]);
            *(u32x2*)(blk + GB_NW + ((16 * ni + r) * 136 + 16 * mk + 4 * q) * 2) = o; }
    }
    if (tid == 0) *(float*)(blk + GB_SC) = __expf(gend);
    __syncthreads();
}

constexpr int R_QR = 0, R_KR = 9216, R_KDT = 18432, R_VT = 27648;
DI void rot_sincos(float pos, int f, float& sn, float& cs) {
    const float inv = exp2f(-(float)f * (13.287712379549449f / 32.f));
    const float ang = pos * inv;
    double rev = (double)ang * 0.15915494309189535; rev -= __builtin_floor(rev);
    const float fr = (float)rev;
    sn = __builtin_amdgcn_sinf(fr); cs = __builtin_amdgcn_cosf(fr);
}
DI void ret_prep_unit(LAS unsigned char* lds, const bf16_t* PROJ, unsigned char* blk, int row0, int h, int tid) {
    asm volatile("" : "+v"(tid));
    const int lane = tid & 63, w = tid >> 6, r = lane & 15, q = lane >> 4;
    const float lg = __logf(1.f - exp2f(-5.f - (float)h));
    const int f = lane & 31, which = lane >> 5;
    LAS bf16_t* qr = (LAS bf16_t*)(lds + R_QR); LAS bf16_t* kr = (LAS bf16_t*)(lds + R_KR); LAS bf16_t* kdt = (LAS bf16_t*)(lds + R_KDT); LAS bf16_t* vt = (LAS bf16_t*)(lds + R_VT);
#pragma unroll
    for (int tt = 0; tt < 8; ++tt) {
        const int i = w * 8 + tt, t = (row0 & (SEQ - 1)) + i;
        const bf16_t* pr = PROJ + (size_t)(row0 + i) * NH;
        const int base = (which ? 2312 : 2056) + h * 64;
        const float x1 = bf2f(pr[base + f]), x2 = bf2f(pr[base + 32 + f]);
        float sn, cs; rot_sincos((float)t, f, sn, cs);
        float o1 = x1 * cs - x2 * sn, o2 = x2 * cs + x1 * sn;
        if (which == 0) {
            qr[i * 72 + f] = f2bf(o1); qr[i * 72 + 32 + f] = f2bf(o2);
            const float eg = __expf((float)(i + 1) * lg);
            *(bf16_t*)(blk + RB_QG + (i * 72 + f) * 2) = f2bf(o1 * eg); *(bf16_t*)(blk + RB_QG + (i * 72 + 32 + f) * 2) = f2bf(o2 * eg);
        } else {
            o1 *= 0.125f; o2 *= 0.125f;
            kr[i * 72 + f] = f2bf(o1); kr[i * 72 + 32 + f] = f2bf(o2);
            const float ed = __expf((float)(63 - i) * lg);
            kdt[f * 72 + i] = f2bf(o1 * ed); kdt[(32 + f) * 72 + i] = f2bf(o2 * ed);
        }
        const unsigned u = *(const unsigned*)(pr + 2568 + h * 128 + 2 * lane);
        vt[(2 * lane) * 72 + i] = (bf16_t)(u & 0xffffu); vt[(2 * lane + 1) * 72 + i] = (bf16_t)(u >> 16);
    }
    __syncthreads();
    for (int tix = w; tix < 16; tix += 8) { const int mi = tix >> 2, nj = tix & 3;
        f32x4 qk = {0.f, 0.f, 0.f, 0.f};
        if (nj <= mi) {
#pragma unroll
            for (int s = 0; s < 2; ++s) qk = MFMA16(lda_nat(lds + R_QR, 16 * mi + r, 144, 32 * s, q), lda_nat(lds + R_KR, 16 * nj + r, 144, 32 * s, q), qk); }
#pragma unroll
        for (int reg = 0; reg < 4; ++reg) { const int i = 16 * mi + 4 * q + reg, j = 16 * nj + r;
            const float dec = (j <= i) ? __expf((float)(i - j) * lg) : 0.f;
            *(bf16_t*)(blk + RB_P + (i * 72 + j) * 2) = f2bf(qk[reg] * dec); }
    }
    for (int idx = tid; idx < 1728; idx += 512) *(u32x4*)(blk + RB_KDT + idx * 16) = *(const LAS u32x4*)(lds + R_KDT + idx * 16);
    if (tid == 0) *(float*)(blk + RB_SC) = __expf(64.f * lg);
    __syncthreads();
}

constexpr int Q_CM = 0, Q_BM = 17408, Q_BT = 34816, Q_XT = 53248, Q_END = 53248 + 73728;
DI void ssd_prep_unit(LAS unsigned char* lds, const bf16_t* PROJ, const float* convw  , const float* convb, const float* dtb, const float* alog, const float* dsk,
                      unsigned char* gblk, unsigned char* hblk0  , int row0, int g, int tid) {
    asm volatile("" : "+v"(tid));
    const int lane = tid & 63, w = tid >> 6, r = lane & 15, q = lane >> 4;
    int ch[6];
#pragma unroll
    for (int j = 0; j < 4; ++j) ch[j] = g * 512 + 128 * j + 2 * lane;
    ch[4] = 2048 + g * 128 + 2 * lane; ch[5] = 2560 + g * 128 + 2 * lane;
    float cw[6][5][2];
#pragma unroll
    for (int j = 0; j < 6; ++j) {
#pragma unroll
        for (int tap = 0; tap < 4; ++tap) { const f32x2 t = *(const f32x2*)(convw + tap * 3072 + ch[j]); cw[j][tap][0] = t[0]; cw[j][tap][1] = t[1]; }
        const f32x2 t = *(const f32x2*)(convb + ch[j]); cw[j][4][0] = t[0]; cw[j][4][1] = t[1]; }
    LAS bf16_t* bt = (LAS bf16_t*)(lds + Q_BT); LAS bf16_t* xt = (LAS bf16_t*)(lds + Q_XT);
    if (w == 0) {
        const bf16_t* pr = PROJ + (size_t)(row0 + lane) * NS + 5120 + g * 8;
#pragma unroll
        for (int hh = 0; hh < 8; ++hh) { const int head = g * 8 + hh;
            const float dt = softplusf(bf2f(pr[hh]) + dtb[head]); const float gg = -__expf(alog[head]) * dt;
            float c = gg;
#pragma unroll
            for (int o = 1; o < 64; o <<= 1) { const float t = __shfl_up(c, o); if (lane >= o) c += t; }
            const float gend = __shfl(c, 63);
            float* sc = (float*)(hblk0 + (size_t)(hh >> 1) * 32 * 2 * SH_SIZE + (hh & 1) * SH_SIZE + SH_SC);
            sc[lane] = dt * __expf(gend - c); sc[64 + lane] = __expf(c);
            LAS float* ls = (LAS float*)(lds + Q_END) + hh * 128; ls[lane] = dt; ls[64 + lane] = c; }
    }
    unsigned xr[11][6];
#pragma unroll
    for (int jr = 0; jr < 11; ++jr) { const int t = (row0 & (SEQ - 1)) + w * 8 - 3 + jr; const bf16_t* pr = PROJ + (size_t)(row0 + w * 8 - 3 + jr) * NS + 2048;
#pragma unroll
        for (int j = 0; j < 6; ++j) xr[jr][j] = (t >= 0) ? *(const unsigned*)(pr + ch[j]) : 0u; }
#pragma unroll
    for (int tt = 0; tt < 8; ++tt) {
        const int i = w * 8 + tt;
        float a[6][2];
#pragma unroll
        for (int j = 0; j < 6; ++j) { a[j][0] = cw[j][4][0]; a[j][1] = cw[j][4][1]; }
#pragma unroll
        for (int tap = 0; tap < 4; ++tap)
#pragma unroll
            for (int j = 0; j < 6; ++j) { const unsigned u = xr[tt + tap][j]; a[j][0] += cw[j][tap][0] * bflo(u); a[j][1] += cw[j][tap][1] * bfhi(u); }
#pragma unroll
        for (int j = 0; j < 6; ++j) { a[j][0] = siluf(a[j][0]); a[j][1] = siluf(a[j][1]); }
#pragma unroll
        for (int j = 0; j < 4; ++j) { xt[(128 * j + 2 * lane) * 72 + i] = f2bf(a[j][0]); xt[(128 * j + 2 * lane + 1) * 72 + i] = f2bf(a[j][1]); }
        *(LAS unsigned*)(lds + Q_BM + i * 272 + lane * 4) = pk(a[4][0], a[4][1]);
        bt[(2 * lane) * 72 + i] = f2bf(a[4][0]); bt[(2 * lane + 1) * 72 + i] = f2bf(a[4][1]);
        const unsigned cu = pk(a[5][0], a[5][1]);
        *(LAS unsigned*)(lds + Q_CM + i * 272 + lane * 4) = cu;
        *(unsigned*)(gblk + SG_CM + i * 272 + lane * 4) = cu;
    }
    __syncthreads();
    for (int tix = w; tix < 16; tix += 8) { const int mi = tix >> 2, nj = tix & 3;
        f32x4 cb = {0.f, 0.f, 0.f, 0.f};
        if (nj <= mi) {
#pragma unroll
            for (int s = 0; s < 4; ++s) cb = MFMA16(lda_nat(lds + Q_CM, 16 * mi + r, 272, 32 * s, q), lda_nat(lds + Q_BM, 16 * nj + r, 272, 32 * s, q), cb); }
#pragma unroll
        for (int hh = 0; hh < 8; ++hh) { const LAS float* ls = (const LAS float*)(lds + Q_END) + hh * 128; const float dj = ls[16 * nj + r], gj = ls[64 + 16 * nj + r], dk = dsk[g * 8 + hh];
            unsigned char* pb = hblk0 + (size_t)(hh >> 1) * 32 * 2 * SH_SIZE + (hh & 1) * SH_SIZE + SH_PP;
#pragma unroll
            for (int reg = 0; reg < 4; ++reg) { const int i = 16 * mi + 4 * q + reg, j = 16 * nj + r;
                float v = (j <= i) ? cb[reg] * __expf(ls[64 + i] - gj) * dj : 0.f; if (i == j) v += dk;
                *(bf16_t*)(pb + (i * 72 + j) * 2) = f2bf(v); } }
    }
    for (int idx = tid; idx < 1152; idx += 512) *(u32x4*)(gblk + SG_BT + idx * 16) = *(const LAS u32x4*)(lds + Q_BT + idx * 16);
    for (int idx = tid; idx < 4608; idx += 512) { const int hh = idx / 576, o = idx % 576;
        *(u32x4*)(hblk0 + (size_t)(hh >> 1) * 32 * 2 * SH_SIZE + (hh & 1) * SH_SIZE + SH_XT + o * 16) = *(const LAS u32x4*)(lds + Q_XT + idx * 16); }
    __syncthreads();
}
#define XB_T0(wid) ((wid) == 0 && __builtin_amdgcn_mbcnt_hi(~0u, __builtin_amdgcn_mbcnt_lo(~0u, 0u)) == 0u)
#define XB_TMO      128
#define XB_XCNT(j)  (256  + 64 * (j))
#define XB_XSUB(j)  (1280 + 64 * (j))
#define XB_XGEN(j)  (2304 + 64 * (j))
#define XB_TOP      3328
#define XB_TOPGEN   3392
#define XCD_BAR_WORDS 3456
#define XB_SPIN_CAP (1u << 18)

__device__ __forceinline__ unsigned xb_ld(unsigned* p)              { return __hip_atomic_load(p, __ATOMIC_RELAXED, __HIP_MEMORY_SCOPE_AGENT); }
__device__ __forceinline__ unsigned xb_add(unsigned* p, unsigned v) { return __hip_atomic_fetch_add(p, v, __ATOMIC_RELAXED, __HIP_MEMORY_SCOPE_AGENT); }
__device__ __forceinline__ unsigned xb_xcc_id() { return (unsigned)__builtin_amdgcn_s_getreg((3 << 11) | 20) & 0xFu; }
#define XB_SPIN(cond, bar) do { unsigned _sp = 0; while (cond) { __builtin_amdgcn_s_sleep(1); \
    if ((++_sp & 255u) == 0u) { if (xb_ld(&(bar)[XB_TMO])) break; if (_sp > XB_SPIN_CAP) { atomicAdd(&(bar)[XB_TMO], 1u); break; } } } } while (0)

struct XcdBarrier {
    unsigned* bar; unsigned x; int wid;
    volatile LAS unsigned* st;
};

__device__ __forceinline__ XcdBarrier xcd_barrier_post(unsigned* bar, volatile LAS unsigned* st, int wid) {
    XcdBarrier b; b.bar = bar; b.x = xb_xcc_id(); b.st = st; b.wid = wid;
    if (XB_T0(wid)) (void)xb_add(&bar[XB_XCNT(b.x)], 1u);
    return b;
}
__device__ __forceinline__ void xcd_barrier_complete(unsigned* bar, unsigned x, unsigned& nloc, unsigned& nx) {
    const unsigned G = gridDim.x * gridDim.y * gridDim.z;
    unsigned sum, cnt, mine, sp = 0u;
    for (;;) {
        sum = 0u; cnt = 0u; mine = 0u;
#pragma unroll
        for (unsigned j = 0; j < 16; ++j) { const unsigned c = xb_ld(&bar[XB_XCNT(j)]); sum += c; cnt += (c > 0u) ? 1u : 0u; mine = (j == x) ? c : mine; }
        if (sum == G) break;
        __builtin_amdgcn_s_sleep(1);
        if ((++sp & 255u) == 0u) { if (xb_ld(&bar[XB_TMO])) break; if (sp > XB_SPIN_CAP) { atomicAdd(&bar[XB_TMO], 1u); break; } }
    }
    nloc = mine > 0u ? mine : 1u; nx = cnt > 0u ? cnt : 1u;
}

__device__ __forceinline__ void xcd_barrier(const XcdBarrier& b) {
    asm volatile("s_waitcnt vmcnt(0)" ::: "memory");
    __syncthreads();
    if (XB_T0(b.wid)) {
        unsigned* bar = b.bar;
        __builtin_amdgcn_s_waitcnt(0);
        unsigned nloc = b.st[0], nx = b.st[1];
        if (nloc == 0u) { xcd_barrier_complete(bar, b.x, nloc, nx); b.st[0] = nloc; b.st[1] = nx; }
        const unsigned old = xb_add(&bar[XB_XSUB(b.x)], 1u);
        const unsigned gen = old / nloc;
        if (old + 1u == (gen + 1u) * nloc) {
            __builtin_amdgcn_fence(__ATOMIC_RELEASE, "agent");
            asm volatile("s_waitcnt vmcnt(0)" ::: "memory");
            const unsigned og = xb_add(&bar[XB_TOP], 1u);
            const unsigned tg = og / nx;
            if (og + 1u == (tg + 1u) * nx) xb_add(&bar[XB_TOPGEN], 1u);
            else XB_SPIN(xb_ld(&bar[XB_TOPGEN]) == tg, bar);
            __builtin_amdgcn_fence(__ATOMIC_ACQUIRE, "agent");
            xb_add(&bar[XB_XGEN(b.x)], 1u);
            asm volatile("s_waitcnt vmcnt(0)" ::: "memory");
        } else {
            XB_SPIN(xb_ld(&bar[XB_XGEN(b.x)]) == gen, bar);
            __builtin_amdgcn_fence(__ATOMIC_ACQUIRE, "agent");
            asm volatile("s_waitcnt vmcnt(0)" ::: "memory");
        }
    }
    __syncthreads();
}


#define PF_LOAD(pf, n, src, nvec) do { _Pragma("unroll") for (int _k = 0; _k < (n); ++_k) { const int _i = tid + _k * 512; if (_i < (nvec)) pf[_k] = ((const u32x4*)(src))[_i]; } } while (0)
#define PF_STORE(pf, n, nvec) do { _Pragma("unroll") for (int _k = 0; _k < (n); ++_k) { const int _i = tid + _k * 512; if (_i < (nvec)) ((LAS u32x4*)lds)[_i] = pf[_k]; } } while (0)

constexpr int GL_UT = 62464, GL_SC = 67072, GL_SIZE = 67136, GL_NV = GL_SIZE / 16;
constexpr int GS_SF = 2 * GL_SIZE, GS_DF = GS_SF + 8192;
static_assert(GS_DF + 4096 <= LDS_BYTES - 32, "GDN scan LDS budget");
DI void gdn_scan(LAS unsigned char* lds, const unsigned char* blk0, bf16_t* YRAW, int row0, int h, float* sout, int tid, const int vs) {
    asm volatile("" : "+v"(tid));
    const int lane = tid & 63, w = tid >> 6, r = lane & 15, q = lane >> 4, ct = w & 1, rg = w >> 1, v0 = 32 * vs + 16 * ct;
    f32x4 S0 = (f32x4){0.f, 0.f, 0.f, 0.f}, S1 = S0;
    u32x4 pfA[9], pfB[9];
#define GDN_LOAD(pf, cc) do { const u32x4* _s = (const u32x4*)(blk0 + (size_t)(cc) * GB_SIZE); _Pragma("unroll") for (int _k = 0; _k < 9; ++_k) { const int _i = tid + _k * 512; \
        if (_i < GL_NV) pf[_k] = _s[_i < 3904 ? _i : (_i < 4192 ? _i + vs * 288 : _i + 864)]; } } while (0)
#define GDN_STORE(pf, boff) do { _Pragma("unroll") for (int _k = 0; _k < 9; ++_k) { const int _i = tid + _k * 512; if (_i < GL_NV) ((LAS u32x4*)(lds + (boff)))[_i] = pf[_k]; } } while (0)
    GDN_LOAD(pfA, 0);
    GDN_STORE(pfA, 0);
    GDN_LOAD(pfA, 1); GDN_LOAD(pfB, 2);
    LAS u32x4* SF = (LAS u32x4*)(lds + GS_SF) + ct * 4 * 64;
    LAS unsigned char* DF = lds + GS_DF + ct * 2 * 1024;
    SF[rg * 64 + lane] = (u32x4){0u, 0u, 0u, 0u};
    __syncthreads();
    auto step = [&](auto BC, const int c, u32x4 (&pf)[9]) __attribute__((always_inline)) {
        constexpr int BUFC = decltype(BC)::value ? GL_SIZE : 0, BUFN = GL_SIZE - BUFC;
        const LAS unsigned char* bc = lds + BUFC;
        const float e = *(const LAS float*)(bc + GL_SC);
        const u32x2 uu = *(const LAS u32x2*)(bc + GL_UT + ((16 * ct + r) * 72 + 16 * rg + 4 * q) * 2);
        f32x4 Dl = (f32x4){bflo(uu.x), bfhi(uu.x), bflo(uu.y), bfhi(uu.y)}, Y = (f32x4){0.f, 0.f, 0.f, 0.f};
#pragma unroll
        for (int s = 0; s < 4; ++s) { const bf16x8 bs = __builtin_bit_cast(bf16x8, SF[s * 64 + lane]);
            Dl = MFMA16(lda_perm(bc + GB_NW, 16 * rg + r, 272, 32 * s, q), bs, Dl); Y = MFMA16(lda_perm(bc + GB_QG, 16 * rg + r, 272, 32 * s, q), bs, Y); }
        { u32x2 dd; dd.x = pk(Dl[0], Dl[1]); dd.y = pk(Dl[2], Dl[3]); *(LAS u32x2*)(DF + (rg >> 1) * 1024 + lane * 16 + (rg & 1) * 8) = dd; }
        __syncthreads();
        if (c + 1 < 32) GDN_STORE(pf, BUFN);
        if (c + 3 < 32) GDN_LOAD(pf, c + 3);
        S0 = S0 * e; S1 = S1 * e;
#pragma unroll
        for (int s2 = 0; s2 < 2; ++s2) { const bf16x8 bd = *(const LAS bf16x8*)(DF + s2 * 1024 + lane * 16);
            Y = MFMA16(lda_perm(bc + GB_P, 16 * rg + r, 144, 32 * s2, q), bd, Y);
            S0 = MFMA16(lda_perm(bc + GB_KDT, 16 * (2 * rg) + r, 144, 32 * s2, q), bd, S0);
            S1 = MFMA16(lda_perm(bc + GB_KDT, 16 * (2 * rg + 1) + r, 144, 32 * s2, q), bd, S1); }
#pragma unroll
        for (int reg = 0; reg < 4; ++reg) YRAW[(size_t)(row0 + c * 64 + 16 * rg + 4 * q + reg) * 2048 + h * 128 + v0 + r] = f2bf(Y[reg]);
        SF[rg * 64 + lane] = __builtin_bit_cast(u32x4, pack2(S0, S1));
        __syncthreads();
    };
#pragma nounroll
    for (int c = 0; c < 32; c += 2) { step(std::integral_constant<int, 0>{}, c, pfA); step(std::integral_constant<int, 1>{}, c + 1, pfB); }
#pragma unroll
    for (int reg = 0; reg < 4; ++reg) { sout[(16 * (2 * rg) + 4 * q + reg) * 128 + v0 + r] = S0[reg]; sout[(16 * (2 * rg + 1) + 4 * q + reg) * 128 + v0 + r] = S1[reg]; }
#undef GDN_LOAD
#undef GDN_STORE
}

DI void ret_scan(LAS unsigned char* lds, const unsigned char* blk0, bf16_t* YRAW, int row0, int h, float* sout, int tid) {
    asm volatile("" : "+v"(tid));
    const int lane = tid & 63, w = tid >> 6, r = lane & 15, q = lane >> 4, v0 = 16 * w;
    constexpr int RL = 46208;
    f32x4 S[4];
#pragma unroll
    for (int k = 0; k < 4; ++k) S[k] = (f32x4){0.f, 0.f, 0.f, 0.f};
    u32x4 pfA[6], pfB[6];
#define RET_STORE(pf, boff) do { _Pragma("unroll") for (int _k = 0; _k < 6; ++_k) { const int _i = tid + _k * 512; if (_i < RB_SIZE / 16) ((LAS u32x4*)(lds + (boff)))[_i] = pf[_k]; } } while (0)
    PF_LOAD(pfA, 6, blk0, RB_SIZE / 16);
    RET_STORE(pfA, 0);
    PF_LOAD(pfA, 6, blk0 + RB_SIZE, RB_SIZE / 16);
    PF_LOAD(pfB, 6, blk0 + 2 * (size_t)RB_SIZE, RB_SIZE / 16);
    __syncthreads();
    auto step = [&](auto BC, const int c, u32x4 (&pf)[6]) __attribute__((always_inline)) {
        constexpr int BUFC = decltype(BC)::value ? RL : 0, BUFN = RL - BUFC;
        const LAS unsigned char* bc = lds + BUFC;
        if (c + 1 < 32) RET_STORE(pf, BUFN);
        if (c + 3 < 32) PF_LOAD(pf, 6, blk0 + (size_t)(c + 3) * RB_SIZE, RB_SIZE / 16);
        const float e = *(const LAS float*)(bc + RB_SC);
        f32x4 Y[4];
#pragma unroll
        for (int m = 0; m < 4; ++m) Y[m] = (f32x4){0.f, 0.f, 0.f, 0.f};
#pragma unroll
        for (int s = 0; s < 2; ++s) { const bf16x8 bs = pack2(S[2 * s], S[2 * s + 1]);
#pragma unroll
            for (int m = 0; m < 4; ++m) Y[m] = MFMA16(lda_perm(bc + RB_QG, 16 * m + r, 144, 32 * s, q), bs, Y[m]); }
#pragma unroll
        for (int k = 0; k < 4; ++k) S[k] = S[k] * e;
#pragma unroll
        for (int s2 = 0; s2 < 2; ++s2) { const bf16x8 bv = lda_nat(bc + RB_VT, v0 + r, 144, 32 * s2, q);
#pragma unroll
            for (int m = 0; m < 4; ++m) Y[m] = MFMA16(lda_nat(bc + RB_P, 16 * m + r, 144, 32 * s2, q), bv, Y[m]);
#pragma unroll
            for (int k = 0; k < 4; ++k) S[k] = MFMA16(lda_nat(bc + RB_KDT, 16 * k + r, 144, 32 * s2, q), bv, S[k]); }
#pragma unroll
        for (int m = 0; m < 4; ++m)
#pragma unroll
            for (int reg = 0; reg < 4; ++reg) YRAW[(size_t)(row0 + c * 64 + 16 * m + 4 * q + reg) * 2048 + 512 + h * 128 + v0 + r] = f2bf(Y[m][reg]);
        __syncthreads();
    };
#pragma nounroll
    for (int c = 0; c < 32; c += 2) { step(std::integral_constant<int, 0>{}, c, pfA); step(std::integral_constant<int, 1>{}, c + 1, pfB); }
#pragma unroll
    for (int k = 0; k < 4; ++k)
#pragma unroll
        for (int reg = 0; reg < 4; ++reg) sout[(16 * k + 4 * q + reg) * 128 + v0 + r] = S[k][reg];
#undef RET_STORE
}

constexpr int SL_SIZE = SG_SIZE + SH_SIZE, SS_SF = 2 * SL_SIZE;
static_assert(SS_SF + 32768 <= LDS_BYTES - 32, "SSD scan LDS budget");
DI void ssd_scan(LAS unsigned char* lds, const unsigned char* gblk0, const unsigned char* hblk0, bf16_t* YRAW, int row0, int head, float* so, int tid) {
    asm volatile("" : "+v"(tid));
    const int lane = tid & 63, w = tid >> 6, r = lane & 15, q = lane >> 4, ct = w & 3, rh = w >> 2, p0 = 16 * ct;
    f32x4 S[4];
#pragma unroll
    for (int k = 0; k < 4; ++k) S[k] = (f32x4){0.f, 0.f, 0.f, 0.f};
    u32x4 pfA[7], pfB[7];
    constexpr int NG = SG_SIZE / 16, NV = NG + SH_SIZE / 16; static_assert(NV <= 7 * 512, "ssd staging");
#define SSD_LOAD(pf, cc) do { _Pragma("unroll") for (int _k = 0; _k < 7; ++_k) { const int _i = tid + _k * 512; if (_i < NG) pf[_k] = ((const u32x4*)(gblk0 + (size_t)(cc) * SG_SIZE))[_i]; \
        else if (_i < NV) pf[_k] = ((const u32x4*)(hblk0 + (size_t)(cc) * 2 * SH_SIZE))[_i - NG]; } } while (0)
#define SSD_STORE(pf, boff) do { _Pragma("unroll") for (int _k = 0; _k < 7; ++_k) { const int _i = tid + _k * 512; if (_i < NV) ((LAS u32x4*)(lds + (boff)))[_i] = pf[_k]; } } while (0)
    SSD_LOAD(pfA, 0);
    SSD_STORE(pfA, 0);
    SSD_LOAD(pfA, 1); SSD_LOAD(pfB, 2);
    LAS u32x4* SF = (LAS u32x4*)(lds + SS_SF) + ct * 4 * 64;
    SF[(2 * rh) * 64 + lane] = (u32x4){0u, 0u, 0u, 0u}; SF[(2 * rh + 1) * 64 + lane] = (u32x4){0u, 0u, 0u, 0u};
    __syncthreads();
    auto step = [&](auto BC, const int c, u32x4 (&pf)[7]) __attribute__((always_inline)) {
        constexpr int PAR = decltype(BC)::value, BUFC = PAR ? SL_SIZE : 0, BUFN = SL_SIZE - BUFC;
        const LAS unsigned char* bc = lds + BUFC;
        const LAS unsigned char* hd = bc + SG_SIZE;
        const LAS unsigned char* pp = hd + SH_PP;
        const LAS float* sx = (const LAS float*)(hd + SH_SC);
        LAS u32x4* SFc = SF + PAR * 1024; LAS u32x4* SFn = SF + (1 - PAR) * 1024;
        if (c + 1 < 32) SSD_STORE(pf, BUFN);
        if (c + 3 < 32) SSD_LOAD(pf, c + 3);
        const float e = sx[64 + 63];
        f32x4 Y[2];
#pragma unroll
        for (int mm = 0; mm < 2; ++mm) Y[mm] = (f32x4){0.f, 0.f, 0.f, 0.f};
#pragma unroll
        for (int s = 0; s < 4; ++s) { const bf16x8 bs = __builtin_bit_cast(bf16x8, SFc[s * 64 + lane]);
#pragma unroll
            for (int mm = 0; mm < 2; ++mm) Y[mm] = MFMA16(lda_perm(bc + SG_CM, 16 * (2 * rh + mm) + r, 272, 32 * s, q), bs, Y[mm]); }
#pragma unroll
        for (int mm = 0; mm < 2; ++mm)
#pragma unroll
            for (int reg = 0; reg < 4; ++reg) Y[mm][reg] *= sx[64 + 16 * (2 * rh + mm) + 4 * q + reg];
#pragma unroll
        for (int k = 0; k < 4; ++k) S[k] = S[k] * e;
#pragma unroll
        for (int s2 = 0; s2 < 2; ++s2) { const bf16x8 bx = lda_nat(hd + SH_XT, p0 + r, 144, 32 * s2, q);
#pragma unroll
            for (int mm = 0; mm < 2; ++mm) Y[mm] = MFMA16(lda_nat(pp, 16 * (2 * rh + mm) + r, 144, 32 * s2, q), bx, Y[mm]);
            const u32x4 xu = __builtin_bit_cast(u32x4, bx); u32x4 xs;
            const LAS float* wj = sx + 32 * s2 + 8 * q;
            xs.x = pk(bflo(xu.x) * wj[0], bfhi(xu.x) * wj[1]); xs.y = pk(bflo(xu.y) * wj[2], bfhi(xu.y) * wj[3]);
            xs.z = pk(bflo(xu.z) * wj[4], bfhi(xu.z) * wj[5]); xs.w = pk(bflo(xu.w) * wj[6], bfhi(xu.w) * wj[7]);
            const bf16x8 bx2 = __builtin_bit_cast(bf16x8, xs);
#pragma unroll
            for (int k = 0; k < 4; ++k) S[k] = MFMA16(lda_nat(bc + SG_BT, 16 * (4 * rh + k) + r, 144, 32 * s2, q), bx2, S[k]); }
#pragma unroll
        for (int mm = 0; mm < 2; ++mm)
#pragma unroll
            for (int reg = 0; reg < 4; ++reg) YRAW[(size_t)(row0 + c * 64 + 16 * (2 * rh + mm) + 4 * q + reg) * 2048 + head * 64 + p0 + r] = f2bf(Y[mm][reg]);
        SFn[(2 * rh) * 64 + lane] = __builtin_bit_cast(u32x4, pack2(S[0], S[1])); SFn[(2 * rh + 1) * 64 + lane] = __builtin_bit_cast(u32x4, pack2(S[2], S[3]));
        __syncthreads();
    };
#pragma nounroll
    for (int c = 0; c < 32; c += 2) { step(std::integral_constant<int, 0>{}, c, pfA); step(std::integral_constant<int, 1>{}, c + 1, pfB); }
#pragma unroll
    for (int k = 0; k < 4; ++k)
#pragma unroll
        for (int reg = 0; reg < 4; ++reg) so[(16 * (4 * rh + k) + 4 * q + reg) * 64 + p0 + r] = S[k][reg];
#undef SSD_LOAD
#undef SSD_STORE
}

constexpr int XB_STEAL = 3520;
DI int steal_unit(unsigned* ctr, LAS unsigned char* lds, int tid) {
    __syncthreads();
    if (tid == 0) *(LAS int*)(lds + LDS_BYTES - 32) = (int)__hip_atomic_fetch_add(ctr, 1u, __ATOMIC_RELAXED, __HIP_MEMORY_SCOPE_AGENT);
    __syncthreads();
    return *(const LAS int*)(lds + LDS_BYTES - 32);
}
DI void gdn_sample_unit(LAS unsigned char* lds, const Params& p, int li, int s, int h, int tid) {
    asm volatile("" : "+v"(tid));
    const int lane = tid & 63, w = tid >> 6, row = TP + s;
    const bf16_t* pr = (const bf16_t*)(p.ws + WS_PROJ) + (size_t)row * NH;
    LAS float* qkv = (LAS float*)lds; LAS float* red = qkv + 384;
    const float* cbuf = p.in[3] + (size_t)(li * 128 + s) * 3 * 1536; float* cout = p.out + O_SGC + (size_t)(li * 128 + s) * 3 * 1536;
    const float* cwp = p.in[11] + (size_t)li * 4 * 1536;
    if (tid < 384) { const int grp = tid >> 7, cl = tid & 127, ch = grp * 512 + h * 128 + cl;
        const float x = bf2f(pr[ch]), b0 = cbuf[ch], b1 = cbuf[1536 + ch], b2 = cbuf[3072 + ch];
        const float o = b0 * cwp[ch] + b1 * cwp[1536 + ch] + b2 * cwp[3072 + ch] + x * cwp[4608 + ch];
        qkv[tid] = siluf(o); cout[ch] = b1; cout[1536 + ch] = b2; cout[3072 + ch] = x; }
    __syncthreads();
    const float qa = qkv[2 * lane], qb = qkv[2 * lane + 1], ka = qkv[128 + 2 * lane], kb = qkv[128 + 2 * lane + 1];
    const float rq = rsqrtf(wsum(qa * qa + qb * qb) + 1e-6f) * 0.08838834764831845f, rk = rsqrtf(wsum(ka * ka + kb * kb) + 1e-6f);
    const float beta = 1.f / (1.f + __expf(-bf2f(pr[2048 + h])));
    const float g = -__expf(p.in[12][li * 4 + h]) * softplusf(bf2f(pr[2052 + h]) + p.in[13][li * 4 + h]);
    const float e = __expf(g);
    const size_t sidx = ((size_t)(li * 128 + s) * 4 + h) * 128 * 128;
    const float* Sin = p.in[2] + sidx; float* Sout = p.out + O_SGDN + sidx;
    f32x2 Sr[16]; float a0 = 0.f, a1 = 0.f;
#pragma unroll
    for (int rr = 0; rr < 16; ++rr) { Sr[rr] = __builtin_nontemporal_load((const f32x2*)(Sin + (16 * w + rr) * 128 + 2 * lane)) * e; const float kn = qkv[128 + 16 * w + rr] * rk; a0 += kn * Sr[rr][0]; a1 += kn * Sr[rr][1]; }
    red[w * 128 + 2 * lane] = a0; red[w * 128 + 2 * lane + 1] = a1;
    __syncthreads();
    a0 = 0.f; a1 = 0.f;
#pragma unroll
    for (int ww = 0; ww < 8; ++ww) { a0 += red[ww * 128 + 2 * lane]; a1 += red[ww * 128 + 2 * lane + 1]; }
    const float d0 = beta * (qkv[256 + 2 * lane] - a0), d1 = beta * (qkv[256 + 2 * lane + 1] - a1);
    __syncthreads();
    float y0 = 0.f, y1 = 0.f;
#pragma unroll
    for (int rr = 0; rr < 16; ++rr) { const float kn = qkv[128 + 16 * w + rr] * rk, qn = qkv[16 * w + rr] * rq;
        Sr[rr][0] += kn * d0; Sr[rr][1] += kn * d1; y0 += qn * Sr[rr][0]; y1 += qn * Sr[rr][1];
        __builtin_nontemporal_store(Sr[rr], (f32x2*)(Sout + (16 * w + rr) * 128 + 2 * lane)); }
    red[w * 128 + 2 * lane] = y0; red[w * 128 + 2 * lane + 1] = y1;
    __syncthreads();
    if (w == 0) { y0 = 0.f; y1 = 0.f;
#pragma unroll
        for (int ww = 0; ww < 8; ++ww) { y0 += red[ww * 128 + 2 * lane]; y1 += red[ww * 128 + 2 * lane + 1]; }
        *(unsigned*)((bf16_t*)(p.ws + WS_YRAW) + (size_t)row * 2048 + h * 128 + 2 * lane) = pk(y0, y1); }
    __syncthreads();
}
DI void ret_sample_unit(LAS unsigned char* lds, const Params& p, int li, int s, int h, int tid) {
    asm volatile("" : "+v"(tid));
    const int lane = tid & 63, w = tid >> 6, row = TP + s;
    const bf16_t* pr = (const bf16_t*)(p.ws + WS_PROJ) + (size_t)row * NH;
    LAS float* qk = (LAS float*)lds; LAS float* red = qk + 128;
    if (tid < 64) { const int f = tid & 31, which = tid >> 5, base = (which ? 2312 : 2056) + h * 64;
        const float x1 = bf2f(pr[base + f]), x2 = bf2f(pr[base + 32 + f]);
        float sn, cs; rot_sincos(16384.f, f, sn, cs);
        float o1 = x1 * cs - x2 * sn, o2 = x2 * cs + x1 * sn;
        if (which) { o1 *= 0.125f; o2 *= 0.125f; }
        qk[which * 64 + f] = o1; qk[which * 64 + 32 + f] = o2; }
    __syncthreads();
    const float gam = 1.f - exp2f(-5.f - (float)h);
    const unsigned vu = *(const unsigned*)(pr + 2568 + h * 128 + 2 * lane);
    const float va = bflo(vu), vb = bfhi(vu);
    const size_t sidx = ((size_t)(li * 128 + s) * 4 + h) * 64 * 128;
    const float* Sin = p.in[4] + sidx; float* Sout = p.out + O_SRET + sidx;
    float y0 = 0.f, y1 = 0.f;
#pragma unroll
    for (int rr = 0; rr < 8; ++rr) { const int k = 8 * w + rr; f32x2 sv = __builtin_nontemporal_load((const f32x2*)(Sin + k * 128 + 2 * lane)) * gam; const float kk = qk[64 + k], qq = qk[k];
        sv[0] += kk * va; sv[1] += kk * vb; y0 += qq * sv[0]; y1 += qq * sv[1]; __builtin_nontemporal_store(sv, (f32x2*)(Sout + k * 128 + 2 * lane)); }
    red[w * 128 + 2 * lane] = y0; red[w * 128 + 2 * lane + 1] = y1;
    __syncthreads();
    if (w == 0) { y0 = 0.f; y1 = 0.f;
#pragma unroll
        for (int ww = 0; ww < 8; ++ww) { y0 += red[ww * 128 + 2 * lane]; y1 += red[ww * 128 + 2 * lane + 1]; }
        *(unsigned*)((bf16_t*)(p.ws + WS_YRAW) + (size_t)row * 2048 + 512 + h * 128 + 2 * lane) = pk(y0, y1); }
    __syncthreads();
}
DI void ssd_sample_unit(LAS unsigned char* lds, const Params& p, int li, int s, int g, int tid) {
    asm volatile("" : "+v"(tid));
    const int lane = tid & 63, w = tid >> 6, row = TP + s, pq = lane & 15, nq = lane >> 4;
    const bf16_t* pr = (const bf16_t*)(p.ws + WS_PROJ) + (size_t)row * NS;
    LAS float* xs = (LAS float*)lds; LAS float* Bv = xs + 512; LAS float* Cv = xs + 640;
    const float* cbuf = p.in[6] + (size_t)(li * 128 + s) * 3 * 3072; float* cout = p.out + O_SSC + (size_t)(li * 128 + s) * 3 * 3072;
    const float* cwp = p.in[18] + (size_t)li * 4 * 3072; const float* cbp = p.in[19] + (size_t)li * 3072;
    const int head = g * 8 + w;
    const size_t sidx = ((size_t)(li * 128 + s) * 32 + head) * 128 * 64;
    const f32x4* Sin4 = (const f32x4*)(p.in[5] + sidx); f32x4* Sout4 = (f32x4*)(p.out + O_SSSM + sidx);
    f32x4 sb[2][8];
#pragma unroll
    for (int j = 0; j < 8; ++j) sb[0][j] = __builtin_nontemporal_load(Sin4 + j * 64 + lane);
    {
        float xv_[2], b0_[2], b1_[2], b2_[2], w_[2][5]; int ch_[2];
#pragma unroll
        for (int it = 0; it < 2; ++it) { const int t = tid + it * 512; const bool ok = t < 768; const int tc = ok ? t : 0;
            const int ch = tc < 512 ? g * 512 + tc : (tc < 640 ? 2048 + g * 128 + (tc - 512) : 2560 + g * 128 + (tc - 640)); ch_[it] = ch;
            xv_[it] = bf2f(pr[2048 + ch]); b0_[it] = cbuf[ch]; b1_[it] = cbuf[3072 + ch]; b2_[it] = cbuf[6144 + ch];
            w_[it][0] = cwp[ch]; w_[it][1] = cwp[3072 + ch]; w_[it][2] = cwp[6144 + ch]; w_[it][3] = cwp[9216 + ch]; w_[it][4] = cbp[ch]; }
#pragma unroll
        for (int it = 0; it < 2; ++it) { const int t = tid + it * 512; if (t < 768) { const int ch = ch_[it];
            const float o = w_[it][4] + b0_[it] * w_[it][0] + b1_[it] * w_[it][1] + b2_[it] * w_[it][2] + xv_[it] * w_[it][3];
            xs[t] = siluf(o); cout[ch] = b1_[it]; cout[3072 + ch] = b2_[it]; cout[6144 + ch] = xv_[it]; } }
    }
    __syncthreads();
    const float dt = softplusf(bf2f(pr[5120 + head]) + p.in[20][li * 32 + head]);
    const float e = __expf(-__expf(p.in[21][li * 32 + head]) * dt);
    const f32x4 xv = *(const LAS f32x4*)(xs + w * 64 + 4 * pq), xd = xv * dt;
    f32x4 y = (f32x4){0.f, 0.f, 0.f, 0.f};
#pragma unroll
    for (int b = 0; b < 4; ++b) {
        if (b < 3) {
#pragma unroll
            for (int j = 0; j < 8; ++j) sb[(b + 1) & 1][j] = __builtin_nontemporal_load(Sin4 + ((b + 1) * 8 + j) * 64 + lane); }
#pragma unroll
        for (int j = 0; j < 8; ++j) { const int n = 4 * (b * 8 + j) + nq; const f32x4 v = sb[b & 1][j] * e + xd * Bv[n]; y = y + v * Cv[n]; __builtin_nontemporal_store(v, Sout4 + (b * 8 + j) * 64 + lane); }
    }
#pragma unroll
    for (int j = 0; j < 4; ++j) { y[j] += __shfl_xor(y[j], 16); y[j] += __shfl_xor(y[j], 32); }
    y = y + xv * p.in[22][li * 32 + head];
    if (nq == 0) { u32x2 o; o.x = pk(y[0], y[1]); o.y = pk(y[2], y[3]); *(u32x2*)((bf16_t*)(p.ws + WS_YRAW) + (size_t)row * 2048 + head * 64 + 4 * pq) = o; }
    __syncthreads();
}

DI void gate_hyb(const Params& p, int li, int gw, int ngw, int lane) {
    const bf16_t* YR = (const bf16_t*)(p.ws + WS_YRAW); const bf16_t* PROJ = (const bf16_t*)(p.ws + WS_PROJ); bf16_t* MIX = (bf16_t*)(p.ws + WS_MIX);
    const int cl = 8 * (lane & 15), h = lane >> 4;
    f32x4 ga[2], ra[2];
    ga[0] = *(const f32x4*)(p.in[14] + li * 128 + cl); ga[1] = *(const f32x4*)(p.in[14] + li * 128 + cl + 4);
    ra[0] = *(const f32x4*)(p.in[15] + li * 512 + h * 128 + cl); ra[1] = *(const f32x4*)(p.in[15] + li * 512 + h * 128 + cl + 4);
    for (int it0 = gw * 2; it0 < TR * 2; it0 += ngw * 2) {
        u32x4 ya[2], za[2];
#pragma unroll
        for (int rr = 0; rr < 2; ++rr) { const int it = it0 + rr, m = it >> 1, half = it & 1;
            ya[rr] = *(const u32x4*)(YR + (size_t)m * 2048 + half * 512 + h * 128 + cl);
            za[rr] = *(const u32x4*)(PROJ + (size_t)m * NH + (half ? 3080 : 1536) + h * 128 + cl); }
#pragma unroll
        for (int rr = 0; rr < 2; ++rr) { const int it = it0 + rr, m = it >> 1, half = it & 1;
            const unsigned yu[4] = {ya[rr].x, ya[rr].y, ya[rr].z, ya[rr].w}, zu[4] = {za[rr].x, za[rr].y, za[rr].z, za[rr].w};
            float v[8], z[8]; float s1 = 0.f;
#pragma unroll
            for (int j = 0; j < 4; ++j) { v[2 * j] = bflo(yu[j]); v[2 * j + 1] = bfhi(yu[j]); z[2 * j] = bflo(zu[j]); z[2 * j + 1] = bfhi(zu[j]); s1 += v[2 * j] + v[2 * j + 1]; }
            float mean = 0.f;
            if (half) { s1 += __shfl_xor(s1, 1); s1 += __shfl_xor(s1, 2); s1 += __shfl_xor(s1, 4); s1 += __shfl_xor(s1, 8); mean = s1 * (1.f / 128.f); }
            float ss = 0.f;
#pragma unroll
            for (int j = 0; j < 8; ++j) { v[j] -= mean; ss += v[j] * v[j]; }
            ss += __shfl_xor(ss, 1); ss += __shfl_xor(ss, 2); ss += __shfl_xor(ss, 4); ss += __shfl_xor(ss, 8);
            const float rs = rsqrtf(ss * (1.f / 128.f) + 1e-6f);
            float o[8];
#pragma unroll
            for (int j = 0; j < 8; ++j) { const float gn = half ? ra[j >> 2][j & 3] : ga[j >> 2][j & 3]; o[j] = v[j] * rs * gn * siluf(z[j]); }
            u32x4 w; w.x = pk(o[0], o[1]); w.y = pk(o[2], o[3]); w.z = pk(o[4], o[5]); w.w = pk(o[6], o[7]);
            *(u32x4*)(MIX + (size_t)m * 1024 + half * 512 + h * 128 + cl) = w; }
    }
    for (int idx = gw * 64 + lane; idx < 8 * 3 * 1536; idx += ngw * 64) { const int ch = idx % 1536, rr = (idx / 1536) % 3, b = idx / (3 * 1536);
        p.out[O_PGC + (size_t)(li * 8 + b) * 3 * 1536 + rr * 1536 + ch] = bf2f(PROJ[(size_t)(b * SEQ + SEQ - 3 + rr) * NH + ch]); }
}
DI void gate_ssm(const Params& p, int li, int gw, int ngw, int lane) {
    const bf16_t* YR = (const bf16_t*)(p.ws + WS_YRAW); const bf16_t* PROJ = (const bf16_t*)(p.ws + WS_PROJ); bf16_t* MIX = (bf16_t*)(p.ws + WS_MIX);
    const float* nw = p.in[23] + li * 2048;
    for (int m = gw; m < TR; m += ngw) {
        const bf16_t* yr = YR + (size_t)m * 2048; const bf16_t* pr = PROJ + (size_t)m * NS; bf16_t* mx = MIX + (size_t)m * 2048;
        u32x4 ua[4], za[4];
#pragma unroll
        for (int g = 0; g < 4; ++g) { ua[g] = *(const u32x4*)(yr + g * 512 + 8 * lane); za[g] = *(const u32x4*)(pr + g * 512 + 8 * lane); }
#pragma unroll
        for (int g = 0; g < 4; ++g) {
            const u32x4 u = ua[g], z = za[g];
            float v[8]; const unsigned uu[4] = {u.x, u.y, u.z, u.w}, zz[4] = {z.x, z.y, z.z, z.w}; float ss = 0.f;
#pragma unroll
            for (int j = 0; j < 4; ++j) { v[2 * j] = bflo(uu[j]) * siluf(bflo(zz[j])); v[2 * j + 1] = bfhi(uu[j]) * siluf(bfhi(zz[j])); ss += v[2 * j] * v[2 * j] + v[2 * j + 1] * v[2 * j + 1]; }
            const float rs = rsqrtf(wsum(ss) * (1.f / 512.f) + 1e-6f);
            const f32x4 w0 = *(const f32x4*)(nw + g * 512 + 8 * lane), w1 = *(const f32x4*)(nw + g * 512 + 8 * lane + 4);
            u32x4 o; o.x = pk(v[0] * rs * w0[0], v[1] * rs * w0[1]); o.y = pk(v[2] * rs * w0[2], v[3] * rs * w0[3]); o.z = pk(v[4] * rs * w1[0], v[5] * rs * w1[1]); o.w = pk(v[6] * rs * w1[2], v[7] * rs * w1[3]);
            *(u32x4*)(mx + g * 512 + 8 * lane) = o;
        }
    }
    for (int idx = gw * 64 + lane; idx < 8 * 3 * 3072; idx += ngw * 64) { const int ch = idx % 3072, rr = (idx / 3072) % 3, b = idx / (3 * 3072);
        p.out[O_PSC + (size_t)(li * 8 + b) * 3 * 3072 + rr * 3072 + ch] = bf2f(PROJ[(size_t)(b * SEQ + SEQ - 3 + rr) * NS + 2048 + ch]); }
}

struct EpiBR {
    static constexpr bool PERM = true, AFTER_DRAIN = false;
    bf16_t* O; int ldc; int act;
    DI void operator()(const f32x4 (&acc)[2][2][4][2], const pg8::Unit& u, int wr, int wc, int fr, int fq) const {
        const int row0 = u.pm * 256 + wr * 64 + fr, col0 = u.pn * 256 + wc * 32 + 8 * fq;
#pragma unroll
        for (int ai = 0; ai < 2; ++ai)
#pragma unroll
            for (int m = 0; m < 4; ++m) { bf16_t* rowp = O + (size_t)(row0 + ai * 128 + m * 16) * ldc + col0;
#pragma unroll
                for (int bj = 0; bj < 2; ++bj) { f32x4 v0 = acc[ai][bj][m][0], v1 = acc[ai][bj][m][1];
                    if (act) {
#pragma unroll
                        for (int j = 0; j < 4; ++j) { const float a = fmaxf(v0[j], 0.f), b = fmaxf(v1[j], 0.f); v0[j] = a * a; v1[j] = b * b; } }
                    u32x4 w; w.x = pk(v0[0], v0[1]); w.y = pk(v0[2], v0[3]); w.z = pk(v1[0], v1[1]); w.w = pk(v1[2], v1[3]);
                    *(u32x4*)(rowp + bj * 128) = w; } }
    }
};
template <int EPI> DI void skinny_tile(LAS unsigned char* lds, const bf16_t* A, const bf16_t* Bt, const int Kext, void* outp, const int ldc, int tid, const int lda = 0) {
    asm volatile("" : "+v"(tid));
    const int lane = tid & 63, w = tid >> 6, r = lane & 15, q = lane >> 4;
    const int K = lda ? lda : Kext;
    constexpr int kw = 128; (void)Kext;
    f32x4 acc[8];
#pragma unroll
    for (int m = 0; m < 8; ++m) acc[m] = (f32x4){0.f, 0.f, 0.f, 0.f};
    const bf16_t* ap = A + (size_t)r * K + w * kw + 8 * q; const bf16_t* bp = Bt + (size_t)r * K + w * kw + 8 * q;
#pragma unroll
    for (int k0 = 0; k0 < kw; k0 += 32) {
        const bf16x8 b = *(const bf16x8*)(bp + k0);
#pragma unroll
        for (int m = 0; m < 8; ++m) acc[m] = MFMA16(*(const bf16x8*)(ap + (size_t)(16 * m) * K + k0), b, acc[m]);
    }
    LAS float* part = (LAS float*)lds;
#pragma unroll
    for (int m = 0; m < 8; ++m)
#pragma unroll
        for (int reg = 0; reg < 4; ++reg) part[(w * 128 + 16 * m + 4 * q + reg) * 16 + r] = acc[m][reg];
    __syncthreads();
    const int row = tid >> 2, c4 = (tid & 3) * 4;
    f32x4 sum = (f32x4){0.f, 0.f, 0.f, 0.f};
#pragma unroll
    for (int ww = 0; ww < 8; ++ww) sum = sum + *(const LAS f32x4*)(part + (ww * 128 + row) * 16 + c4);
    if (EPI == 2) { f32x4* o = (f32x4*)((float*)outp + (size_t)row * ldc + c4); *o = *o + sum; }
    else if (EPI == 3) { float* o = (float*)outp + (size_t)row * ldc + c4;
#pragma unroll
        for (int j = 0; j < 4; ++j) (void)__hip_atomic_fetch_add(o + j, sum[j], __ATOMIC_RELAXED, __HIP_MEMORY_SCOPE_AGENT); }
    else { if (EPI == 1) {
#pragma unroll
            for (int j = 0; j < 4; ++j) { const float a = fmaxf(sum[j], 0.f); sum[j] = a * a; } }
        u32x2 o; o.x = pk(sum[0], sum[1]); o.y = pk(sum[2], sum[3]); *(u32x2*)((bf16_t*)outp + (size_t)row * ldc + c4) = o; }
    __syncthreads();
}

template <int KIND, bool hyb> DI void run_phase(const Params& P, LAS unsigned char* lds, const int L, const int tid, const int bid, const int G) {
    const int lane = tid & 63, wv = tid >> 6, gw = bid * 8 + wv, ngw = G * 8, li = L >> 1;
    unsigned char* ws = P.ws;
    bf16_t* H = (bf16_t*)(ws + WS_H); bf16_t* PROJ = (bf16_t*)(ws + WS_PROJ); bf16_t* YRAW = (bf16_t*)(ws + WS_YRAW); bf16_t* MIX = (bf16_t*)(ws + WS_MIX); bf16_t* ACT = (bf16_t*)(ws + WS_ACT);
    float* X = (float*)(ws + WS_X);
    if constexpr (KIND == 0) prologue(P, lds, gw, ngw, wv, lane);
    if constexpr (KIND == 1) norm_rows(P, P.in[7] + L * D, L == 0, gw, ngw, lane);
    if constexpr (KIND == 7) norm_rows(P, P.in[8] + L * D, false, gw, ngw, lane);
    if constexpr (KIND == 2 || KIND == 8) {
        constexpr bool up = KIND == 8;
        const bf16_t* Bt = up ? (const bf16_t*)(ws + WS_W1) + (size_t)L * FF * 1024 : (hyb ? (const bf16_t*)(ws + WS_WINH) + (size_t)li * NH * 1024 : (const bf16_t*)(ws + WS_WINS) + (size_t)li * NS * 1024);
        constexpr int N = up ? FF : (hyb ? NH : NS), NMAIN = up ? FF : (hyb ? NH : 5120);
        pg8::Gemm g{H, Bt, TP, NMAIN, 1024}; pg8::StaticOrder S; S.init(TP, NMAIN, G, bid); EpiB<up ? 1 : 0> E{up ? ACT : PROJ, N};
        pg8::gemm_phase<EpiB<up ? 1 : 0>, pg8::StaticOrder>((PG8_LAS unsigned char*)lds, g, S, E, nullptr, tid);
        constexpr int NCB = up ? FF / 16 : (hyb ? (NHR + 15) / 16 : NSR / 16);
        constexpr int NT = NCB + ((!up && !hyb) ? 256 : 0);
        const int nw = (!up && hyb) ? 64 : G;
        const int first = G - 1 - bid;
        if (first < nw) {
#pragma nounroll
            for (int t = first; t < NT; t += nw) {
                if (t < NCB) skinny_tile<up ? 1 : 0>(lds, H + (size_t)TP * 1024, Bt + (size_t)t * 16 * 1024, 1024, (up ? ACT : PROJ) + (size_t)TP * N + t * 16, N, tid);
                else { const int t2 = t - NCB, rb = t2 >> 1, cb = t2 & 1;
                    skinny_tile<0>(lds, H + (size_t)rb * 128 * 1024, Bt + (size_t)(5120 + cb * 16) * 1024, 1024, PROJ + (size_t)rb * 128 * N + 5120 + cb * 16, N, tid); }
            }
        }
    }
    if constexpr (KIND == 6 || KIND == 9) {
        constexpr bool dn = KIND == 9;
        const bf16_t* Bt = dn ? (const bf16_t*)(ws + WS_W2) + (size_t)L * 1024 * FF : (hyb ? (const bf16_t*)(ws + WS_WOUTH) + (size_t)li * 1024 * 1024 : (const bf16_t*)(ws + WS_WOUTS) + (size_t)li * 1024 * 2048);
        constexpr int K = dn ? FF : (hyb ? 1024 : 2048);
        pg8::Gemm g{dn ? ACT : MIX, Bt, TP, 1024, K}; pg8::StaticOrder S; S.init(TP, 1024, G, bid); EpiRes E{(bf16_t*)(ws + WS_X)};
        pg8::gemm_phase<EpiRes, pg8::StaticOrder>((PG8_LAS unsigned char*)lds, g, S, E, nullptr, tid);
        const int first = G - 1 - bid;
        constexpr int KS = K / 1024;
#pragma nounroll
        for (int t = first; t < 64 * KS; t += G) { const int ct = t / KS, ks = t % KS;
            skinny_tile<3>(lds, (dn ? ACT : MIX) + (size_t)TP * K + ks * 1024, Bt + (size_t)ct * 16 * K + ks * 1024, 1024, (float*)(ws + WS_XS) + ct * 16, 1024, tid, K); }
    }
    if constexpr (KIND == 3) {
        if constexpr (hyb) {
#pragma nounroll
            for (int u = bid; u < 1024; u += G) { const int b = u >> 7, c = (u >> 2) & 31, h = u & 3;
                gdn_prep_unit(lds, PROJ, P.in[11] + (size_t)li * 4 * 1536, P.in[12][li * 4 + h], P.in[13][li * 4 + h], ws + WS_CHK + CHK_GDN + (size_t)((b * 4 + h) * 32 + c) * GB_SIZE, b * SEQ + c * 64, h, tid); }
#ifdef PROBE_GDNPREP
#pragma nounroll
            for (int u = bid; u < 1024; u += G) { const int b = u >> 7, c = (u >> 2) & 31, h = u & 3;
                gdn_prep_unit(lds, PROJ, P.in[11] + (size_t)li * 4 * 1536, P.in[12][li * 4 + h], P.in[13][li * 4 + h], ws + WS_CHK + CHK_GDN + (size_t)((b * 4 + h) * 32 + c) * GB_SIZE, b * SEQ + c * 64, h, tid); }
#endif
#pragma nounroll
            for (int u2 = bid; u2 < 1024; u2 += G) { const int b = u2 >> 7, c = (u2 >> 2) & 31, h = u2 & 3;
                ret_prep_unit(lds, PROJ, ws + WS_CHK + CHK_RET + (size_t)((b * 4 + h) * 32 + c) * RB_SIZE, b * SEQ + c * 64, h, tid); }
        } else {
            for (int u = bid; u < 1024; u += G) { const int b = u >> 7, c = (u >> 2) & 31, g = u & 3;
                ssd_prep_unit(lds, PROJ, P.in[18] + (size_t)li * 4 * 3072, P.in[19] + (size_t)li * 3072, P.in[20] + li * 32, P.in[21] + li * 32, P.in[22] + li * 32,
                              ws + WS_CHK + CHK_SG + (size_t)((b * 4 + g) * 32 + c) * SG_SIZE, ws + WS_CHK + CHK_SH + (size_t)(((b * 16 + 4 * g) * 32 + c) * 2) * SH_SIZE, b * SEQ + c * 64, g, tid); }
        }
    }
    if constexpr (KIND == 4) {
        if constexpr (hyb) {
            if (bid < 128) { const int xq = bid & 7, jq = bid >> 3, bh = xq * 4 + (jq >> 2), b = bh >> 2, h = bh & 3;
                gdn_scan(lds, ws + WS_CHK + CHK_GDN + (size_t)((b * 4 + h) * 32) * GB_SIZE, YRAW, b * SEQ, h, P.out + O_PGDN + (size_t)((li * 8 + b) * 4 + h) * 128 * 128, tid, jq & 3); }
            else if (bid < 160) { const int b = (bid - 128) >> 2, h = bid & 3;
                ret_scan(lds, ws + WS_CHK + CHK_RET + (size_t)((b * 4 + h) * 32) * RB_SIZE, YRAW, b * SEQ, h, P.out + O_PRET + (size_t)((li * 8 + b) * 4 + h) * 64 * 128, tid); }
            for (;;) { const int u = steal_unit((unsigned*)(ws + WS_BAR) + XB_STEAL + 64 * L, lds, tid); if (u >= 1024) break;
                if (u < 512) gdn_sample_unit(lds, P, li, u >> 2, u & 3, tid); else ret_sample_unit(lds, P, li, (u - 512) >> 2, u & 3, tid); }
        } else {
#pragma nounroll
            for (int unit = bid; unit < 256; unit += G) { const int xq = unit & 7, jq = unit >> 3, grp = xq * 4 + (jq >> 3), b = grp >> 2, g = grp & 3, head = g * 8 + (jq & 7), u = head >> 1;
                ssd_scan(lds, ws + WS_CHK + CHK_SG + (size_t)((b * 4 + g) * 32) * SG_SIZE, ws + WS_CHK + CHK_SH + (size_t)(((b * 16 + u) * 32) * 2 + (head & 1)) * SH_SIZE, YRAW, b * SEQ, head,
                         P.out + O_PSSM + (size_t)((li * 8 + b) * 32 + head) * 128 * 64, tid); }
            for (;;) { const int u = steal_unit((unsigned*)(ws + WS_BAR) + XB_STEAL + 64 * L, lds, tid); if (u >= 512) break; ssd_sample_unit(lds, P, li, u >> 2, u & 3, tid); }
        }
    }
    if constexpr (KIND == 5) { if constexpr (hyb) gate_hyb(P, li, gw, ngw, lane); else gate_ssm(P, li, gw, ngw, lane); }
    if constexpr (KIND == 10) final_norm(P, gw, ngw, lane);
}
constexpr int LDS_ST = LDS_BYTES - 16;
template <int PH> DI void do_phase(const Params& p, cg::grid_group& grid, const int wid_s) {
    constexpr int kind = PH == 37 ? 10 : (PH == 0 ? 0 : 1 + (PH - 1) % 9), L = (PH == 0 || PH == 37) ? 0 : (PH - 1) / 9;
    constexpr bool hyb = (L & 1) == 0, hsel = (kind == 2 || kind == 3 || kind == 4 || kind == 5 || kind == 6) ? hyb : true;
    extern __shared__ __attribute__((aligned(16))) unsigned char smem[];
    int tid; asm volatile("v_mbcnt_lo_u32_b32 %0, -1, 0\n\tv_mbcnt_hi_u32_b32 %0, -1, %0" : "=v"(tid)); tid += wid_s * 64;
    unsigned lbase = 0; asm volatile("" : "+v"(lbase));
    LAS unsigned char* lds = (LAS unsigned char*)smem + lbase;
    int bid = blockIdx.x; asm volatile("" : "+s"(bid));
    int Gr = (int)gridDim.x; asm volatile("" : "+s"(Gr));
    run_phase<kind, hsel>(p, lds, L, tid, bid, Gr);
#ifdef PROBE_DUP
    if constexpr ((((PROBE_DUP) >> kind) & 1) && (PROBE_HYB == 2 || (PROBE_HYB == 1) == hyb)) { __syncthreads(); asm volatile("" : "+v"(tid)); run_phase<kind, hsel>(p, lds, L, tid, bid, Gr); }
#endif
    if (PH == 0) grid.sync();
    else if (PH < 37) { XcdBarrier b; b.bar = (unsigned*)(p.ws + WS_BAR); b.x = xb_xcc_id(); b.wid = wid_s; b.st = (volatile LAS unsigned*)((LAS unsigned char*)smem + LDS_ST); xcd_barrier(b); }
}
template <int... PH> DI void all_phases(const Params& p, cg::grid_group& grid, const int wid_s, std::integer_sequence<int, PH...>) { (do_phase<PH>(p, grid, wid_s), ...); }
__global__ void __launch_bounds__(512, 2) fwd_megakernel(Params p) {
    extern __shared__ __attribute__((aligned(16))) unsigned char smem[];
    cg::grid_group grid = cg::this_grid();
    const int wid_s = __builtin_amdgcn_readfirstlane(threadIdx.x >> 6);
    if (threadIdx.x == 0) { volatile LAS unsigned* st = (volatile LAS unsigned*)((LAS unsigned char*)smem + LDS_ST); st[0] = 0u; st[1] = 0u; }
    __syncthreads();
    (void)xcd_barrier_post((unsigned*)(p.ws + WS_BAR), (volatile LAS unsigned*)((LAS unsigned char*)smem + LDS_ST), wid_s);
    all_phases(p, grid, wid_s, std::make_integer_sequence<int, 38>{});
}

extern "C" void kernel_launch(void* const* d_in, const int* in_sizes, int n_in, void* d_out, int out_size, void* d_ws, size_t ws_size, hipStream_t stream) {
    static int grid = 0;
    if (grid == 0) {
        if (n_in != 27 || ws_size < WS_END) { fprintf(stderr, "kernel_launch: bad inputs n_in=%d ws=%zu need %zu\n", n_in, ws_size, (size_t)WS_END); grid = -1; return; }
        int dev = 0, cus = 0, per_cu = 0;
        (void)hipGetDevice(&dev); (void)hipDeviceGetAttribute(&cus, hipDeviceAttributeMultiprocessorCount, dev);
        if (hipFuncSetAttribute((const void*)fwd_megakernel, hipFuncAttributeMaxDynamicSharedMemorySize, LDS_BYTES) != hipSuccess) { fprintf(stderr, "kernel_launch: hipFuncSetAttribute failed\n"); grid = -1; return; }
        (void)hipOccupancyMaxActiveBlocksPerMultiprocessor(&per_cu, (const void*)fwd_megakernel, 512, LDS_BYTES);
        if (per_cu < 1) { fprintf(stderr, "kernel_launch: occupancy query says %d blocks/CU\n", per_cu); per_cu = 1; }
        (void)hipGetLastError();
        grid = cus;
        if (grid < 192) fprintf(stderr, "kernel_launch: only %d CUs\n", grid);
    }
    if (grid < 0) return;
    Params p{};
    for (int i = 0; i < 27; ++i) p.in[i] = (const float*)d_in[i];
    p.out = (float*)d_out; p.ws = (unsigned char*)d_ws; p.ph_lo = 0; p.ph_hi = 38;
    if (hipMemsetAsync((char*)d_ws + WS_BAR, 0, 16384, stream) != hipSuccess) { fprintf(stderr, "kernel_launch: memset failed\n"); return; }
    void* args[] = {&p};
    hipError_t e = hipLaunchCooperativeKernel((const void*)fwd_megakernel, dim3(grid), dim3(512), args, LDS_BYTES, stream);
    if (e != hipSuccess) fprintf(stderr, "cooperative launch failed: %s (grid %d)\n", hipGetErrorString(e), grid);
}
```

```cpp
#include <hip/hip_runtime.h>
#include <hip/hip_cooperative_groups.h>
#include <cstdio>
#include <utility>
namespace cg = cooperative_groups;
namespace pg8 {
#define PG8_LAS __attribute__((address_space(3)))
typedef unsigned short bf16_t;
typedef short bf16x8 __attribute__((ext_vector_type(8)));
typedef float f32x4 __attribute__((ext_vector_type(4)));
typedef unsigned u32x4 __attribute__((ext_vector_type(4)));
constexpr int BM = 256, BK = 64, HALF = 128, HTB = HALF * BK * 2  , STAGE_BYTES = 8 * HTB, NXCD = 8, WGM = 8;

__host__ __device__ __forceinline__ int lds_byte(int r, int c) { const int st = (r >> 4) * 2 + (c >> 5), rr = r & 15, cc = c & 31, ob = rr * 64 + cc * 2; return st * 1024 + (ob ^ (((ob >> 9) & 1) << 5)); }
__host__ __device__ __forceinline__ void stage_rc(int b, int& R, int& C) { const int st = b / 1024, sb = b % 1024, swz = sb ^ (((sb >> 9) & 1) << 5); R = (st >> 1) * 16 + swz / 64; C = (st & 1) * 32 + (swz % 64) / 2; }
__host__ __device__ __forceinline__ int perm32(int rho) { const int n = rho >> 4, i = rho & 15; return 8 * (i >> 2) + 4 * n + (i & 3); }

struct Unit { int pm, pn; };
struct Gemm { const bf16_t* A; const bf16_t* Bt; int M, N, K; };

struct StaticOrder {
    int nM, nN, nwg, G, c;
    __host__ __device__ void init(int M, int N, int G_, int c_) { nM = M / BM; nN = N / BM; nwg = nM * nN; G = G_; c = c_; }
    __host__ __device__ bool next(int i, Unit& u) const {
        const long L = (long)i * G + c; if (L >= nwg) return false;
        int wgid = (int)L; { const int q = nwg / NXCD, r = nwg % NXCD, xcd = wgid % NXCD, off = wgid / NXCD; wgid = (xcd < r ? xcd * (q + 1) : r * (q + 1) + (xcd - r) * q) + off; }
        const int nig = WGM * nN, gid = wgid / nig, fm = gid * WGM, gsz = (nM - fm) < WGM ? (nM - fm) : WGM;
        u.pm = fm + ((wgid % nig) % gsz); u.pn = (wgid % nig) / gsz; return true;
    }
    __device__ __forceinline__ void a_ready(const Unit&) const {}
    __device__ __forceinline__ void done(const Unit&) const {}
};
template <class Epi, class Sched, bool STAMP = false>
__device__ __forceinline__ void gemm_phase(PG8_LAS unsigned char* lds, const Gemm g, const Sched& S, const Epi& E, unsigned long long* stamps, const int tid_in) {
    const int tid = tid_in, wid = __builtin_amdgcn_readfirstlane(tid >> 6), lane = tid & 63, wr = wid >> 2, wc = wid & 3, fr = lane & 15, fq = lane >> 4;
    const int K = g.K, nt = K / BK;
    int ts_lo = 0, ts_hi = 0, nts = 0; const unsigned long long rt_entry = STAMP ? (unsigned long long)wall_clock64() : 0ull;
#define PG8_STAMP() do { if (STAMP && wid == 0 && nts < 64) { const unsigned long long _c = (unsigned long long)clock64(); \
        ts_lo = (lane == nts) ? (int)(unsigned)_c : ts_lo; ts_hi = (lane == nts) ? (int)(unsigned)(_c >> 32) : ts_hi; ++nts; } } while (0)
    PG8_STAMP();
    unsigned voffA[2], voffB[2];
#pragma unroll
    for (int i = 0; i < 2; ++i) { int R, C; stage_rc(tid * 16 + i * 8192, R, C); const int Rb = Epi::PERM ? ((R & ~31) + perm32(R & 31)) : R;
        voffA[i] = (unsigned)(R * K + C) * 2u; voffB[i] = (unsigned)(Rb * K + C) * 2u; }
    const size_t kstep = (size_t)(BK * 2);
    const size_t hstep = (size_t)HALF * K * 2;
    const size_t tstep = 2 * hstep;
    const unsigned ldsw = (unsigned)wid * 1024u;
    const int aoff = lds_byte(wr * 64 + fr, fq * 8), boff = lds_byte(wc * 32 + fr, fq * 8);
#define PG8_SA(b, h) (((b) * 2 + (h)) * HTB)
#define PG8_SB(b, h) ((4 + (b) * 2 + (h)) * HTB)
#define PG8_STAGE(bufoff, gbase, voff) do { _Pragma("unroll") for (int _i = 0; _i < 2; ++_i) \
        __builtin_amdgcn_global_load_lds((const unsigned*)((const char*)(gbase) + (voff)[_i]), (PG8_LAS unsigned*)(lds + (bufoff) + ldsw + _i * 8192), 16, 0, 0); } while (0)
#define PG8_LDA(dst, b, h) do { _Pragma("unroll") for (int m = 0; m < 4; ++m) _Pragma("unroll") for (int k = 0; k < 2; ++k) dst[m][k] = *(const PG8_LAS bf16x8*)(lds + PG8_SA(b, h) + aoff + m * 2048 + k * 1024); } while (0)
#define PG8_LDB(dst, b, h) do { _Pragma("unroll") for (int n = 0; n < 2; ++n) _Pragma("unroll") for (int k = 0; k < 2; ++k) dst[n][k] = *(const PG8_LAS bf16x8*)(lds + PG8_SB(b, h) + boff + n * 2048 + k * 1024); } while (0)
#define PG8_MMA(ai, bj, At, Bt) do { __builtin_amdgcn_s_setprio(1); _Pragma("unroll") for (int m = 0; m < 4; ++m) _Pragma("unroll") for (int n = 0; n < 2; ++n) _Pragma("unroll") for (int k = 0; k < 2; ++k) \
        acc[ai][bj][m][n] = __builtin_amdgcn_mfma_f32_16x16x32_bf16(Bt[n][k], At[m][k], acc[ai][bj][m][n], 0, 0, 0); __builtin_amdgcn_s_setprio(0); } while (0)
#define PG8_WAIT_V(n) asm volatile("s_waitcnt vmcnt(" #n ")" ::: "memory")
#define PG8_WAIT_L(n) asm volatile("s_waitcnt lgkmcnt(" #n ")" ::: "memory")
#define PG8_BAR __builtin_amdgcn_s_barrier()
#define PG8_SCHED __builtin_amdgcn_sched_barrier(0)
    Unit cur, nxt; int ui = 0;
    if (!S.next(0, cur)) return;
    f32x4 acc[2][2][4][2];
#pragma unroll
    for (int a = 0; a < 2; ++a)
#pragma unroll
        for (int b = 0; b < 2; ++b)
#pragma unroll
            for (int m = 0; m < 4; ++m)
#pragma unroll
                for (int n = 0; n < 2; ++n) acc[a][b][m][n] = (f32x4){0.f, 0.f, 0.f, 0.f};
    bf16x8 At[4][2], B0[2][2], B1[2][2];
    const char* cA = (const char*)g.A + (size_t)cur.pm * tstep; const char* cB = (const char*)g.Bt + (size_t)cur.pn * tstep;
    S.a_ready(cur);
    PG8_STAGE(PG8_SB(0, 0), cB, voffB); PG8_STAGE(PG8_SA(0, 0), cA, voffA); PG8_STAGE(PG8_SB(0, 1), cB + hstep, voffB); PG8_STAGE(PG8_SA(0, 1), cA + hstep, voffA);
    if (wr == 1) PG8_BAR;
    PG8_WAIT_V(4); PG8_BAR;
    PG8_STAGE(PG8_SB(1, 0), cB + kstep, voffB); PG8_STAGE(PG8_SA(1, 0), cA + kstep, voffA); PG8_STAGE(PG8_SB(1, 1), cB + hstep + kstep, voffB);
    PG8_WAIT_V(6); PG8_BAR;
    PG8_STAMP();
    for (;;) {
        const bool has_next = S.next(ui + 1, nxt);
        const char* nA = has_next ? (const char*)g.A + (size_t)nxt.pm * tstep : cA; const char* nB = has_next ? (const char*)g.Bt + (size_t)nxt.pn * tstep : cB;
        for (int t = 0; t < nt; t += 2) {
            const bool last = (t == nt - 2);
            const char* a1 = cA + (size_t)(t + 1) * kstep;
            const char* a2 = last ? nA : cA + (size_t)(t + 2) * kstep; const char* b2 = last ? nB : cB + (size_t)(t + 2) * kstep;
            const char* a3 = a2 + kstep; const char* b3 = b2 + kstep;
            if (last && has_next) S.a_ready(nxt);
            PG8_LDB(B0, 0, 0); PG8_SCHED; PG8_LDA(At, 0, 0); PG8_STAGE(PG8_SA(1, 1), a1 + hstep, voffA);
            PG8_WAIT_L(8); PG8_BAR; PG8_WAIT_L(0); PG8_MMA(0, 0, At, B0); PG8_BAR; PG8_SCHED;
            PG8_LDB(B1, 0, 1); PG8_STAGE(PG8_SB(0, 0), b2, voffB);
            PG8_BAR; PG8_WAIT_L(0); PG8_MMA(0, 1, At, B1); PG8_BAR;
            PG8_LDA(At, 0, 1); PG8_STAGE(PG8_SA(0, 0), a2, voffA);
            PG8_BAR; PG8_WAIT_L(0); PG8_MMA(1, 0, At, B0); PG8_BAR; PG8_SCHED;
            PG8_STAGE(PG8_SB(0, 1), b2 + hstep, voffB);
            PG8_WAIT_V(6); PG8_BAR; PG8_MMA(1, 1, At, B1); PG8_BAR;
            PG8_LDB(B0, 1, 0); PG8_SCHED; PG8_LDA(At, 1, 0); PG8_STAGE(PG8_SA(0, 1), a2 + hstep, voffA);
            PG8_WAIT_L(8); PG8_BAR; PG8_WAIT_L(0); PG8_MMA(0, 0, At, B0); PG8_BAR; PG8_SCHED;
            PG8_LDB(B1, 1, 1); PG8_STAGE(PG8_SB(1, 0), b3, voffB);
            PG8_BAR; PG8_WAIT_L(0); PG8_MMA(0, 1, At, B1); PG8_BAR;
            PG8_LDA(At, 1, 1); PG8_STAGE(PG8_SA(1, 0), a3, voffA);
            PG8_BAR; PG8_WAIT_L(0); PG8_MMA(1, 0, At, B0); PG8_BAR; PG8_SCHED;
            PG8_STAGE(PG8_SB(1, 1), b3 + hstep, voffB);
            PG8_WAIT_V(6); PG8_BAR; PG8_MMA(1, 1, At, B1); PG8_BAR;
        }
        PG8_STAMP();
        if constexpr (!Epi::AFTER_DRAIN) { E(acc, cur, wr, wc, fr, fq); S.done(cur); }
        PG8_STAMP();
        if (!has_next) break;
#pragma unroll
        for (int a = 0; a < 2; ++a)
#pragma unroll
            for (int b = 0; b < 2; ++b)
#pragma unroll
                for (int m = 0; m < 4; ++m)
#pragma unroll
                    for (int n = 0; n < 2; ++n) acc[a][b][m][n] = (f32x4){0.f, 0.f, 0.f, 0.f};
        cur = nxt; cA = nA; cB = nB; ++ui;
    }
    PG8_WAIT_V(0);
    if (wr == 0) PG8_BAR;
    PG8_BAR;
    if constexpr (Epi::AFTER_DRAIN) { E.fused(acc, cur, wr, wc, fr, fq, lds, wid, lane); S.done(cur); }
    PG8_STAMP();
    if (STAMP && wid == 0) { stamps[lane] = lane < nts ? (((unsigned long long)(unsigned)ts_hi << 32) | (unsigned)ts_lo) : 0ull;
        if (lane == 62) stamps[62] = rt_entry; if (lane == 63) stamps[63] = (unsigned long long)wall_clock64(); }
#undef PG8_STAMP
#undef PG8_SA
#undef PG8_SB
#undef PG8_STAGE
#undef PG8_LDA
#undef PG8_LDB
#undef PG8_MMA
#undef PG8_WAIT_V
#undef PG8_WAIT_L
#undef PG8_BAR
#undef PG8_SCHED
}
}

#define DI __device__ __forceinline__
#define LAS __attribute__((address_space(3)))
using pg8::bf16_t; using pg8::bf16x8; using pg8::f32x4; using pg8::u32x4;
typedef short s16x4 __attribute__((ext_vector_type(4)));
typedef unsigned u32x2 __attribute__((ext_vector_type(2)));
typedef float f32x2 __attribute__((ext_vector_type(2)));
typedef __bf16 bfv2 __attribute__((ext_vector_type(2)));

constexpr int D = 1024, TP = 16384, TS = 128, TR = TP + TS, MP = 16640, SEQ = 2048;
constexpr int NH = 3840, NHR = 3592, NS = 5376, NSR = 5152, FF = 4096;
constexpr int LDS_BYTES = 150 * 1024;
constexpr size_t O_YP = 0, O_YS = 16777216, O_PGDN = O_YS + 131072, O_PGC = O_PGDN + 1048576, O_PRET = O_PGC + 73728, O_PSSM = O_PRET + 524288,
                 O_PSC = O_PSSM + 4194304, O_SGDN = O_PSC + 147456, O_SGC = O_SGDN + 16777216, O_SRET = O_SGC + 1179648, O_SSSM = O_SRET + 8388608, O_SSC = O_SSSM + 67108864;
constexpr size_t WS_WINH = 0, WS_WOUTH = WS_WINH + 2ull * NH * 1024 * 2, WS_WINS = WS_WOUTH + 2ull * 1024 * 1024 * 2, WS_WOUTS = WS_WINS + 2ull * NS * 1024 * 2,
                 WS_W1 = WS_WOUTS + 2ull * 1024 * 2048 * 2, WS_W2 = WS_W1 + 4ull * 4096 * 1024 * 2, WS_X = WS_W2 + 4ull * 4096 * 1024 * 2, WS_H = WS_X + (size_t)MP * 1024 * 4,
                 WS_PROJ = WS_H + (size_t)MP * 1024 * 2, WS_YRAW = WS_PROJ + (size_t)MP * NS * 2, WS_MIX = WS_YRAW + (size_t)MP * 2048 * 2, WS_ACT = WS_MIX + (size_t)MP * 2048 * 2,
                 WS_CHK = WS_ACT + (size_t)MP * 4096 * 2;
constexpr int GB_NW = 0, GB_QG = 17408, GB_P = 34816, GB_KDT = 44032, GB_UT = 62464, GB_SC = 80896, GB_SIZE = 80960;
constexpr int RB_QG = 0, RB_P = 9216, RB_KDT = 18432, RB_VT = 27648, RB_SC = 46080, RB_SIZE = 46144;
constexpr int SG_CM = 0, SG_BT = 17408, SG_SIZE = 35840;
constexpr int SH_XT = 0, SH_PP = 9216, SH_SC = 18432, SH_SIZE = 19456;
constexpr size_t CHK_GDN = 0, CHK_RET = 1024ull * GB_SIZE, CHK_SG = 0, CHK_SH = 1024ull * SG_SIZE, CHK_END = 1024ull * GB_SIZE + 1024ull * RB_SIZE;
constexpr size_t WS_BAR = WS_CHK + (CHK_END > (1024ull * SG_SIZE + 8192ull * SH_SIZE) ? CHK_END : (1024ull * SG_SIZE + 8192ull * SH_SIZE));
constexpr size_t WS_END = WS_BAR + 16384;

struct Params { const float* in[27]; float* out; unsigned char* ws; int ph_lo, ph_hi; };

DI unsigned pk(float a, float b) { f32x2 v = {a, b}; bfv2 r = __builtin_convertvector(v, bfv2); return __builtin_bit_cast(unsigned, r); }
DI bf16_t f2bf(float a) { return (bf16_t)(pk(a, a) & 0xffffu); }
DI float bf2f(bf16_t b) { return __uint_as_float((unsigned)b << 16); }
DI float bflo(unsigned u) { return __uint_as_float(u << 16); }
DI float bfhi(unsigned u) { return __uint_as_float(u & 0xffff0000u); }
DI float wsum(float v) {
#pragma unroll
    for (int o = 32; o >= 1; o >>= 1) v += __shfl_xor(v, o);
    return v; }
DI float siluf(float x) { return x / (1.f + __expf(-x)); }
DI float softplusf(float x) { return fmaxf(x, 0.f) + log1pf(__expf(-fabsf(x))); }
DI bf16x8 lda_nat(const LAS unsigned char* base, int row, int strideB, int k0, int q) { return *(const LAS bf16x8*)(base + row * strideB + (k0 + 8 * q) * 2); }
DI bf16x8 lda_perm(const LAS unsigned char* base, int row, int strideB, int k0, int q) {
    const s16x4 lo = *(const LAS s16x4*)(base + row * strideB + (k0 + 4 * q) * 2);
    const s16x4 hi = *(const LAS s16x4*)(base + row * strideB + (k0 + 16 + 4 * q) * 2);
    return __builtin_shufflevector(lo, hi, 0, 1, 2, 3, 4, 5, 6, 7); }
DI bf16x8 pack2(f32x4 a, f32x4 b) { u32x4 p; p.x = pk(a[0], a[1]); p.y = pk(a[2], a[3]); p.z = pk(b[0], b[1]); p.w = pk(b[2], b[3]); return __builtin_bit_cast(bf16x8, p); }
#define MFMA16(a, b, c) __builtin_amdgcn_mfma_f32_16x16x32_bf16((a), (b), (c), 0, 0, 0)

template <int ACT> struct EpiB {
    static constexpr bool PERM = true, AFTER_DRAIN = false;
    bf16_t* O; int ldc;
    DI void operator()(const f32x4 (&acc)[2][2][4][2], const pg8::Unit& u, int wr, int wc, int fr, int fq) const {
        const int row0 = u.pm * 256 + wr * 64 + fr, col0 = u.pn * 256 + wc * 32 + 8 * fq;
#pragma unroll
        for (int ai = 0; ai < 2; ++ai)
#pragma unroll
            for (int m = 0; m < 4; ++m) { bf16_t* rowp = O + (size_t)(row0 + ai * 128 + m * 16) * ldc + col0;
#pragma unroll
                for (int bj = 0; bj < 2; ++bj) { f32x4 v0 = acc[ai][bj][m][0], v1 = acc[ai][bj][m][1];
                    if (ACT == 1) {
#pragma unroll
                        for (int j = 0; j < 4; ++j) { const float a = fmaxf(v0[j], 0.f), b = fmaxf(v1[j], 0.f); v0[j] = a * a; v1[j] = b * b; } }
                    u32x4 w; w.x = pk(v0[0], v0[1]); w.y = pk(v0[2], v0[3]); w.z = pk(v1[0], v1[1]); w.w = pk(v1[2], v1[3]);
                    *(u32x4*)(rowp + bj * 128) = w; } }
    }
};
struct EpiRes {
    static constexpr bool PERM = true, AFTER_DRAIN = false;
    bf16_t* X;
    DI void operator()(const f32x4 (&acc)[2][2][4][2], const pg8::Unit& u, int wr, int wc, int fr, int fq) const {
        const int row0 = u.pm * 256 + wr * 64 + fr, col0 = u.pn * 256 + wc * 32 + 8 * fq;
#pragma unroll
        for (int ai = 0; ai < 2; ++ai)
#pragma unroll
            for (int m = 0; m < 4; ++m) { bf16_t* rowp = X + (size_t)(row0 + ai * 128 + m * 16) * D + col0;
#pragma unroll
                for (int bj = 0; bj < 2; ++bj) { u32x4* p = (u32x4*)(rowp + bj * 128); const u32x4 o = *p; const f32x4 a = acc[ai][bj][m][0], b = acc[ai][bj][m][1];
                    u32x4 w; w.x = pk(bflo(o.x) + a[0], bfhi(o.x) + a[1]); w.y = pk(bflo(o.y) + a[2], bfhi(o.y) + a[3]);
                    w.z = pk(bflo(o.z) + b[0], bfhi(o.z) + b[1]); w.w = pk(bflo(o.w) + b[2], bfhi(o.w) + b[3]); *p = w; } }
    }
};

DI void tload(const float* W, int N, int item, int nblk, int lane, f32x4 (&tv)[8]) {
    const int kb = item / nblk, nb = item % nblk, k0 = 64 * kb, n0 = 32 * nb;
    const int n4 = (lane & 7) * 4, kr = lane >> 3; const bool ok = n0 + n4 < N;
#pragma unroll
    for (int i = 0; i < 8; ++i) tv[i] = ok ? __builtin_nontemporal_load((const f32x4*)(W + (size_t)(k0 + 8 * i + kr) * N + n0 + n4)) : (f32x4){0.f, 0.f, 0.f, 0.f};
}
DI void tstore(const f32x4 (&tv)[8], int K, bf16_t* WT, LAS float* scr, int item, int nblk, int lane) {
    const int kb = item / nblk, nb = item % nblk, k0 = 64 * kb, n0 = 32 * nb;
    const int n4 = (lane & 7) * 4, kr = lane >> 3;
#pragma unroll
    for (int i = 0; i < 8; ++i) { LAS float* d = scr + (8 * i + kr) * 33 + n4; d[0] = tv[i][0]; d[1] = tv[i][1]; d[2] = tv[i][2]; d[3] = tv[i][3]; }
    __builtin_amdgcn_s_waitcnt(0xc07f); asm volatile("" ::: "memory");
    const int c = lane & 7;
#pragma unroll
    for (int j = 0; j < 4; ++j) { const int nn = (lane >> 3) + 8 * j; const LAS float* s = scr + (8 * c) * 33 + nn;
        u32x4 o; o.x = pk(s[0 * 33], s[1 * 33]); o.y = pk(s[2 * 33], s[3 * 33]); o.z = pk(s[4 * 33], s[5 * 33]); o.w = pk(s[6 * 33], s[7 * 33]);
        *(u32x4*)(WT + (size_t)(n0 + nn) * K + k0 + 8 * c) = o; }
    __builtin_amdgcn_s_waitcnt(0xc07f); asm volatile("" ::: "memory");
}
DI void prologue(const Params& p, LAS unsigned char* lds, int gw, int ngw, int wv, int lane) {
    LAS float* scr = (LAS float*)(lds + wv * 8704);
    for (int mat = 0; mat < 6; ++mat) {
        const float* src; int K, N, Np, cnt; size_t dst;
        switch (mat) {
            case 0: src = p.in[10]; K = 1024; N = NHR; Np = NH; cnt = 2; dst = WS_WINH; break;
            case 1: src = p.in[16]; K = 1024; N = 1024; Np = 1024; cnt = 2; dst = WS_WOUTH; break;
            case 2: src = p.in[17]; K = 1024; N = NSR; Np = NS; cnt = 2; dst = WS_WINS; break;
            case 3: src = p.in[24]; K = 2048; N = 1024; Np = 1024; cnt = 2; dst = WS_WOUTS; break;
            case 4: src = p.in[25]; K = 1024; N = FF; Np = FF; cnt = 4; dst = WS_W1; break;
            default: src = p.in[26]; K = FF; N = 1024; Np = 1024; cnt = 4; dst = WS_W2; break;
        }
        const int nblk = Np / 32, per = (K / 64) * nblk, tot = per * cnt;
        f32x4 ta[8], tb[8];
        int it = gw;
        if (it < tot) tload(src + (size_t)(it / per) * K * N, N, it % per, nblk, lane, ta);
#pragma nounroll
        for (; it < tot; it += 2 * ngw) {
            const int it2 = it + ngw;
            if (it2 < tot) tload(src + (size_t)(it2 / per) * K * N, N, it2 % per, nblk, lane, tb);
            tstore(ta, K, (bf16_t*)(p.ws + dst) + (size_t)(it / per) * Np * K, scr, it % per, nblk, lane);
            const int it3 = it2 + ngw;
            if (it3 < tot) tload(src + (size_t)(it3 / per) * K * N, N, it3 % per, nblk, lane, ta);
            if (it2 < tot) tstore(tb, K, (bf16_t*)(p.ws + dst) + (size_t)(it2 / per) * Np * K, scr, it2 % per, nblk, lane);
        }
    }
    bf16_t* H = (bf16_t*)(p.ws + WS_H);
    for (int m = TR + gw; m < MP; m += ngw) { u32x4 z = {0u, 0u, 0u, 0u}; *(u32x4*)(H + (size_t)m * D + lane * 8) = z; *(u32x4*)(H + (size_t)m * D + 512 + lane * 8) = z; }
}

constexpr size_t WS_XS = WS_X + (size_t)MP * 1024 * 2;
DI void norm_rows(const Params& p, const float* w, bool copy, int gw, int ngw, int lane) {
    bf16_t* X16 = (bf16_t*)(p.ws + WS_X); float* Xs = (float*)(p.ws + WS_XS); bf16_t* H = (bf16_t*)(p.ws + WS_H);
    f32x4 wv[4];
#pragma unroll
    for (int j = 0; j < 2; ++j) { wv[2 * j] = *(const f32x4*)(w + 8 * lane + 512 * j); wv[2 * j + 1] = *(const f32x4*)(w + 8 * lane + 512 * j + 4); }
    for (int m0 = gw * 2; m0 < TP; m0 += ngw * 2) {
        f32x4 v[2][4];
#pragma unroll
        for (int rr = 0; rr < 2; ++rr) { const int m = m0 + rr;
            if (copy) {
#pragma unroll
                for (int j = 0; j < 2; ++j) { v[rr][2 * j] = __builtin_nontemporal_load((const f32x4*)(p.in[0] + (size_t)m * D + 8 * lane + 512 * j)); v[rr][2 * j + 1] = __builtin_nontemporal_load((const f32x4*)(p.in[0] + (size_t)m * D + 8 * lane + 512 * j + 4)); }
            } else {
#pragma unroll
                for (int j = 0; j < 2; ++j) { const u32x4 u = *(const u32x4*)(X16 + (size_t)m * D + 8 * lane + 512 * j);
                    v[rr][2 * j] = (f32x4){bflo(u.x), bfhi(u.x), bflo(u.y), bfhi(u.y)}; v[rr][2 * j + 1] = (f32x4){bflo(u.z), bfhi(u.z), bflo(u.w), bfhi(u.w)}; }
            } }
#pragma unroll
        for (int rr = 0; rr < 2; ++rr) { const int m = m0 + rr; float ss = 0.f;
#pragma unroll
            for (int j = 0; j < 4; ++j) ss += v[rr][j][0] * v[rr][j][0] + v[rr][j][1] * v[rr][j][1] + v[rr][j][2] * v[rr][j][2] + v[rr][j][3] * v[rr][j][3];
            ss = wsum(ss); const float r = rsqrtf(ss * (1.f / 1024.f) + 1e-6f);
#pragma unroll
            for (int j = 0; j < 2; ++j) { const f32x4 a = v[rr][2 * j], b = v[rr][2 * j + 1];
                if (copy) { u32x4 xo; xo.x = pk(a[0], a[1]); xo.y = pk(a[2], a[3]); xo.z = pk(b[0], b[1]); xo.w = pk(b[2], b[3]); *(u32x4*)(X16 + (size_t)m * D + 8 * lane + 512 * j) = xo; }
                u32x4 o; o.x = pk(a[0] * r * wv[2 * j][0], a[1] * r * wv[2 * j][1]); o.y = pk(a[2] * r * wv[2 * j][2], a[3] * r * wv[2 * j][3]);
                o.z = pk(b[0] * r * wv[2 * j + 1][0], b[1] * r * wv[2 * j + 1][1]); o.w = pk(b[2] * r * wv[2 * j + 1][2], b[3] * r * wv[2 * j + 1][3]);
                *(u32x4*)(H + (size_t)m * D + 8 * lane + 512 * j) = o; } }
    }
    for (int m = TP + gw; m < TR; m += ngw) {
        const float* src = copy ? p.in[1] + (size_t)(m - TP) * D : Xs + (size_t)(m - TP) * D;
        f32x4 v[4]; float ss = 0.f;
#pragma unroll
        for (int j = 0; j < 4; ++j) { v[j] = *(const f32x4*)(src + 4 * lane + 256 * j); ss += v[j][0] * v[j][0] + v[j][1] * v[j][1] + v[j][2] * v[j][2] + v[j][3] * v[j][3]; }
        ss = wsum(ss); const float r = rsqrtf(ss * (1.f / 1024.f) + 1e-6f);
#pragma unroll
        for (int j = 0; j < 4; ++j) { const f32x4 ww = *(const f32x4*)(w + 4 * lane + 256 * j);
            if (copy) *(f32x4*)(Xs + (size_t)(m - TP) * D + 4 * lane + 256 * j) = v[j];
            u32x2 o; o.x = pk(v[j][0] * r * ww[0], v[j][1] * r * ww[1]); o.y = pk(v[j][2] * r * ww[2], v[j][3] * r * ww[3]);
            *(u32x2*)(H + (size_t)m * D + 4 * lane + 256 * j) = o; }
    }
}
DI void final_norm(const Params& p, int gw, int ngw, int lane) {
    const bf16_t* X16 = (const bf16_t*)(p.ws + WS_X); const float* Xs = (const float*)(p.ws + WS_XS); const float* w = p.in[9];
    f32x4 wv[4];
#pragma unroll
    for (int j = 0; j < 2; ++j) { wv[2 * j] = *(const f32x4*)(w + 8 * lane + 512 * j); wv[2 * j + 1] = *(const f32x4*)(w + 8 * lane + 512 * j + 4); }
    for (int m0 = gw * 2; m0 < TP; m0 += ngw * 2) {
        f32x4 v[2][4];
#pragma unroll
        for (int rr = 0; rr < 2; ++rr)
#pragma unroll
            for (int j = 0; j < 2; ++j) { const u32x4 u = *(const u32x4*)(X16 + (size_t)(m0 + rr) * D + 8 * lane + 512 * j);
                v[rr][2 * j] = (f32x4){bflo(u.x), bfhi(u.x), bflo(u.y), bfhi(u.y)}; v[rr][2 * j + 1] = (f32x4){bflo(u.z), bfhi(u.z), bflo(u.w), bfhi(u.w)}; }
#pragma unroll
        for (int rr = 0; rr < 2; ++rr) { const int m = m0 + rr; float ss = 0.f; float* dst = p.out + O_YP + (size_t)m * D;
#pragma unroll
            for (int j = 0; j < 4; ++j) ss += v[rr][j][0] * v[rr][j][0] + v[rr][j][1] * v[rr][j][1] + v[rr][j][2] * v[rr][j][2] + v[rr][j][3] * v[rr][j][3];
            ss = wsum(ss); const float r = rsqrtf(ss * (1.f / 1024.f) + 1e-6f);
#pragma unroll
            for (int j = 0; j < 2; ++j) { __builtin_nontemporal_store(v[rr][2 * j] * r * wv[2 * j], (f32x4*)(dst + 8 * lane + 512 * j)); __builtin_nontemporal_store(v[rr][2 * j + 1] * r * wv[2 * j + 1], (f32x4*)(dst + 8 * lane + 512 * j + 4)); } }
    }
    for (int m = TP + gw; m < TR; m += ngw) {
        const float* src = Xs + (size_t)(m - TP) * D; float* dst = p.out + O_YS + (size_t)(m - TP) * D;
        f32x4 v[4]; float ss = 0.f;
#pragma unroll
        for (int j = 0; j < 4; ++j) { v[j] = *(const f32x4*)(src + 4 * lane + 256 * j); ss += v[j][0] * v[j][0] + v[j][1] * v[j][1] + v[j][2] * v[j][2] + v[j][3] * v[j][3]; }
        ss = wsum(ss); const float r = rsqrtf(ss * (1.f / 1024.f) + 1e-6f);
#pragma unroll
        for (int j = 0; j < 4; ++j) { const f32x4 ww = *(const f32x4*)(w + 4 * lane + 256 * j); *(f32x4*)(dst + 4 * lane + 256 * j) = v[j] * r * ww; }
    }
}

constexpr int P_KN = 0, P_QN = 17408, P_KBT = 34816, P_KDT = 53248, P_VBT = 71680, P_AM = 90112, P_TM = 107520, P_SC = 116736, P_TF = 117760;
DI void gdn_prep_unit(LAS unsigned char* lds, const bf16_t* PROJ, const float* convw, float a_log_h, float dtb_h, unsigned char* blk, int row0, int h, int tid) {
    asm volatile("" : "+v"(tid));
    const int lane = tid & 63, w = tid >> 6, r = lane & 15, q = lane >> 4;
    LAS float* scG = (LAS float*)(lds + P_SC); LAS float* scC = scG + 64; LAS float* scB = scG + 128;
    if (w == 0) {
        const bf16_t* pr = PROJ + (size_t)(row0 + lane) * NH;
        const float braw = bf2f(pr[2048 + h]), araw = bf2f(pr[2052 + h]);
        const float beta = 1.f / (1.f + __expf(-braw));
        const float g = -__expf(a_log_h) * softplusf(araw + dtb_h);
        float c = g;
#pragma unroll
        for (int o = 1; o < 64; o <<= 1) { const float t = __shfl_up(c, o); if (lane >= o) c += t; }
        scG[lane] = g; scC[lane] = c; scB[lane] = beta;
    }
    __syncthreads();
    const float gend = scC[63];
    float cw[3][4][2];
#pragma unroll
    for (int grp = 0; grp < 3; ++grp)
#pragma unroll
        for (int tap = 0; tap < 4; ++tap) { const f32x2 t = *(const f32x2*)(convw + tap * 1536 + grp * 512 + h * 128 + 2 * lane); cw[grp][tap][0] = t[0]; cw[grp][tap][1] = t[1]; }
    LAS bf16_t* kbt = (LAS bf16_t*)(lds + P_KBT); LAS bf16_t* kdt = (LAS bf16_t*)(lds + P_KDT); LAS bf16_t* vbt = (LAS bf16_t*)(lds + P_VBT);
    unsigned xr[11][3];
#pragma unroll
    for (int j = 0; j < 11; ++j) { const int t = (row0 & (SEQ - 1)) + w * 8 - 3 + j; const bf16_t* pr = PROJ + (size_t)(row0 + w * 8 - 3 + j) * NH + h * 128 + 2 * lane;
#pragma unroll
        for (int grp = 0; grp < 3; ++grp) xr[j][grp] = (t >= 0) ? *(const unsigned*)(pr + grp * 512) : 0u; }
#pragma unroll
    for (int tt = 0; tt < 8; ++tt) {
        const int i = w * 8 + tt;
        float a[3][2] = {{0.f, 0.f}, {0.f, 0.f}, {0.f, 0.f}};
#pragma unroll
        for (int tap = 0; tap < 4; ++tap)
#pragma unroll
            for (int grp = 0; grp < 3; ++grp) { const unsigned u = xr[tt + tap][grp]; a[grp][0] += cw[grp][tap][0] * bflo(u); a[grp][1] += cw[grp][tap][1] * bfhi(u); }
#pragma unroll
        for (int grp = 0; grp < 3; ++grp) { a[grp][0] = siluf(a[grp][0]); a[grp][1] = siluf(a[grp][1]); }
        const float sq = wsum(a[0][0] * a[0][0] + a[0][1] * a[0][1]), sk = wsum(a[1][0] * a[1][0] + a[1][1] * a[1][1]);
        const float rq = rsqrtf(sq + 1e-6f) * 0.08838834764831845f, rk = rsqrtf(sk + 1e-6f);
        const float q0 = a[0][0] * rq, q1 = a[0][1] * rq, k0 = a[1][0] * rk, k1 = a[1][1] * rk, v0 = a[2][0], v1 = a[2][1];
        const float gc = scC[i], be = scB[i], eg = __expf(gc), ed = __expf(gend - gc);
        *(LAS unsigned*)(lds + P_QN + i * 272 + lane * 4) = pk(q0, q1);
        *(LAS unsigned*)(lds + P_KN + i * 272 + lane * 4) = pk(k0, k1);
        *(unsigned*)(blk + GB_QG + i * 272 + lane * 4) = pk(q0 * eg, q1 * eg);
        kbt[(2 * lane) * 72 + i] = f2bf(k0 * be * eg); kbt[(2 * lane + 1) * 72 + i] = f2bf(k1 * be * eg);
        kdt[(2 * lane) * 72 + i] = f2bf(k0 * ed); kdt[(2 * lane + 1) * 72 + i] = f2bf(k1 * ed);
        vbt[(2 * lane) * 72 + i] = f2bf(v0 * be); vbt[(2 * lane + 1) * 72 + i] = f2bf(v1 * be);
    }
    __syncthreads();
    LAS float* AM = (LAS float*)(lds + P_AM);
    for (int tix = w; tix < 16; tix += 8) { const int mi = tix >> 2, nj = tix & 3;
        f32x4 kk = {0.f, 0.f, 0.f, 0.f}, qk = {0.f, 0.f, 0.f, 0.f};
        if (nj <= mi) {
#pragma unroll
            for (int s = 0; s < 4; ++s) { const bf16x8 bk = lda_nat(lds + P_KN, 16 * nj + r, 272, 32 * s, q), ak = lda_nat(lds + P_KN, 16 * mi + r, 272, 32 * s, q), aq = lda_nat(lds + P_QN, 16 * mi + r, 272, 32 * s, q);
                kk = MFMA16(ak, bk, kk); qk = MFMA16(aq, bk, qk); } }
#pragma unroll
        for (int reg = 0; reg < 4; ++reg) { const int i = 16 * mi + 4 * q + reg, j = 16 * nj + r;
            const float dec = (j <= i) ? __expf(scC[i] - scC[j]) : 0.f;
            AM[j * 68 + i] = (j < i) ? scB[i] * kk[reg] * dec : 0.f;
            *(bf16_t*)(blk + GB_P + (i * 72 + j) * 2) = f2bf(qk[reg] * dec); }
    }
    __syncthreads();
    if (w == 0) {
        LAS bf16_t* TM = (LAS bf16_t*)(lds + P_TM);
        float t[64];
#pragma unroll
        for (int i = 0; i < 64; ++i) t[i] = (lane == i) ? 1.f : 0.f;
#pragma unroll
        for (int j = 0; j < 63; ++j) { const float tj = t[j];
#pragma unroll
            for (int i = j + 1; i < 64; ++i) t[i] -= AM[j * 68 + i] * tj; }
#pragma unroll
        for (int i = 0; i < 64; ++i) TM[i * 72 + lane] = f2bf(t[i]);
    } else {
        for (int idx = tid - 64; idx < 1152; idx += 448) *(u32x4*)(blk + GB_KDT + idx * 16) = *(const LAS u32x4*)(lds + P_KDT + idx * 16);
    }
    __syncthreads();
    for (int tix = w; tix < 64; tix += 8) {
        f32x4 acc = {0.f, 0.f, 0.f, 0.f};
        if (tix < 32) { const int mi = tix >> 3, nv = tix & 7;
#pragma unroll
            for (int s = 0; s < 2; ++s) acc = MFMA16(lda_nat(lds + P_TM, 16 * mi + r, 144, 32 * s, q), lda_nat(lds + P_VBT, 16 * nv + r, 144, 32 * s, q), acc);
            u32x2 o; o.x = pk(acc[0], acc[1]); o.y = pk(acc[2], acc[3]);
            *(u32x2*)(blk + GB_UT + ((16 * nv + r) * 72 + 16 * mi + 4 * q) * 2) = o;
        } else { const int t2 = tix - 32, mk = t2 >> 2, ni = t2 & 3;
#pragma unroll
            for (int s = 0; s < 2; ++s) acc = MFMA16(lda_nat(lds + P_KBT, 16 * mk + r, 144, 32 * s, q), lda_nat(lds + P_TM, 16 * ni + r, 144, 32 * s, q), acc);
            u32x2 o; o.x = pk(-acc[0], -acc[1]); o.y = pk(-acc[2], -acc[3]);
            *(u32x2*)(blk + GB_NW + ((16 * ni + r) * 136 + 16 * mk + 4 * q) * 2) = o; }
    }
    if (tid == 0) *(float*)(blk + GB_SC) = __expf(gend);
    __syncthreads();
}

constexpr int R_QR = 0, R_KR = 9216, R_KDT = 18432, R_VT = 27648;
DI void rot_sincos(float pos, int f, float& sn, float& cs) {
    const float inv = exp2f(-(float)f * (13.287712379549449f / 32.f));
    const float ang = pos * inv;
    double rev = (double)ang * 0.15915494309189535; rev -= __builtin_floor(rev);
    const float fr = (float)rev;
    sn = __builtin_amdgcn_sinf(fr); cs = __builtin_amdgcn_cosf(fr);
}
DI void ret_prep_unit(LAS unsigned char* lds, const bf16_t* PROJ, unsigned char* blk, int row0, int h, int tid) {
    asm volatile("" : "+v"(tid));
    const int lane = tid & 63, w = tid >> 6, r = lane & 15, q = lane >> 4;
    const float lg = __logf(1.f - exp2f(-5.f - (float)h));
    const int f = lane & 31, which = lane >> 5;
    LAS bf16_t* qr = (LAS bf16_t*)(lds + R_QR); LAS bf16_t* kr = (LAS bf16_t*)(lds + R_KR); LAS bf16_t* kdt = (LAS bf16_t*)(lds + R_KDT); LAS bf16_t* vt = (LAS bf16_t*)(lds + R_VT);
#pragma unroll
    for (int tt = 0; tt < 8; ++tt) {
        const int i = w * 8 + tt, t = (row0 & (SEQ - 1)) + i;
        const bf16_t* pr = PROJ + (size_t)(row0 + i) * NH;
        const int base = (which ? 2312 : 2056) + h * 64;
        const float x1 = bf2f(pr[base + f]), x2 = bf2f(pr[base + 32 + f]);
        float sn, cs; rot_sincos((float)t, f, sn, cs);
        float o1 = x1 * cs - x2 * sn, o2 = x2 * cs + x1 * sn;
        if (which == 0) {
            qr[i * 72 + f] = f2bf(o1); qr[i * 72 + 32 + f] = f2bf(o2);
            const float eg = __expf((float)(i + 1) * lg);
            *(bf16_t*)(blk + RB_QG + (i * 72 + f) * 2) = f2bf(o1 * eg); *(bf16_t*)(blk + RB_QG + (i * 72 + 32 + f) * 2) = f2bf(o2 * eg);
        } else {
            o1 *= 0.125f; o2 *= 0.125f;
            kr[i * 72 + f] = f2bf(o1); kr[i * 72 + 32 + f] = f2bf(o2);
            const float ed = __expf((float)(63 - i) * lg);
            kdt[f * 72 + i] = f2bf(o1 * ed); kdt[(32 + f) * 72 + i] = f2bf(o2 * ed);
        }
        const unsigned u = *(const unsigned*)(pr + 2568 + h * 128 + 2 * lane);
        vt[(2 * lane) * 72 + i] = (bf16_t)(u & 0xffffu); vt[(2 * lane + 1) * 72 + i] = (bf16_t)(u >> 16);
    }
    __syncthreads();
    for (int tix = w; tix < 16; tix += 8) { const int mi = tix >> 2, nj = tix & 3;
        f32x4 qk = {0.f, 0.f, 0.f, 0.f};
        if (nj <= mi) {
#pragma unroll
            for (int s = 0; s < 2; ++s) qk = MFMA16(lda_nat(lds + R_QR, 16 * mi + r, 144, 32 * s, q), lda_nat(lds + R_KR, 16 * nj + r, 144, 32 * s, q), qk); }
#pragma unroll
        for (int reg = 0; reg < 4; ++reg) { const int i = 16 * mi + 4 * q + reg, j = 16 * nj + r;
            const float dec = (j <= i) ? __expf((float)(i - j) * lg) : 0.f;
            *(bf16_t*)(blk + RB_P + (i * 72 + j) * 2) = f2bf(qk[reg] * dec); }
    }
    for (int idx = tid; idx < 1728; idx += 512) *(u32x4*)(blk + RB_KDT + idx * 16) = *(const LAS u32x4*)(lds + R_KDT + idx * 16);
    if (tid == 0) *(float*)(blk + RB_SC) = __expf(64.f * lg);
    __syncthreads();
}

constexpr int Q_CM = 0, Q_BM = 17408, Q_BT = 34816, Q_XT = 53248, Q_END = 53248 + 73728;
DI void ssd_prep_unit(LAS unsigned char* lds, const bf16_t* PROJ, const float* convw  , const float* convb, const float* dtb, const float* alog, const float* dsk,
                      unsigned char* gblk, unsigned char* hblk0  , int row0, int g, int tid) {
    asm volatile("" : "+v"(tid));
    const int lane = tid & 63, w = tid >> 6, r = lane & 15, q = lane >> 4;
    int ch[6];
#pragma unroll
    for (int j = 0; j < 4; ++j) ch[j] = g * 512 + 128 * j + 2 * lane;
    ch[4] = 2048 + g * 128 + 2 * lane; ch[5] = 2560 + g * 128 + 2 * lane;
    float cw[6][5][2];
#pragma unroll
    for (int j = 0; j < 6; ++j) {
#pragma unroll
        for (int tap = 0; tap < 4; ++tap) { const f32x2 t = *(const f32x2*)(convw + tap * 3072 + ch[j]); cw[j][tap][0] = t[0]; cw[j][tap][1] = t[1]; }
        const f32x2 t = *(const f32x2*)(convb + ch[j]); cw[j][4][0] = t[0]; cw[j][4][1] = t[1]; }
    LAS bf16_t* bt = (LAS bf16_t*)(lds + Q_BT); LAS bf16_t* xt = (LAS bf16_t*)(lds + Q_XT);
    if (w == 0) {
        const bf16_t* pr = PROJ + (size_t)(row0 + lane) * NS + 5120 + g * 8;
#pragma unroll
        for (int hh = 0; hh < 8; ++hh) { const int head = g * 8 + hh;
            const float dt = softplusf(bf2f(pr[hh]) + dtb[head]); const float gg = -__expf(alog[head]) * dt;
            float c = gg;
#pragma unroll
            for (int o = 1; o < 64; o <<= 1) { const float t = __shfl_up(c, o); if (lane >= o) c += t; }
            const float gend = __shfl(c, 63);
            float* sc = (float*)(hblk0 + (size_t)(hh >> 1) * 32 * 2 * SH_SIZE + (hh & 1) * SH_SIZE + SH_SC);
            sc[lane] = dt * __expf(gend - c); sc[64 + lane] = __expf(c);
            LAS float* ls = (LAS float*)(lds + Q_END) + hh * 128; ls[lane] = dt; ls[64 + lane] = c; }
    }
    unsigned xr[11][6];
#pragma unroll
    for (int jr = 0; jr < 11; ++jr) { const int t = (row0 & (SEQ - 1)) + w * 8 - 3 + jr; const bf16_t* pr = PROJ + (size_t)(row0 + w * 8 - 3 + jr) * NS + 2048;
#pragma unroll
        for (int j = 0; j < 6; ++j) xr[jr][j] = (t >= 0) ? *(const unsigned*)(pr + ch[j]) : 0u; }
#pragma unroll
    for (int tt = 0; tt < 8; ++tt) {
        const int i = w * 8 + tt;
        float a[6][2];
#pragma unroll
        for (int j = 0; j < 6; ++j) { a[j][0] = cw[j][4][0]; a[j][1] = cw[j][4][1]; }
#pragma unroll
        for (int tap = 0; tap < 4; ++tap)
#pragma unroll
            for (int j = 0; j < 6; ++j) { const unsigned u = xr[tt + tap][j]; a[j][0] += cw[j][tap][0] * bflo(u); a[j][1] += cw[j][tap][1] * bfhi(u); }
#pragma unroll
        for (int j = 0; j < 6; ++j) { a[j][0] = siluf(a[j][0]); a[j][1] = siluf(a[j][1]); }
#pragma unroll
        for (int j = 0; j < 4; ++j) { xt[(128 * j + 2 * lane) * 72 + i] = f2bf(a[j][0]); xt[(128 * j + 2 * lane + 1) * 72 + i] = f2bf(a[j][1]); }
        *(LAS unsigned*)(lds + Q_BM + i * 272 + lane * 4) = pk(a[4][0], a[4][1]);
        bt[(2 * lane) * 72 + i] = f2bf(a[4][0]); bt[(2 * lane + 1) * 72 + i] = f2bf(a[4][1]);
        const unsigned cu = pk(a[5][0], a[5][1]);
        *(LAS unsigned*)(lds + Q_CM + i * 272 + lane * 4) = cu;
        *(unsigned*)(gblk + SG_CM + i * 272 + lane * 4) = cu;
    }
    __syncthreads();
    for (int tix = w; tix < 16; tix += 8) { const int mi = tix >> 2, nj = tix & 3;
        f32x4 cb = {0.f, 0.f, 0.f, 0.f};
        if (nj <= mi) {
#pragma unroll
            for (int s = 0; s < 4; ++s) cb = MFMA16(lda_nat(lds + Q_CM, 16 * mi + r, 272, 32 * s, q), lda_nat(lds + Q_BM, 16 * nj + r, 272, 32 * s, q), cb); }
#pragma unroll
        for (int hh = 0; hh < 8; ++hh) { const LAS float* ls = (const LAS float*)(lds + Q_END) + hh * 128; const float dj = ls[16 * nj + r], gj = ls[64 + 16 * nj + r], dk = dsk[g * 8 + hh];
            unsigned char* pb = hblk0 + (size_t)(hh >> 1) * 32 * 2 * SH_SIZE + (hh & 1) * SH_SIZE + SH_PP;
#pragma unroll
            for (int reg = 0; reg < 4; ++reg) { const int i = 16 * mi + 4 * q + reg, j = 16 * nj + r;
                float v = (j <= i) ? cb[reg] * __expf(ls[64 + i] - gj) * dj : 0.f; if (i == j) v += dk;
                *(bf16_t*)(pb + (i * 72 + j) * 2) = f2bf(v); } }
    }
    for (int idx = tid; idx < 1152; idx += 512) *(u32x4*)(gblk + SG_BT + idx * 16) = *(const LAS u32x4*)(lds + Q_BT + idx * 16);
    for (int idx = tid; idx < 4608; idx += 512) { const int hh = idx / 576, o = idx % 576;
        *(u32x4*)(hblk0 + (size_t)(hh >> 1) * 32 * 2 * SH_SIZE + (hh & 1) * SH_SIZE + SH_XT + o * 16) = *(const LAS u32x4*)(lds + Q_XT + idx * 16); }
    __syncthreads();
}
#define XB_T0(wid) ((wid) == 0 && __builtin_amdgcn_mbcnt_hi(~0u, __builtin_amdgcn_mbcnt_lo(~0u, 0u)) == 0u)
#define XB_TMO      128
#define XB_XCNT(j)  (256  + 64 * (j))
#define XB_XSUB(j)  (1280 + 64 * (j))
#define XB_XGEN(j)  (2304 + 64 * (j))
#define XB_TOP      3328
#define XB_TOPGEN   3392
#define XCD_BAR_WORDS 3456
#define XB_SPIN_CAP (1u << 18)

__device__ __forceinline__ unsigned xb_ld(unsigned* p)              { return __hip_atomic_load(p, __ATOMIC_RELAXED, __HIP_MEMORY_SCOPE_AGENT); }
__device__ __forceinline__ unsigned xb_add(unsigned* p, unsigned v) { return __hip_atomic_fetch_add(p, v, __ATOMIC_RELAXED, __HIP_MEMORY_SCOPE_AGENT); }
__device__ __forceinline__ unsigned xb_xcc_id() { return (unsigned)__builtin_amdgcn_s_getreg((3 << 11) | 20) & 0xFu; }
#define XB_SPIN(cond, bar) do { unsigned _sp = 0; while (cond) { __builtin_amdgcn_s_sleep(1); \
    if ((++_sp & 255u) == 0u) { if (xb_ld(&(bar)[XB_TMO])) break; if (_sp > XB_SPIN_CAP) { atomicAdd(&(bar)[XB_TMO], 1u); break; } } } } while (0)

struct XcdBarrier {
    unsigned* bar; unsigned x; int wid;
    volatile LAS unsigned* st;
};

__device__ __forceinline__ XcdBarrier xcd_barrier_post(unsigned* bar, volatile LAS unsigned* st, int wid) {
    XcdBarrier b; b.bar = bar; b.x = xb_xcc_id(); b.st = st; b.wid = wid;
    if (XB_T0(wid)) (void)xb_add(&bar[XB_XCNT(b.x)], 1u);
    return b;
}
__device__ __forceinline__ void xcd_barrier_complete(unsigned* bar, unsigned x, unsigned& nloc, unsigned& nx) {
    const unsigned G = gridDim.x * gridDim.y * gridDim.z;
    unsigned sum, cnt, mine, sp = 0u;
    for (;;) {
        sum = 0u; cnt = 0u; mine = 0u;
#pragma unroll
        for (unsigned j = 0; j < 16; ++j) { const unsigned c = xb_ld(&bar[XB_XCNT(j)]); sum += c; cnt += (c > 0u) ? 1u : 0u; mine = (j == x) ? c : mine; }
        if (sum == G) break;
        __builtin_amdgcn_s_sleep(1);
        if ((++sp & 255u) == 0u) { if (xb_ld(&bar[XB_TMO])) break; if (sp > XB_SPIN_CAP) { atomicAdd(&bar[XB_TMO], 1u); break; } }
    }
    nloc = mine > 0u ? mine : 1u; nx = cnt > 0u ? cnt : 1u;
}

__device__ __forceinline__ void xcd_barrier(const XcdBarrier& b) {
    asm volatile("s_waitcnt vmcnt(0)" ::: "memory");
    __syncthreads();
    if (XB_T0(b.wid)) {
        unsigned* bar = b.bar;
        __builtin_amdgcn_s_waitcnt(0);
        unsigned nloc = b.st[0], nx = b.st[1];
        if (nloc == 0u) { xcd_barrier_complete(bar, b.x, nloc, nx); b.st[0] = nloc; b.st[1] = nx; }
        const unsigned old = xb_add(&bar[XB_XSUB(b.x)], 1u);
        const unsigned gen = old / nloc;
        if (old + 1u == (gen + 1u) * nloc) {
            __builtin_amdgcn_fence(__ATOMIC_RELEASE, "agent");
            asm volatile("s_waitcnt vmcnt(0)" ::: "memory");
            const unsigned og = xb_add(&bar[XB_TOP], 1u);
            const unsigned tg = og / nx;
            if (og + 1u == (tg + 1u) * nx) xb_add(&bar[XB_TOPGEN], 1u);
            else XB_SPIN(xb_ld(&bar[XB_TOPGEN]) == tg, bar);
            __builtin_amdgcn_fence(__ATOMIC_ACQUIRE, "agent");
            xb_add(&bar[XB_XGEN(b.x)], 1u);
            asm volatile("s_waitcnt vmcnt(0)" ::: "memory");
        } else {
            XB_SPIN(xb_ld(&bar[XB_XGEN(b.x)]) == gen, bar);
            __builtin_amdgcn_fence(__ATOMIC_ACQUIRE, "agent");
            asm volatile("s_waitcnt vmcnt(0)" ::: "memory");
        }
    }
    __syncthreads();
}


#define PF_LOAD(pf, n, src, nvec) do { _Pragma("unroll") for (int _k = 0; _k < (n); ++_k) { const int _i = tid + _k * 512; if (_i < (nvec)) pf[_k] = ((const u32x4*)(src))[_i]; } } while (0)
#define PF_LOAD_NT(pf, n, src, nvec) do { _Pragma("unroll") for (int _k = 0; _k < (n); ++_k) { const int _i = tid + _k * 512; if (_i < (nvec)) pf[_k] = __builtin_nontemporal_load((const u32x4*)(src) + _i); } } while (0)
#define PF_STORE(pf, n, nvec) do { _Pragma("unroll") for (int _k = 0; _k < (n); ++_k) { const int _i = tid + _k * 512; if (_i < (nvec)) ((LAS u32x4*)lds)[_i] = pf[_k]; } } while (0)

constexpr int GL_UT = 62464, GL_SC = 67072, GL_SIZE = 67136, GL_NV = GL_SIZE / 16;
constexpr int GS_SF = 2 * GL_SIZE, GS_DF = GS_SF + 8192;
static_assert(GS_DF + 4096 <= LDS_BYTES - 32, "GDN scan LDS budget");
DI void gdn_scan(LAS unsigned char* lds, const unsigned char* blk0, bf16_t* YRAW, int row0, int h, float* sout, int tid, const int vs) {
    asm volatile("" : "+v"(tid));
    const int lane = tid & 63, w = tid >> 6, r = lane & 15, q = lane >> 4, ct = w & 1, rg = w >> 1, v0 = 32 * vs + 16 * ct;
    f32x4 S0 = (f32x4){0.f, 0.f, 0.f, 0.f}, S1 = S0;
    u32x4 pfA[9], pfB[9];
#define GDN_LOAD(pf, cc) do { const u32x4* _s = (const u32x4*)(blk0 + (size_t)(cc) * GB_SIZE); _Pragma("unroll") for (int _k = 0; _k < 9; ++_k) { const int _i = tid + _k * 512; \
        if (_i < GL_NV) pf[_k] = _s[_i < 3904 ? _i : (_i < 4192 ? _i + vs * 288 : _i + 864)]; } } while (0)
#define GDN_STORE(pf, boff) do { _Pragma("unroll") for (int _k = 0; _k < 9; ++_k) { const int _i = tid + _k * 512; if (_i < GL_NV) ((LAS u32x4*)(lds + (boff)))[_i] = pf[_k]; } } while (0)
    GDN_LOAD(pfA, 0);
    GDN_STORE(pfA, 0);
    GDN_LOAD(pfA, 1); GDN_LOAD(pfB, 2);
    LAS u32x4* SF = (LAS u32x4*)(lds + GS_SF) + ct * 4 * 64;
    LAS unsigned char* DF = lds + GS_DF + ct * 2 * 1024;
    SF[rg * 64 + lane] = (u32x4){0u, 0u, 0u, 0u};
    __syncthreads();
    auto step = [&](auto BC, const int c, u32x4 (&pf)[9]) __attribute__((always_inline)) {
        constexpr int BUFC = decltype(BC)::value ? GL_SIZE : 0, BUFN = GL_SIZE - BUFC;
        const LAS unsigned char* bc = lds + BUFC;
        const float e = *(const LAS float*)(bc + GL_SC);
        const u32x2 uu = *(const LAS u32x2*)(bc + GL_UT + ((16 * ct + r) * 72 + 16 * rg + 4 * q) * 2);
        f32x4 Dl = (f32x4){bflo(uu.x), bfhi(uu.x), bflo(uu.y), bfhi(uu.y)}, Y = (f32x4){0.f, 0.f, 0.f, 0.f};
#pragma unroll
        for (int s = 0; s < 4; ++s) { const bf16x8 bs = __builtin_bit_cast(bf16x8, SF[s * 64 + lane]);
            Dl = MFMA16(lda_perm(bc + GB_NW, 16 * rg + r, 272, 32 * s, q), bs, Dl); Y = MFMA16(lda_perm(bc + GB_QG, 16 * rg + r, 272, 32 * s, q), bs, Y); }
        { u32x2 dd; dd.x = pk(Dl[0], Dl[1]); dd.y = pk(Dl[2], Dl[3]); *(LAS u32x2*)(DF + (rg >> 1) * 1024 + lane * 16 + (rg & 1) * 8) = dd; }
        __syncthreads();
        if (c + 1 < 32) GDN_STORE(pf, BUFN);
        if (c + 3 < 32) GDN_LOAD(pf, c + 3);
        S0 = S0 * e; S1 = S1 * e;
#pragma unroll
        for (int s2 = 0; s2 < 2; ++s2) { const bf16x8 bd = *(const LAS bf16x8*)(DF + s2 * 1024 + lane * 16);
            Y = MFMA16(lda_perm(bc + GB_P, 16 * rg + r, 144, 32 * s2, q), bd, Y);
            S0 = MFMA16(lda_perm(bc + GB_KDT, 16 * (2 * rg) + r, 144, 32 * s2, q), bd, S0);
            S1 = MFMA16(lda_perm(bc + GB_KDT, 16 * (2 * rg + 1) + r, 144, 32 * s2, q), bd, S1); }
#pragma unroll
        for (int reg = 0; reg < 4; ++reg) YRAW[(size_t)(row0 + c * 64 + 16 * rg + 4 * q + reg) * 2048 + h * 128 + v0 + r] = f2bf(Y[reg]);
        SF[rg * 64 + lane] = __builtin_bit_cast(u32x4, pack2(S0, S1));
        __syncthreads();
    };
#pragma nounroll
    for (int c = 0; c < 32; c += 2) { step(std::integral_constant<int, 0>{}, c, pfA); step(std::integral_constant<int, 1>{}, c + 1, pfB); }
#pragma unroll
    for (int reg = 0; reg < 4; ++reg) { sout[(16 * (2 * rg) + 4 * q + reg) * 128 + v0 + r] = S0[reg]; sout[(16 * (2 * rg + 1) + 4 * q + reg) * 128 + v0 + r] = S1[reg]; }
#undef GDN_LOAD
#undef GDN_STORE
}

DI void ret_scan(LAS unsigned char* lds, const unsigned char* blk0, bf16_t* YRAW, int row0, int h, float* sout, int tid) {
    asm volatile("" : "+v"(tid));
    const int lane = tid & 63, w = tid >> 6, r = lane & 15, q = lane >> 4, v0 = 16 * w;
    constexpr int RL = 46208;
    f32x4 S[4];
#pragma unroll
    for (int k = 0; k < 4; ++k) S[k] = (f32x4){0.f, 0.f, 0.f, 0.f};
    u32x4 pfA[6], pfB[6];
#define RET_STORE(pf, boff) do { _Pragma("unroll") for (int _k = 0; _k < 6; ++_k) { const int _i = tid + _k * 512; if (_i < RB_SIZE / 16) ((LAS u32x4*)(lds + (boff)))[_i] = pf[_k]; } } while (0)
    PF_LOAD_NT(pfA, 6, blk0, RB_SIZE / 16);
    RET_STORE(pfA, 0);
    PF_LOAD_NT(pfA, 6, blk0 + RB_SIZE, RB_SIZE / 16);
    PF_LOAD_NT(pfB, 6, blk0 + 2 * (size_t)RB_SIZE, RB_SIZE / 16);
    __syncthreads();
    auto step = [&](auto BC, const int c, u32x4 (&pf)[6]) __attribute__((always_inline)) {
        constexpr int BUFC = decltype(BC)::value ? RL : 0, BUFN = RL - BUFC;
        const LAS unsigned char* bc = lds + BUFC;
        if (c + 1 < 32) RET_STORE(pf, BUFN);
        if (c + 3 < 32) PF_LOAD_NT(pf, 6, blk0 + (size_t)(c + 3) * RB_SIZE, RB_SIZE / 16);
        const float e = *(const LAS float*)(bc + RB_SC);
        f32x4 Y[4];
#pragma unroll
        for (int m = 0; m < 4; ++m) Y[m] = (f32x4){0.f, 0.f, 0.f, 0.f};
#pragma unroll
        for (int s = 0; s < 2; ++s) { const bf16x8 bs = pack2(S[2 * s], S[2 * s + 1]);
#pragma unroll
            for (int m = 0; m < 4; ++m) Y[m] = MFMA16(lda_perm(bc + RB_QG, 16 * m + r, 144, 32 * s, q), bs, Y[m]); }
#pragma unroll
        for (int k = 0; k < 4; ++k) S[k] = S[k] * e;
#pragma unroll
        for (int s2 = 0; s2 < 2; ++s2) { const bf16x8 bv = lda_nat(bc + RB_VT, v0 + r, 144, 32 * s2, q);
#pragma unroll
            for (int m = 0; m < 4; ++m) Y[m] = MFMA16(lda_nat(bc + RB_P, 16 * m + r, 144, 32 * s2, q), bv, Y[m]);
#pragma unroll
            for (int k = 0; k < 4; ++k) S[k] = MFMA16(lda_nat(bc + RB_KDT, 16 * k + r, 144, 32 * s2, q), bv, S[k]); }
#pragma unroll
        for (int m = 0; m < 4; ++m)
#pragma unroll
            for (int reg = 0; reg < 4; ++reg) YRAW[(size_t)(row0 + c * 64 + 16 * m + 4 * q + reg) * 2048 + 512 + h * 128 + v0 + r] = f2bf(Y[m][reg]);
        __syncthreads();
    };
#pragma nounroll
    for (int c = 0; c < 32; c += 2) { step(std::integral_constant<int, 0>{}, c, pfA); step(std::integral_constant<int, 1>{}, c + 1, pfB); }
#pragma unroll
    for (int k = 0; k < 4; ++k)
#pragma unroll
        for (int reg = 0; reg < 4; ++reg) sout[(16 * k + 4 * q + reg) * 128 + v0 + r] = S[k][reg];
#undef RET_STORE
}

constexpr int SL_SIZE = SG_SIZE + SH_SIZE, SS_SF = 2 * SL_SIZE;
static_assert(SS_SF + 32768 <= LDS_BYTES - 32, "SSD scan LDS budget");
DI void ssd_scan(LAS unsigned char* lds, const unsigned char* gblk0, const unsigned char* hblk0, bf16_t* YRAW, int row0, int head, float* so, int tid) {
    asm volatile("" : "+v"(tid));
    const int lane = tid & 63, w = tid >> 6, r = lane & 15, q = lane >> 4, ct = w & 3, rh = w >> 2, p0 = 16 * ct;
    f32x4 S[4];
#pragma unroll
    for (int k = 0; k < 4; ++k) S[k] = (f32x4){0.f, 0.f, 0.f, 0.f};
    u32x4 pfA[7], pfB[7];
    constexpr int NG = SG_SIZE / 16, NV = NG + SH_SIZE / 16; static_assert(NV <= 7 * 512, "ssd staging");
#define SSD_LOAD(pf, cc) do { _Pragma("unroll") for (int _k = 0; _k < 7; ++_k) { const int _i = tid + _k * 512; if (_i < NG) pf[_k] = ((const u32x4*)(gblk0 + (size_t)(cc) * SG_SIZE))[_i]; \
        else if (_i < NV) pf[_k] = __builtin_nontemporal_load((const u32x4*)(hblk0 + (size_t)(cc) * 2 * SH_SIZE) + (_i - NG)); } } while (0)
#define SSD_STORE(pf, boff) do { _Pragma("unroll") for (int _k = 0; _k < 7; ++_k) { const int _i = tid + _k * 512; if (_i < NV) ((LAS u32x4*)(lds + (boff)))[_i] = pf[_k]; } } while (0)
    SSD_LOAD(pfA, 0);
    SSD_STORE(pfA, 0);
    SSD_LOAD(pfA, 1); SSD_LOAD(pfB, 2);
    LAS u32x4* SF = (LAS u32x4*)(lds + SS_SF) + ct * 4 * 64;
    SF[(2 * rh) * 64 + lane] = (u32x4){0u, 0u, 0u, 0u}; SF[(2 * rh + 1) * 64 + lane] = (u32x4){0u, 0u, 0u, 0u};
    __syncthreads();
    auto step = [&](auto BC, const int c, u32x4 (&pf)[7]) __attribute__((always_inline)) {
        constexpr int PAR = decltype(BC)::value, BUFC = PAR ? SL_SIZE : 0, BUFN = SL_SIZE - BUFC;
        const LAS unsigned char* bc = lds + BUFC;
        const LAS unsigned char* hd = bc + SG_SIZE;
        const LAS unsigned char* pp = hd + SH_PP;
        const LAS float* sx = (const LAS float*)(hd + SH_SC);
        LAS u32x4* SFc = SF + PAR * 1024; LAS u32x4* SFn = SF + (1 - PAR) * 1024;
        if (c + 1 < 32) SSD_STORE(pf, BUFN);
        if (c + 3 < 32) SSD_LOAD(pf, c + 3);
        const float e = sx[64 + 63];
        f32x4 Y[2];
#pragma unroll
        for (int mm = 0; mm < 2; ++mm) Y[mm] = (f32x4){0.f, 0.f, 0.f, 0.f};
#pragma unroll
        for (int s = 0; s < 4; ++s) { const bf16x8 bs = __builtin_bit_cast(bf16x8, SFc[s * 64 + lane]);
#pragma unroll
            for (int mm = 0; mm < 2; ++mm) Y[mm] = MFMA16(lda_perm(bc + SG_CM, 16 * (2 * rh + mm) + r, 272, 32 * s, q), bs, Y[mm]); }
#pragma unroll
        for (int mm = 0; mm < 2; ++mm)
#pragma unroll
            for (int reg = 0; reg < 4; ++reg) Y[mm][reg] *= sx[64 + 16 * (2 * rh + mm) + 4 * q + reg];
#pragma unroll
        for (int k = 0; k < 4; ++k) S[k] = S[k] * e;
#pragma unroll
        for (int s2 = 0; s2 < 2; ++s2) { const bf16x8 bx = lda_nat(hd + SH_XT, p0 + r, 144, 32 * s2, q);
#pragma unroll
            for (int mm = 0; mm < 2; ++mm) Y[mm] = MFMA16(lda_nat(pp, 16 * (2 * rh + mm) + r, 144, 32 * s2, q), bx, Y[mm]);
            const u32x4 xu = __builtin_bit_cast(u32x4, bx); u32x4 xs;
            const LAS float* wj = sx + 32 * s2 + 8 * q;
            xs.x = pk(bflo(xu.x) * wj[0], bfhi(xu.x) * wj[1]); xs.y = pk(bflo(xu.y) * wj[2], bfhi(xu.y) * wj[3]);
            xs.z = pk(bflo(xu.z) * wj[4], bfhi(xu.z) * wj[5]); xs.w = pk(bflo(xu.w) * wj[6], bfhi(xu.w) * wj[7]);
            const bf16x8 bx2 = __builtin_bit_cast(bf16x8, xs);
#pragma unroll
            for (int k = 0; k < 4; ++k) S[k] = MFMA16(lda_nat(bc + SG_BT, 16 * (4 * rh + k) + r, 144, 32 * s2, q), bx2, S[k]); }
#pragma unroll
        for (int mm = 0; mm < 2; ++mm)
#pragma unroll
            for (int reg = 0; reg < 4; ++reg) YRAW[(size_t)(row0 + c * 64 + 16 * (2 * rh + mm) + 4 * q + reg) * 2048 + head * 64 + p0 + r] = f2bf(Y[mm][reg]);
        SFn[(2 * rh) * 64 + lane] = __builtin_bit_cast(u32x4, pack2(S[0], S[1])); SFn[(2 * rh + 1) * 64 + lane] = __builtin_bit_cast(u32x4, pack2(S[2], S[3]));
        __syncthreads();
    };
#pragma nounroll
    for (int c = 0; c < 32; c += 2) { step(std::integral_constant<int, 0>{}, c, pfA); step(std::integral_constant<int, 1>{}, c + 1, pfB); }
#pragma unroll
    for (int k = 0; k < 4; ++k)
#pragma unroll
        for (int reg = 0; reg < 4; ++reg) so[(16 * (4 * rh + k) + 4 * q + reg) * 64 + p0 + r] = S[k][reg];
#undef SSD_LOAD
#undef SSD_STORE
}

constexpr int XB_STEAL = 3520;
DI int steal_unit(unsigned* ctr, LAS unsigned char* lds, int tid) {
    __syncthreads();
    if (tid == 0) *(LAS int*)(lds + LDS_BYTES - 32) = (int)__hip_atomic_fetch_add(ctr, 1u, __ATOMIC_RELAXED, __HIP_MEMORY_SCOPE_AGENT);
    __syncthreads();
    return *(const LAS int*)(lds + LDS_BYTES - 32);
}
DI void gdn_sample_unit(LAS unsigned char* lds, const Params& p, int li, int s, int h, int tid) {
    asm volatile("" : "+v"(tid));
    const int lane = tid & 63, w = tid >> 6, row = TP + s;
    const bf16_t* pr = (const bf16_t*)(p.ws + WS_PROJ) + (size_t)row * NH;
    LAS float* qkv = (LAS float*)lds; LAS float* red = qkv + 384;
    const float* cbuf = p.in[3] + (size_t)(li * 128 + s) * 3 * 1536; float* cout = p.out + O_SGC + (size_t)(li * 128 + s) * 3 * 1536;
    const float* cwp = p.in[11] + (size_t)li * 4 * 1536;
    if (tid < 384) { const int grp = tid >> 7, cl = tid & 127, ch = grp * 512 + h * 128 + cl;
        const float x = bf2f(pr[ch]), b0 = cbuf[ch], b1 = cbuf[1536 + ch], b2 = cbuf[3072 + ch];
        const float o = b0 * cwp[ch] + b1 * cwp[1536 + ch] + b2 * cwp[3072 + ch] + x * cwp[4608 + ch];
        qkv[tid] = siluf(o); cout[ch] = b1; cout[1536 + ch] = b2; cout[3072 + ch] = x; }
    __syncthreads();
    const float qa = qkv[2 * lane], qb = qkv[2 * lane + 1], ka = qkv[128 + 2 * lane], kb = qkv[128 + 2 * lane + 1];
    const float rq = rsqrtf(wsum(qa * qa + qb * qb) + 1e-6f) * 0.08838834764831845f, rk = rsqrtf(wsum(ka * ka + kb * kb) + 1e-6f);
    const float beta = 1.f / (1.f + __expf(-bf2f(pr[2048 + h])));
    const float g = -__expf(p.in[12][li * 4 + h]) * softplusf(bf2f(pr[2052 + h]) + p.in[13][li * 4 + h]);
    const float e = __expf(g);
    const size_t sidx = ((size_t)(li * 128 + s) * 4 + h) * 128 * 128;
    const float* Sin = p.in[2] + sidx; float* Sout = p.out + O_SGDN + sidx;
    f32x2 Sr[16]; float a0 = 0.f, a1 = 0.f;
#pragma unroll
    for (int rr = 0; rr < 16; ++rr) { Sr[rr] = __builtin_nontemporal_load((const f32x2*)(Sin + (16 * w + rr) * 128 + 2 * lane)) * e; const float kn = qkv[128 + 16 * w + rr] * rk; a0 += kn * Sr[rr][0]; a1 += kn * Sr[rr][1]; }
    red[w * 128 + 2 * lane] = a0; red[w * 128 + 2 * lane + 1] = a1;
    __syncthreads();
    a0 = 0.f; a1 = 0.f;
#pragma unroll
    for (int ww = 0; ww < 8; ++ww) { a0 += red[ww * 128 + 2 * lane]; a1 += red[ww * 128 + 2 * lane + 1]; }
    const float d0 = beta * (qkv[256 + 2 * lane] - a0), d1 = beta * (qkv[256 + 2 * lane + 1] - a1);
    __syncthreads();
    float y0 = 0.f, y1 = 0.f;
#pragma unroll
    for (int rr = 0; rr < 16; ++rr) { const float kn = qkv[128 + 16 * w + rr] * rk, qn = qkv[16 * w + rr] * rq;
        Sr[rr][0] += kn * d0; Sr[rr][1] += kn * d1; y0 += qn * Sr[rr][0]; y1 += qn * Sr[rr][1];
        __builtin_nontemporal_store(Sr[rr], (f32x2*)(Sout + (16 * w + rr) * 128 + 2 * lane)); }
    red[w * 128 + 2 * lane] = y0; red[w * 128 + 2 * lane + 1] = y1;
    __syncthreads();
    if (w == 0) { y0 = 0.f; y1 = 0.f;
#pragma unroll
        for (int ww = 0; ww < 8; ++ww) { y0 += red[ww * 128 + 2 * lane]; y1 += red[ww * 128 + 2 * lane + 1]; }
        *(unsigned*)((bf16_t*)(p.ws + WS_YRAW) + (size_t)row * 2048 + h * 128 + 2 * lane) = pk(y0, y1); }
    __syncthreads();
}
DI void ret_sample_unit(LAS unsigned char* lds, const Params& p, int li, int s, int h, int tid) {
    asm volatile("" : "+v"(tid));
    const int lane = tid & 63, w = tid >> 6, row = TP + s;
    const bf16_t* pr = (const bf16_t*)(p.ws + WS_PROJ) + (size_t)row * NH;
    LAS float* qk = (LAS float*)lds; LAS float* red = qk + 128;
    if (tid < 64) { const int f = tid & 31, which = tid >> 5, base = (which ? 2312 : 2056) + h * 64;
        const float x1 = bf2f(pr[base + f]), x2 = bf2f(pr[base + 32 + f]);
        float sn, cs; rot_sincos(16384.f, f, sn, cs);
        float o1 = x1 * cs - x2 * sn, o2 = x2 * cs + x1 * sn;
        if (which) { o1 *= 0.125f; o2 *= 0.125f; }
        qk[which * 64 + f] = o1; qk[which * 64 + 32 + f] = o2; }
    __syncthreads();
    const float gam = 1.f - exp2f(-5.f - (float)h);
    const unsigned vu = *(const unsigned*)(pr + 2568 + h * 128 + 2 * lane);
    const float va = bflo(vu), vb = bfhi(vu);
    const size_t sidx = ((size_t)(li * 128 + s) * 4 + h) * 64 * 128;
    const float* Sin = p.in[4] + sidx; float* Sout = p.out + O_SRET + sidx;
    float y0 = 0.f, y1 = 0.f;
#pragma unroll
    for (int rr = 0; rr < 8; ++rr) { const int k = 8 * w + rr; f32x2 sv = __builtin_nontemporal_load((const f32x2*)(Sin + k * 128 + 2 * lane)) * gam; const float kk = qk[64 + k], qq = qk[k];
        sv[0] += kk * va; sv[1] += kk * vb; y0 += qq * sv[0]; y1 += qq * sv[1]; __builtin_nontemporal_store(sv, (f32x2*)(Sout + k * 128 + 2 * lane)); }
    red[w * 128 + 2 * lane] = y0; red[w * 128 + 2 * lane + 1] = y1;
    __syncthreads();
    if (w == 0) { y0 = 0.f; y1 = 0.f;
#pragma unroll
        for (int ww = 0; ww < 8; ++ww) { y0 += red[ww * 128 + 2 * lane]; y1 += red[ww * 128 + 2 * lane + 1]; }
        *(unsigned*)((bf16_t*)(p.ws + WS_YRAW) + (size_t)row * 2048 + 512 + h * 128 + 2 * lane) = pk(y0, y1); }
    __syncthreads();
}
DI void ssd_sample_unit(LAS unsigned char* lds, const Params& p, int li, int s, int g, int tid) {
    asm volatile("" : "+v"(tid));
    const int lane = tid & 63, w = tid >> 6, row = TP + s, pq = lane & 15, nq = lane >> 4;
    const bf16_t* pr = (const bf16_t*)(p.ws + WS_PROJ) + (size_t)row * NS;
    LAS float* xs = (LAS float*)lds; LAS float* Bv = xs + 512; LAS float* Cv = xs + 640;
    const float* cbuf = p.in[6] + (size_t)(li * 128 + s) * 3 * 3072; float* cout = p.out + O_SSC + (size_t)(li * 128 + s) * 3 * 3072;
    const float* cwp = p.in[18] + (size_t)li * 4 * 3072; const float* cbp = p.in[19] + (size_t)li * 3072;
    const int head = g * 8 + w;
    const size_t sidx = ((size_t)(li * 128 + s) * 32 + head) * 128 * 64;
    const f32x4* Sin4 = (const f32x4*)(p.in[5] + sidx); f32x4* Sout4 = (f32x4*)(p.out + O_SSSM + sidx);
    f32x4 sb[2][8];
#pragma unroll
    for (int j = 0; j < 8; ++j) sb[0][j] = __builtin_nontemporal_load(Sin4 + j * 64 + lane);
    {
        float xv_[2], b0_[2], b1_[2], b2_[2], w_[2][5]; int ch_[2];
#pragma unroll
        for (int it = 0; it < 2; ++it) { const int t = tid + it * 512; const bool ok = t < 768; const int tc = ok ? t : 0;
            const int ch = tc < 512 ? g * 512 + tc : (tc < 640 ? 2048 + g * 128 + (tc - 512) : 2560 + g * 128 + (tc - 640)); ch_[it] = ch;
            xv_[it] = bf2f(pr[2048 + ch]); b0_[it] = cbuf[ch]; b1_[it] = cbuf[3072 + ch]; b2_[it] = cbuf[6144 + ch];
            w_[it][0] = cwp[ch]; w_[it][1] = cwp[3072 + ch]; w_[it][2] = cwp[6144 + ch]; w_[it][3] = cwp[9216 + ch]; w_[it][4] = cbp[ch]; }
#pragma unroll
        for (int it = 0; it < 2; ++it) { const int t = tid + it * 512; if (t < 768) { const int ch = ch_[it];
            const float o = w_[it][4] + b0_[it] * w_[it][0] + b1_[it] * w_[it][1] + b2_[it] * w_[it][2] + xv_[it] * w_[it][3];
            xs[t] = siluf(o); cout[ch] = b1_[it]; cout[3072 + ch] = b2_[it]; cout[6144 + ch] = xv_[it]; } }
    }
    __syncthreads();
    const float dt = softplusf(bf2f(pr[5120 + head]) + p.in[20][li * 32 + head]);
    const float e = __expf(-__expf(p.in[21][li * 32 + head]) * dt);
    const f32x4 xv = *(const LAS f32x4*)(xs + w * 64 + 4 * pq), xd = xv * dt;
    f32x4 y = (f32x4){0.f, 0.f, 0.f, 0.f};
#pragma unroll
    for (int b = 0; b < 4; ++b) {
        if (b < 3) {
#pragma unroll
            for (int j = 0; j < 8; ++j) sb[(b + 1) & 1][j] = __builtin_nontemporal_load(Sin4 + ((b + 1) * 8 + j) * 64 + lane); }
#pragma unroll
        for (int j = 0; j < 8; ++j) { const int n = 4 * (b * 8 + j) + nq; const f32x4 v = sb[b & 1][j] * e + xd * Bv[n]; y = y + v * Cv[n]; __builtin_nontemporal_store(v, Sout4 + (b * 8 + j) * 64 + lane); }
    }
#pragma unroll
    for (int j = 0; j < 4; ++j) { y[j] += __shfl_xor(y[j], 16); y[j] += __shfl_xor(y[j], 32); }
    y = y + xv * p.in[22][li * 32 + head];
    if (nq == 0) { u32x2 o; o.x = pk(y[0], y[1]); o.y = pk(y[2], y[3]); *(u32x2*)((bf16_t*)(p.ws + WS_YRAW) + (size_t)row * 2048 + head * 64 + 4 * pq) = o; }
    __syncthreads();
}

DI void gate_hyb(const Params& p, int li, int gw, int ngw, int lane) {
    const bf16_t* YR = (const bf16_t*)(p.ws + WS_YRAW); const bf16_t* PROJ = (const bf16_t*)(p.ws + WS_PROJ); bf16_t* MIX = (bf16_t*)(p.ws + WS_MIX);
    const int cl = 8 * (lane & 15), h = lane >> 4;
    f32x4 ga[2], ra[2];
    ga[0] = *(const f32x4*)(p.in[14] + li * 128 + cl); ga[1] = *(const f32x4*)(p.in[14] + li * 128 + cl + 4);
    ra[0] = *(const f32x4*)(p.in[15] + li * 512 + h * 128 + cl); ra[1] = *(const f32x4*)(p.in[15] + li * 512 + h * 128 + cl + 4);
    for (int it0 = gw * 2; it0 < TR * 2; it0 += ngw * 2) {
        u32x4 ya[2], za[2];
#pragma unroll
        for (int rr = 0; rr < 2; ++rr) { const int it = it0 + rr, m = it >> 1, half = it & 1;
            ya[rr] = *(const u32x4*)(YR + (size_t)m * 2048 + half * 512 + h * 128 + cl);
            za[rr] = *(const u32x4*)(PROJ + (size_t)m * NH + (half ? 3080 : 1536) + h * 128 + cl); }
#pragma unroll
        for (int rr = 0; rr < 2; ++rr) { const int it = it0 + rr, m = it >> 1, half = it & 1;
            const unsigned yu[4] = {ya[rr].x, ya[rr].y, ya[rr].z, ya[rr].w}, zu[4] = {za[rr].x, za[rr].y, za[rr].z, za[rr].w};
            float v[8], z[8]; float s1 = 0.f;
#pragma unroll
            for (int j = 0; j < 4; ++j) { v[2 * j] = bflo(yu[j]); v[2 * j + 1] = bfhi(yu[j]); z[2 * j] = bflo(zu[j]); z[2 * j + 1] = bfhi(zu[j]); s1 += v[2 * j] + v[2 * j + 1]; }
            float mean = 0.f;
            if (half) { s1 += __shfl_xor(s1, 1); s1 += __shfl_xor(s1, 2); s1 += __shfl_xor(s1, 4); s1 += __shfl_xor(s1, 8); mean = s1 * (1.f / 128.f); }
            float ss = 0.f;
#pragma unroll
            for (int j = 0; j < 8; ++j) { v[j] -= mean; ss += v[j] * v[j]; }
            ss += __shfl_xor(ss, 1); ss += __shfl_xor(ss, 2); ss += __shfl_xor(ss, 4); ss += __shfl_xor(ss, 8);
            const float rs = rsqrtf(ss * (1.f / 128.f) + 1e-6f);
            float o[8];
#pragma unroll
            for (int j = 0; j < 8; ++j) { const float gn = half ? ra[j >> 2][j & 3] : ga[j >> 2][j & 3]; o[j] = v[j] * rs * gn * siluf(z[j]); }
            u32x4 w; w.x = pk(o[0], o[1]); w.y = pk(o[2], o[3]); w.z = pk(o[4], o[5]); w.w = pk(o[6], o[7]);
            *(u32x4*)(MIX + (size_t)m * 1024 + half * 512 + h * 128 + cl) = w; }
    }
    for (int idx = gw * 64 + lane; idx < 8 * 3 * 1536; idx += ngw * 64) { const int ch = idx % 1536, rr = (idx / 1536) % 3, b = idx / (3 * 1536);
        p.out[O_PGC + (size_t)(li * 8 + b) * 3 * 1536 + rr * 1536 + ch] = bf2f(PROJ[(size_t)(b * SEQ + SEQ - 3 + rr) * NH + ch]); }
}
DI void gate_ssm(const Params& p, int li, int gw, int ngw, int lane) {
    const bf16_t* YR = (const bf16_t*)(p.ws + WS_YRAW); const bf16_t* PROJ = (const bf16_t*)(p.ws + WS_PROJ); bf16_t* MIX = (bf16_t*)(p.ws + WS_MIX);
    const float* nw = p.in[23] + li * 2048;
    for (int m = gw; m < TR; m += ngw) {
        const bf16_t* yr = YR + (size_t)m * 2048; const bf16_t* pr = PROJ + (size_t)m * NS; bf16_t* mx = MIX + (size_t)m * 2048;
        u32x4 ua[4], za[4];
#pragma unroll
        for (int g = 0; g < 4; ++g) { ua[g] = *(const u32x4*)(yr + g * 512 + 8 * lane); za[g] = *(const u32x4*)(pr + g * 512 + 8 * lane); }
#pragma unroll
        for (int g = 0; g < 4; ++g) {
            const u32x4 u = ua[g], z = za[g];
            float v[8]; const unsigned uu[4] = {u.x, u.y, u.z, u.w}, zz[4] = {z.x, z.y, z.z, z.w}; float ss = 0.f;
#pragma unroll
            for (int j = 0; j < 4; ++j) { v[2 * j] = bflo(uu[j]) * siluf(bflo(zz[j])); v[2 * j + 1] = bfhi(uu[j]) * siluf(bfhi(zz[j])); ss += v[2 * j] * v[2 * j] + v[2 * j + 1] * v[2 * j + 1]; }
            const float rs = rsqrtf(wsum(ss) * (1.f / 512.f) + 1e-6f);
            const f32x4 w0 = *(const f32x4*)(nw + g * 512 + 8 * lane), w1 = *(const f32x4*)(nw + g * 512 + 8 * lane + 4);
            u32x4 o; o.x = pk(v[0] * rs * w0[0], v[1] * rs * w0[1]); o.y = pk(v[2] * rs * w0[2], v[3] * rs * w0[3]); o.z = pk(v[4] * rs * w1[0], v[5] * rs * w1[1]); o.w = pk(v[6] * rs * w1[2], v[7] * rs * w1[3]);
            *(u32x4*)(mx + g * 512 + 8 * lane) = o;
        }
    }
    for (int idx = gw * 64 + lane; idx < 8 * 3 * 3072; idx += ngw * 64) { const int ch = idx % 3072, rr = (idx / 3072) % 3, b = idx / (3 * 3072);
        p.out[O_PSC + (size_t)(li * 8 + b) * 3 * 3072 + rr * 3072 + ch] = bf2f(PROJ[(size_t)(b * SEQ + SEQ - 3 + rr) * NS + 2048 + ch]); }
}

struct EpiBR {
    static constexpr bool PERM = true, AFTER_DRAIN = false;
    bf16_t* O; int ldc; int act;
    DI void operator()(const f32x4 (&acc)[2][2][4][2], const pg8::Unit& u, int wr, int wc, int fr, int fq) const {
        const int row0 = u.pm * 256 + wr * 64 + fr, col0 = u.pn * 256 + wc * 32 + 8 * fq;
#pragma unroll
        for (int ai = 0; ai < 2; ++ai)
#pragma unroll
            for (int m = 0; m < 4; ++m) { bf16_t* rowp = O + (size_t)(row0 + ai * 128 + m * 16) * ldc + col0;
#pragma unroll
                for (int bj = 0; bj < 2; ++bj) { f32x4 v0 = acc[ai][bj][m][0], v1 = acc[ai][bj][m][1];
                    if (act) {
#pragma unroll
                        for (int j = 0; j < 4; ++j) { const float a = fmaxf(v0[j], 0.f), b = fmaxf(v1[j], 0.f); v0[j] = a * a; v1[j] = b * b; } }
                    u32x4 w; w.x = pk(v0[0], v0[1]); w.y = pk(v0[2], v0[3]); w.z = pk(v1[0], v1[1]); w.w = pk(v1[2], v1[3]);
                    *(u32x4*)(rowp + bj * 128) = w; } }
    }
};
template <int EPI> DI void skinny_tile(LAS unsigned char* lds, const bf16_t* A, const bf16_t* Bt, const int Kext, void* outp, const int ldc, int tid, const int lda = 0) {
    asm volatile("" : "+v"(tid));
    const int lane = tid & 63, w = tid >> 6, r = lane & 15, q = lane >> 4;
    const int K = lda ? lda : Kext;
    constexpr int kw = 128; (void)Kext;
    f32x4 acc[8];
#pragma unroll
    for (int m = 0; m < 8; ++m) acc[m] = (f32x4){0.f, 0.f, 0.f, 0.f};
    const bf16_t* ap = A + (size_t)r * K + w * kw + 8 * q; const bf16_t* bp = Bt + (size_t)r * K + w * kw + 8 * q;
#pragma unroll
    for (int k0 = 0; k0 < kw; k0 += 32) {
        const bf16x8 b = *(const bf16x8*)(bp + k0);
#pragma unroll
        for (int m = 0; m < 8; ++m) acc[m] = MFMA16(*(const bf16x8*)(ap + (size_t)(16 * m) * K + k0), b, acc[m]);
    }
    LAS float* part = (LAS float*)lds;
#pragma unroll
    for (int m = 0; m < 8; ++m)
#pragma unroll
        for (int reg = 0; reg < 4; ++reg) part[(w * 128 + 16 * m + 4 * q + reg) * 16 + r] = acc[m][reg];
    __syncthreads();
    const int row = tid >> 2, c4 = (tid & 3) * 4;
    f32x4 sum = (f32x4){0.f, 0.f, 0.f, 0.f};
#pragma unroll
    for (int ww = 0; ww < 8; ++ww) sum = sum + *(const LAS f32x4*)(part + (ww * 128 + row) * 16 + c4);
    if (EPI == 2) { f32x4* o = (f32x4*)((float*)outp + (size_t)row * ldc + c4); *o = *o + sum; }
    else if (EPI == 3) { float* o = (float*)outp + (size_t)row * ldc + c4;
#pragma unroll
        for (int j = 0; j < 4; ++j) (void)__hip_atomic_fetch_add(o + j, sum[j], __ATOMIC_RELAXED, __HIP_MEMORY_SCOPE_AGENT); }
    else { if (EPI == 1) {
#pragma unroll
            for (int j = 0; j < 4; ++j) { const float a = fmaxf(sum[j], 0.f); sum[j] = a * a; } }
        u32x2 o; o.x = pk(sum[0], sum[1]); o.y = pk(sum[2], sum[3]); *(u32x2*)((bf16_t*)outp + (size_t)row * ldc + c4) = o; }
    __syncthreads();
}

template <int KIND, bool hyb> DI void run_phase(const Params& P, LAS unsigned char* lds, const int L, const int tid, const int bid, const int G) {
    const int lane = tid & 63, wv = tid >> 6, gw = bid * 8 + wv, ngw = G * 8, li = L >> 1;
    unsigned char* ws = P.ws;
    bf16_t* H = (bf16_t*)(ws + WS_H); bf16_t* PROJ = (bf16_t*)(ws + WS_PROJ); bf16_t* YRAW = (bf16_t*)(ws + WS_YRAW); bf16_t* MIX = (bf16_t*)(ws + WS_MIX); bf16_t* ACT = (bf16_t*)(ws + WS_ACT);
    float* X = (float*)(ws + WS_X);
    if constexpr (KIND == 0) prologue(P, lds, gw, ngw, wv, lane);
    if constexpr (KIND == 1) norm_rows(P, P.in[7] + L * D, L == 0, gw, ngw, lane);
    if constexpr (KIND == 7) norm_rows(P, P.in[8] + L * D, false, gw, ngw, lane);
    if constexpr (KIND == 2 || KIND == 8) {
        constexpr bool up = KIND == 8;
        const bf16_t* Bt = up ? (const bf16_t*)(ws + WS_W1) + (size_t)L * FF * 1024 : (hyb ? (const bf16_t*)(ws + WS_WINH) + (size_t)li * NH * 1024 : (const bf16_t*)(ws + WS_WINS) + (size_t)li * NS * 1024);
        constexpr int N = up ? FF : (hyb ? NH : NS), NMAIN = up ? FF : (hyb ? NH : 5120);
        pg8::Gemm g{H, Bt, TP, NMAIN, 1024}; pg8::StaticOrder S; S.init(TP, NMAIN, G, bid); EpiB<up ? 1 : 0> E{up ? ACT : PROJ, N};
        pg8::gemm_phase<EpiB<up ? 1 : 0>, pg8::StaticOrder>((PG8_LAS unsigned char*)lds, g, S, E, nullptr, tid);
        constexpr int NCB = up ? FF / 16 : (hyb ? (NHR + 15) / 16 : NSR / 16);
        constexpr int NT = NCB + ((!up && !hyb) ? 256 : 0);
        const int nw = (!up && hyb) ? 64 : G;
        const int first = G - 1 - bid;
        if (first < nw) {
#pragma nounroll
            for (int t = first; t < NT; t += nw) {
                if (t < NCB) skinny_tile<up ? 1 : 0>(lds, H + (size_t)TP * 1024, Bt + (size_t)t * 16 * 1024, 1024, (up ? ACT : PROJ) + (size_t)TP * N + t * 16, N, tid);
                else { const int t2 = t - NCB, rb = t2 >> 1, cb = t2 & 1;
                    skinny_tile<0>(lds, H + (size_t)rb * 128 * 1024, Bt + (size_t)(5120 + cb * 16) * 1024, 1024, PROJ + (size_t)rb * 128 * N + 5120 + cb * 16, N, tid); }
            }
        }
    }
    if constexpr (KIND == 6 || KIND == 9) {
        constexpr bool dn = KIND == 9;
        const bf16_t* Bt = dn ? (const bf16_t*)(ws + WS_W2) + (size_t)L * 1024 * FF : (hyb ? (const bf16_t*)(ws + WS_WOUTH) + (size_t)li * 1024 * 1024 : (const bf16_t*)(ws + WS_WOUTS) + (size_t)li * 1024 * 2048);
        constexpr int K = dn ? FF : (hyb ? 1024 : 2048);
        pg8::Gemm g{dn ? ACT : MIX, Bt, TP, 1024, K}; pg8::StaticOrder S; S.init(TP, 1024, G, bid); EpiRes E{(bf16_t*)(ws + WS_X)};
        pg8::gemm_phase<EpiRes, pg8::StaticOrder>((PG8_LAS unsigned char*)lds, g, S, E, nullptr, tid);
        const int first = G - 1 - bid;
        constexpr int KS = K / 1024;
#pragma nounroll
        for (int t = first; t < 64 * KS; t += G) { const int ct = t / KS, ks = t % KS;
            skinny_tile<3>(lds, (dn ? ACT : MIX) + (size_t)TP * K + ks * 1024, Bt + (size_t)ct * 16 * K + ks * 1024, 1024, (float*)(ws + WS_XS) + ct * 16, 1024, tid, K); }
    }
    if constexpr (KIND == 3) {
        if constexpr (hyb) {
#pragma nounroll
            for (int u = bid; u < 1024; u += G) { const int b = u >> 7, c = (u >> 2) & 31, h = u & 3;
                gdn_prep_unit(lds, PROJ, P.in[11] + (size_t)li * 4 * 1536, P.in[12][li * 4 + h], P.in[13][li * 4 + h], ws + WS_CHK + CHK_GDN + (size_t)((b * 4 + h) * 32 + c) * GB_SIZE, b * SEQ + c * 64, h, tid); }
#ifdef PROBE_GDNPREP
#pragma nounroll
            for (int u = bid; u < 1024; u += G) { const int b = u >> 7, c = (u >> 2) & 31, h = u & 3;
                gdn_prep_unit(lds, PROJ, P.in[11] + (size_t)li * 4 * 1536, P.in[12][li * 4 + h], P.in[13][li * 4 + h], ws + WS_CHK + CHK_GDN + (size_t)((b * 4 + h) * 32 + c) * GB_SIZE, b * SEQ + c * 64, h, tid); }
#endif
#pragma nounroll
            for (int u2 = bid; u2 < 1024; u2 += G) { const int b = u2 >> 7, c = (u2 >> 2) & 31, h = u2 & 3;
                ret_prep_unit(lds, PROJ, ws + WS_CHK + CHK_RET + (size_t)((b * 4 + h) * 32 + c) * RB_SIZE, b * SEQ + c * 64, h, tid); }
        } else {
            for (int u = bid; u < 1024; u += G) { const int b = u >> 7, c = (u >> 2) & 31, g = u & 3;
                ssd_prep_unit(lds, PROJ, P.in[18] + (size_t)li * 4 * 3072, P.in[19] + (size_t)li * 3072, P.in[20] + li * 32, P.in[21] + li * 32, P.in[22] + li * 32,
                              ws + WS_CHK + CHK_SG + (size_t)((b * 4 + g) * 32 + c) * SG_SIZE, ws + WS_CHK + CHK_SH + (size_t)(((b * 16 + 4 * g) * 32 + c) * 2) * SH_SIZE, b * SEQ + c * 64, g, tid); }
        }
    }
    if constexpr (KIND == 4) {
        if constexpr (hyb) {
            if (bid < 128) { const int xq = bid & 7, jq = bid >> 3, bh = xq * 4 + (jq >> 2), b = bh >> 2, h = bh & 3;
                gdn_scan(lds, ws + WS_CHK + CHK_GDN + (size_t)((b * 4 + h) * 32) * GB_SIZE, YRAW, b * SEQ, h, P.out + O_PGDN + (size_t)((li * 8 + b) * 4 + h) * 128 * 128, tid, jq & 3); }
            else if (bid < 160) { const int b = (bid - 128) >> 2, h = bid & 3;
                ret_scan(lds, ws + WS_CHK + CHK_RET + (size_t)((b * 4 + h) * 32) * RB_SIZE, YRAW, b * SEQ, h, P.out + O_PRET + (size_t)((li * 8 + b) * 4 + h) * 64 * 128, tid); }
            for (;;) { const int u = steal_unit((unsigned*)(ws + WS_BAR) + XB_STEAL + 64 * L, lds, tid); if (u >= 1024) break;
                if (u < 512) gdn_sample_unit(lds, P, li, u >> 2, u & 3, tid); else ret_sample_unit(lds, P, li, (u - 512) >> 2, u & 3, tid); }
        } else {
#pragma nounroll
            for (int unit = bid; unit < 256; unit += G) { const int xq = unit & 7, jq = unit >> 3, grp = xq * 4 + (jq >> 3), b = grp >> 2, g = grp & 3, head = g * 8 + (jq & 7), u = head >> 1;
                ssd_scan(lds, ws + WS_CHK + CHK_SG + (size_t)((b * 4 + g) * 32) * SG_SIZE, ws + WS_CHK + CHK_SH + (size_t)(((b * 16 + u) * 32) * 2 + (head & 1)) * SH_SIZE, YRAW, b * SEQ, head,
                         P.out + O_PSSM + (size_t)((li * 8 + b) * 32 + head) * 128 * 64, tid); }
            for (;;) { const int u = steal_unit((unsigned*)(ws + WS_BAR) + XB_STEAL + 64 * L, lds, tid); if (u >= 512) break; ssd_sample_unit(lds, P, li, u >> 2, u & 3, tid); }
        }
    }
    if constexpr (KIND == 5) { if constexpr (hyb) gate_hyb(P, li, gw, ngw, lane); else gate_ssm(P, li, gw, ngw, lane); }
    if constexpr (KIND == 10) final_norm(P, gw, ngw, lane);
}
constexpr int LDS_ST = LDS_BYTES - 16;
template <int PH> DI void do_phase(const Params& p, cg::grid_group& grid, const int wid_s) {
    constexpr int kind = PH == 37 ? 10 : (PH == 0 ? 0 : 1 + (PH - 1) % 9), L = (PH == 0 || PH == 37) ? 0 : (PH - 1) / 9;
    constexpr bool hyb = (L & 1) == 0, hsel = (kind == 2 || kind == 3 || kind == 4 || kind == 5 || kind == 6) ? hyb : true;
    extern __shared__ __attribute__((aligned(16))) unsigned char smem[];
    int tid; asm volatile("v_mbcnt_lo_u32_b32 %0, -1, 0\n\tv_mbcnt_hi_u32_b32 %0, -1, %0" : "=v"(tid)); tid += wid_s * 64;
    unsigned lbase = 0; asm volatile("" : "+v"(lbase));
    LAS unsigned char* lds = (LAS unsigned char*)smem + lbase;
    int bid = blockIdx.x; asm volatile("" : "+s"(bid));
    int Gr = (int)gridDim.x; asm volatile("" : "+s"(Gr));
    run_phase<kind, hsel>(p, lds, L, tid, bid, Gr);
#ifdef PROBE_DUP
    if constexpr ((((PROBE_DUP) >> kind) & 1) && (PROBE_HYB == 2 || (PROBE_HYB == 1) == hyb)) { __syncthreads(); asm volatile("" : "+v"(tid)); run_phase<kind, hsel>(p, lds, L, tid, bid, Gr); }
#endif
    if (PH == 0) grid.sync();
    else if (PH < 37) { XcdBarrier b; b.bar = (unsigned*)(p.ws + WS_BAR); b.x = xb_xcc_id(); b.wid = wid_s; b.st = (volatile LAS unsigned*)((LAS unsigned char*)smem + LDS_ST); xcd_barrier(b); }
}
template <int... PH> DI void all_phases(const Params& p, cg::grid_group& grid, const int wid_s, std::integer_sequence<int, PH...>) { (do_phase<PH>(p, grid, wid_s), ...); }
__global__ void __launch_bounds__(512, 2) fwd_megakernel(Params p) {
    extern __shared__ __attribute__((aligned(16))) unsigned char smem[];
    cg::grid_group grid = cg::this_grid();
    const int wid_s = __builtin_amdgcn_readfirstlane(threadIdx.x >> 6);
    if (threadIdx.x == 0) { volatile LAS unsigned* st = (volatile LAS unsigned*)((LAS unsigned char*)smem + LDS_ST); st[0] = 0u; st[1] = 0u; }
    __syncthreads();
    (void)xcd_barrier_post((unsigned*)(p.ws + WS_BAR), (volatile LAS unsigned*)((LAS unsigned char*)smem + LDS_ST), wid_s);
    all_phases(p, grid, wid_s, std::make_integer_sequence<int, 38>{});
}

extern "C" void kernel_launch(void* const* d_in, const int* in_sizes, int n_in, void* d_out, int out_size, void* d_ws, size_t ws_size, hipStream_t stream) {
    static int grid = 0;
    if (grid == 0) {
        if (n_in != 27 || ws_size < WS_END) { fprintf(stderr, "kernel_launch: bad inputs n_in=%d ws=%zu need %zu\n", n_in, ws_size, (size_t)WS_END); grid = -1; return; }
        int dev = 0, cus = 0, per_cu = 0;
        (void)hipGetDevice(&dev); (void)hipDeviceGetAttribute(&cus, hipDeviceAttributeMultiprocessorCount, dev);
        if (hipFuncSetAttribute((const void*)fwd_megakernel, hipFuncAttributeMaxDynamicSharedMemorySize, LDS_BYTES) != hipSuccess) { fprintf(stderr, "kernel_launch: hipFuncSetAttribute failed\n"); grid = -1; return; }
        (void)hipOccupancyMaxActiveBlocksPerMultiprocessor(&per_cu, (const void*)fwd_megakernel, 512, LDS_BYTES);
        if (per_cu < 1) { fprintf(stderr, "kernel_launch: occupancy query says %d blocks/CU\n", per_cu); per_cu = 1; }
        (void)hipGetLastError();
        grid = cus;
        if (grid < 192) fprintf(stderr, "kernel_launch: only %d CUs\n", grid);
    }
    if (grid < 0) return;
    Params p{};
    for (int i = 0; i < 27; ++i) p.in[i] = (const float*)d_in[i];
    p.out = (float*)d_out; p.ws = (unsigned char*)d_ws; p.ph_lo = 0; p.ph_hi = 38;
    if (hipMemsetAsync((char*)d_ws + WS_BAR, 0, 16384, stream) != hipSuccess) { fprintf(stderr, "kernel_launch: memset failed\n"); return; }
    void* args[] = {&p};
    hipError_t e = hipLaunchCooperativeKernel((const void*)fwd_megakernel, dim3(grid), dim3(512), args, LDS_BYTES, stream);
    if (e != hipSuccess) fprintf(stderr, "cooperative launch failed: %s (grid %d)\n", hipGetErrorString(e), grid);
}
```

```cpp
#include <hip/hip_runtime.h>
#include <hip/hip_cooperative_groups.h>
#include <cstdio>
#include <utility>
namespace cg = cooperative_groups;
namespace pg8 {
#define PG8_LAS __attribute__((address_space(3)))
typedef unsigned short bf16_t;
typedef short bf16x8 __attribute__((ext_vector_type(8)));
typedef float f32x4 __attribute__((ext_vector_type(4)));
typedef unsigned u32x4 __attribute__((ext_vector_type(4)));
constexpr int BM = 256, BK = 64, HALF = 128, HTB = HALF * BK * 2  , STAGE_BYTES = 8 * HTB, NXCD = 8, WGM = 8;

__host__ __device__ __forceinline__ int lds_byte(int r, int c) { const int st = (r >> 4) * 2 + (c >> 5), rr = r & 15, cc = c & 31, ob = rr * 64 + cc * 2; return st * 1024 + (ob ^ (((ob >> 9) & 1) << 5)); }
__host__ __device__ __forceinline__ void stage_rc(int b, int& R, int& C) { const int st = b / 1024, sb = b % 1024, swz = sb ^ (((sb >> 9) & 1) << 5); R = (st >> 1) * 16 + swz / 64; C = (st & 1) * 32 + (swz % 64) / 2; }
__host__ __device__ __forceinline__ int perm32(int rho) { const int n = rho >> 4, i = rho & 15; return 8 * (i >> 2) + 4 * n + (i & 3); }

struct Unit { int pm, pn; };
struct Gemm { const bf16_t* A; const bf16_t* Bt; int M, N, K; };

struct StaticOrder {
    int nM, nN, nwg, G, c;
    __host__ __device__ void init(int M, int N, int G_, int c_) { nM = M / BM; nN = N / BM; nwg = nM * nN; G = G_; c = c_; }
    __host__ __device__ bool next(int i, Unit& u) const {
        const long L = (long)i * G + c; if (L >= nwg) return false;
        int wgid = (int)L; { const int q = nwg / NXCD, r = nwg % NXCD, xcd = wgid % NXCD, off = wgid / NXCD; wgid = (xcd < r ? xcd * (q + 1) : r * (q + 1) + (xcd - r) * q) + off; }
        const int nig = WGM * nN, gid = wgid / nig, fm = gid * WGM, gsz = (nM - fm) < WGM ? (nM - fm) : WGM;
        u.pm = fm + ((wgid % nig) % gsz); u.pn = (wgid % nig) / gsz; return true;
    }
    __device__ __forceinline__ void a_ready(const Unit&) const {}
    __device__ __forceinline__ void done(const Unit&) const {}
};
template <class Epi, class Sched, bool STAMP = false>
__device__ __forceinline__ void gemm_phase(PG8_LAS unsigned char* lds, const Gemm g, const Sched& S, const Epi& E, unsigned long long* stamps, const int tid_in) {
    const int tid = tid_in, wid = __builtin_amdgcn_readfirstlane(tid >> 6), lane = tid & 63, wr = wid >> 2, wc = wid & 3, fr = lane & 15, fq = lane >> 4;
    const int K = g.K, nt = K / BK;
    int ts_lo = 0, ts_hi = 0, nts = 0; const unsigned long long rt_entry = STAMP ? (unsigned long long)wall_clock64() : 0ull;
#define PG8_STAMP() do { if (STAMP && wid == 0 && nts < 64) { const unsigned long long _c = (unsigned long long)clock64(); \
        ts_lo = (lane == nts) ? (int)(unsigned)_c : ts_lo; ts_hi = (lane == nts) ? (int)(unsigned)(_c >> 32) : ts_hi; ++nts; } } while (0)
    PG8_STAMP();
    unsigned voffA[2], voffB[2];
#pragma unroll
    for (int i = 0; i < 2; ++i) { int R, C; stage_rc(tid * 16 + i * 8192, R, C); const int Rb = Epi::PERM ? ((R & ~31) + perm32(R & 31)) : R;
        voffA[i] = (unsigned)(R * K + C) * 2u; voffB[i] = (unsigned)(Rb * K + C) * 2u; }
    const size_t kstep = (size_t)(BK * 2);
    const size_t hstep = (size_t)HALF * K * 2;
    const size_t tstep = 2 * hstep;
    const unsigned ldsw = (unsigned)wid * 1024u;
    const int aoff = lds_byte(wr * 64 + fr, fq * 8), boff = lds_byte(wc * 32 + fr, fq * 8);
#define PG8_SA(b, h) (((b) * 2 + (h)) * HTB)
#define PG8_SB(b, h) ((4 + (b) * 2 + (h)) * HTB)
#define PG8_STAGE(bufoff, gbase, voff) do { _Pragma("unroll") for (int _i = 0; _i < 2; ++_i) \
        __builtin_amdgcn_global_load_lds((const unsigned*)((const char*)(gbase) + (voff)[_i]), (PG8_LAS unsigned*)(lds + (bufoff) + ldsw + _i * 8192), 16, 0, 0); } while (0)
#define PG8_LDA(dst, b, h) do { _Pragma("unroll") for (int m = 0; m < 4; ++m) _Pragma("unroll") for (int k = 0; k < 2; ++k) dst[m][k] = *(const PG8_LAS bf16x8*)(lds + PG8_SA(b, h) + aoff + m * 2048 + k * 1024); } while (0)
#define PG8_LDB(dst, b, h) do { _Pragma("unroll") for (int n = 0; n < 2; ++n) _Pragma("unroll") for (int k = 0; k < 2; ++k) dst[n][k] = *(const PG8_LAS bf16x8*)(lds + PG8_SB(b, h) + boff + n * 2048 + k * 1024); } while (0)
#define PG8_MMA(ai, bj, At, Bt) do { __builtin_amdgcn_s_setprio(1); _Pragma("unroll") for (int m = 0; m < 4; ++m) _Pragma("unroll") for (int n = 0; n < 2; ++n) _Pragma("unroll") for (int k = 0; k < 2; ++k) \
        acc[ai][bj][m][n] = __builtin_amdgcn_mfma_f32_16x16x32_bf16(Bt[n][k], At[m][k], acc[ai][bj][m][n], 0, 0, 0); __builtin_amdgcn_s_setprio(0); } while (0)
#define PG8_WAIT_V(n) asm volatile("s_waitcnt vmcnt(" #n ")" ::: "memory")
#define PG8_WAIT_L(n) asm volatile("s_waitcnt lgkmcnt(" #n ")" ::: "memory")
#define PG8_BAR __builtin_amdgcn_s_barrier()
#define PG8_SCHED __builtin_amdgcn_sched_barrier(0)
    Unit cur, nxt; int ui = 0;
    if (!S.next(0, cur)) return;
    f32x4 acc[2][2][4][2];
#pragma unroll
    for (int a = 0; a < 2; ++a)
#pragma unroll
        for (int b = 0; b < 2; ++b)
#pragma unroll
            for (int m = 0; m < 4; ++m)
#pragma unroll
                for (int n = 0; n < 2; ++n) acc[a][b][m][n] = (f32x4){0.f, 0.f, 0.f, 0.f};
    bf16x8 At[4][2], B0[2][2], B1[2][2];
    const char* cA = (const char*)g.A + (size_t)cur.pm * tstep; const char* cB = (const char*)g.Bt + (size_t)cur.pn * tstep;
    S.a_ready(cur);
    PG8_STAGE(PG8_SB(0, 0), cB, voffB); PG8_STAGE(PG8_SA(0, 0), cA, voffA); PG8_STAGE(PG8_SB(0, 1), cB + hstep, voffB); PG8_STAGE(PG8_SA(0, 1), cA + hstep, voffA);
    if (wr == 1) PG8_BAR;
    PG8_WAIT_V(4); PG8_BAR;
    PG8_STAGE(PG8_SB(1, 0), cB + kstep, voffB); PG8_STAGE(PG8_SA(1, 0), cA + kstep, voffA); PG8_STAGE(PG8_SB(1, 1), cB + hstep + kstep, voffB);
    PG8_WAIT_V(6); PG8_BAR;
    PG8_STAMP();
    for (;;) {
        const bool has_next = S.next(ui + 1, nxt);
        const char* nA = has_next ? (const char*)g.A + (size_t)nxt.pm * tstep : cA; const char* nB = has_next ? (const char*)g.Bt + (size_t)nxt.pn * tstep : cB;
        for (int t = 0; t < nt; t += 2) {
            const bool last = (t == nt - 2);
            const char* a1 = cA + (size_t)(t + 1) * kstep;
            const char* a2 = last ? nA : cA + (size_t)(t + 2) * kstep; const char* b2 = last ? nB : cB + (size_t)(t + 2) * kstep;
            const char* a3 = a2 + kstep; const char* b3 = b2 + kstep;
            if (last && has_next) S.a_ready(nxt);
            PG8_LDB(B0, 0, 0); PG8_SCHED; PG8_LDA(At, 0, 0); PG8_STAGE(PG8_SA(1, 1), a1 + hstep, voffA);
            PG8_WAIT_L(8); PG8_BAR; PG8_WAIT_L(0); PG8_MMA(0, 0, At, B0); PG8_BAR; PG8_SCHED;
            PG8_LDB(B1, 0, 1); PG8_STAGE(PG8_SB(0, 0), b2, voffB);
            PG8_BAR; PG8_WAIT_L(0); PG8_MMA(0, 1, At, B1); PG8_BAR;
            PG8_LDA(At, 0, 1); PG8_STAGE(PG8_SA(0, 0), a2, voffA);
            PG8_BAR; PG8_WAIT_L(0); PG8_MMA(1, 0, At, B0); PG8_BAR; PG8_SCHED;
            PG8_STAGE(PG8_SB(0, 1), b2 + hstep, voffB);
            PG8_WAIT_V(6); PG8_BAR; PG8_MMA(1, 1, At, B1); PG8_BAR;
            PG8_LDB(B0, 1, 0); PG8_SCHED; PG8_LDA(At, 1, 0); PG8_STAGE(PG8_SA(0, 1), a2 + hstep, voffA);
            PG8_WAIT_L(8); PG8_BAR; PG8_WAIT_L(0); PG8_MMA(0, 0, At, B0); PG8_BAR; PG8_SCHED;
            PG8_LDB(B1, 1, 1); PG8_STAGE(PG8_SB(1, 0), b3, voffB);
            PG8_BAR; PG8_WAIT_L(0); PG8_MMA(0, 1, At, B1); PG8_BAR;
            PG8_LDA(At, 1, 1); PG8_STAGE(PG8_SA(1, 0), a3, voffA);
            PG8_BAR; PG8_WAIT_L(0); PG8_MMA(1, 0, At, B0); PG8_BAR; PG8_SCHED;
            PG8_STAGE(PG8_SB(1, 1), b3 + hstep, voffB);
            PG8_WAIT_V(6); PG8_BAR; PG8_MMA(1, 1, At, B1); PG8_BAR;
        }
        PG8_STAMP();
        if constexpr (!Epi::AFTER_DRAIN) { E(acc, cur, wr, wc, fr, fq); S.done(cur); }
        PG8_STAMP();
        if (!has_next) break;
#pragma unroll
        for (int a = 0; a < 2; ++a)
#pragma unroll
            for (int b = 0; b < 2; ++b)
#pragma unroll
                for (int m = 0; m < 4; ++m)
#pragma unroll
                    for (int n = 0; n < 2; ++n) acc[a][b][m][n] = (f32x4){0.f, 0.f, 0.f, 0.f};
        cur = nxt; cA = nA; cB = nB; ++ui;
    }
    PG8_WAIT_V(0);
    if (wr == 0) PG8_BAR;
    PG8_BAR;
    if constexpr (Epi::AFTER_DRAIN) { E.fused(acc, cur, wr, wc, fr, fq, lds, wid, lane); S.done(cur); }
    PG8_STAMP();
    if (STAMP && wid == 0) { stamps[lane] = lane < nts ? (((unsigned long long)(unsigned)ts_hi << 32) | (unsigned)ts_lo) : 0ull;
        if (lane == 62) stamps[62] = rt_entry; if (lane == 63) stamps[63] = (unsigned long long)wall_clock64(); }
#undef PG8_STAMP
#undef PG8_SA
#undef PG8_SB
#undef PG8_STAGE
#undef PG8_LDA
#undef PG8_LDB
#undef PG8_MMA
#undef PG8_WAIT_V
#undef PG8_WAIT_L
#undef PG8_BAR
#undef PG8_SCHED
}
}

#define DI __device__ __forceinline__
#define LAS __attribute__((address_space(3)))
using pg8::bf16_t; using pg8::bf16x8; using pg8::f32x4; using pg8::u32x4;
typedef short s16x4 __attribute__((ext_vector_type(4)));
typedef unsigned u32x2 __attribute__((ext_vector_type(2)));
typedef float f32x2 __attribute__((ext_vector_type(2)));
typedef __bf16 bfv2 __attribute__((ext_vector_type(2)));

constexpr int D = 1024, TP = 16384, TS = 128, TR = TP + TS, MP = 16640, SEQ = 2048;
constexpr int NH = 3840, NHR = 3592, NS = 5376, NSR = 5152, FF = 4096;
constexpr int LDS_BYTES = 150 * 1024;
constexpr size_t O_YP = 0, O_YS = 16777216, O_PGDN = O_YS + 131072, O_PGC = O_PGDN + 1048576, O_PRET = O_PGC + 73728, O_PSSM = O_PRET + 524288,
                 O_PSC = O_PSSM + 4194304, O_SGDN = O_PSC + 147456, O_SGC = O_SGDN + 16777216, O_SRET = O_SGC + 1179648, O_SSSM = O_SRET + 8388608, O_SSC = O_SSSM + 67108864;
constexpr size_t WS_WINH = 0, WS_WOUTH = WS_WINH + 2ull * NH * 1024 * 2, WS_WINS = WS_WOUTH + 2ull * 1024 * 1024 * 2, WS_WOUTS = WS_WINS + 2ull * NS * 1024 * 2,
                 WS_W1 = WS_WOUTS + 2ull * 1024 * 2048 * 2, WS_W2 = WS_W1 + 4ull * 4096 * 1024 * 2, WS_X = WS_W2 + 4ull * 4096 * 1024 * 2, WS_H = WS_X + (size_t)MP * 1024 * 4,
                 WS_PROJ = WS_H + (size_t)MP * 1024 * 2, WS_YRAW = WS_PROJ + (size_t)MP * NS * 2, WS_MIX = WS_YRAW + (size_t)MP * 2048 * 2, WS_ACT = WS_MIX + (size_t)MP * 2048 * 2,
                 WS_CHK = WS_ACT + (size_t)MP * 4096 * 2;
constexpr int GB_NW = 0, GB_QG = 17408, GB_P = 34816, GB_KDT = 44032, GB_UT = 62464, GB_SC = 80896, GB_SIZE = 80960;
constexpr int RB_QG = 0, RB_P = 9216, RB_KDT = 18432, RB_VT = 27648, RB_SC = 46080, RB_SIZE = 46144;
constexpr int SG_CM = 0, SG_BT = 17408, SG_SIZE = 35840;
constexpr int SH_XT = 0, SH_PP = 9216, SH_SC = 18432, SH_SIZE = 19456;
constexpr size_t CHK_GDN = 0, CHK_RET = 1024ull * GB_SIZE, CHK_SG = 0, CHK_SH = 1024ull * SG_SIZE, CHK_END = 1024ull * GB_SIZE + 1024ull * RB_SIZE;
constexpr size_t WS_BAR = WS_CHK + (CHK_END > (1024ull * SG_SIZE + 8192ull * SH_SIZE) ? CHK_END : (1024ull * SG_SIZE + 8192ull * SH_SIZE));
constexpr size_t WS_END = WS_BAR + 16384;

struct Params { const float* in[27]; float* out; unsigned char* ws; int ph_lo, ph_hi; };

DI unsigned pk(float a, float b) { f32x2 v = {a, b}; bfv2 r = __builtin_convertvector(v, bfv2); return __builtin_bit_cast(unsigned, r); }
DI bf16_t f2bf(float a) { return (bf16_t)(pk(a, a) & 0xffffu); }
DI float bf2f(bf16_t b) { return __uint_as_float((unsigned)b << 16); }
DI float bflo(unsigned u) { return __uint_as_float(u << 16); }
DI float bfhi(unsigned u) { return __uint_as_float(u & 0xffff0000u); }
DI float wsum(float v) {
#pragma unroll
    for (int o = 32; o >= 1; o >>= 1) v += __shfl_xor(v, o);
    return v; }
DI float siluf(float x) { return x / (1.f + __expf(-x)); }
DI float softplusf(float x) { return fmaxf(x, 0.f) + log1pf(__expf(-fabsf(x))); }
DI bf16x8 lda_nat(const LAS unsigned char* base, int row, int strideB, int k0, int q) { return *(const LAS bf16x8*)(base + row * strideB + (k0 + 8 * q) * 2); }
DI bf16x8 lda_perm(const LAS unsigned char* base, int row, int strideB, int k0, int q) {
    const s16x4 lo = *(const LAS s16x4*)(base + row * strideB + (k0 + 4 * q) * 2);
    const s16x4 hi = *(const LAS s16x4*)(base + row * strideB + (k0 + 16 + 4 * q) * 2);
    return __builtin_shufflevector(lo, hi, 0, 1, 2, 3, 4, 5, 6, 7); }
DI bf16x8 pack2(f32x4 a, f32x4 b) { u32x4 p; p.x = pk(a[0], a[1]); p.y = pk(a[2], a[3]); p.z = pk(b[0], b[1]); p.w = pk(b[2], b[3]); return __builtin_bit_cast(bf16x8, p); }
#define MFMA16(a, b, c) __builtin_amdgcn_mfma_f32_16x16x32_bf16((a), (b), (c), 0, 0, 0)

template <int ACT> struct EpiB {
    static constexpr bool PERM = true, AFTER_DRAIN = false;
    bf16_t* O; int ldc;
    DI void operator()(const f32x4 (&acc)[2][2][4][2], const pg8::Unit& u, int wr, int wc, int fr, int fq) const {
        const int row0 = u.pm * 256 + wr * 64 + fr, col0 = u.pn * 256 + wc * 32 + 8 * fq;
#pragma unroll
        for (int ai = 0; ai < 2; ++ai)
#pragma unroll
            for (int m = 0; m < 4; ++m) { bf16_t* rowp = O + (size_t)(row0 + ai * 128 + m * 16) * ldc + col0;
#pragma unroll
                for (int bj = 0; bj < 2; ++bj) { f32x4 v0 = acc[ai][bj][m][0], v1 = acc[ai][bj][m][1];
                    if (ACT == 1) {
#pragma unroll
                        for (int j = 0; j < 4; ++j) { const float a = fmaxf(v0[j], 0.f), b = fmaxf(v1[j], 0.f); v0[j] = a * a; v1[j] = b * b; } }
                    u32x4 w; w.x = pk(v0[0], v0[1]); w.y = pk(v0[2], v0[3]); w.z = pk(v1[0], v1[1]); w.w = pk(v1[2], v1[3]);
                    *(u32x4*)(rowp + bj * 128) = w; } }
    }
};
struct EpiRes {
    static constexpr bool PERM = true, AFTER_DRAIN = false;
    bf16_t* X;
    DI void operator()(const f32x4 (&acc)[2][2][4][2], const pg8::Unit& u, int wr, int wc, int fr, int fq) const {
        const int row0 = u.pm * 256 + wr * 64 + fr, col0 = u.pn * 256 + wc * 32 + 8 * fq;
#pragma unroll
        for (int ai = 0; ai < 2; ++ai)
#pragma unroll
            for (int m = 0; m < 4; ++m) { bf16_t* rowp = X + (size_t)(row0 + ai * 128 + m * 16) * D + col0;
#pragma unroll
                for (int bj = 0; bj < 2; ++bj) { u32x4* p = (u32x4*)(rowp + bj * 128); const u32x4 o = *p; const f32x4 a = acc[ai][bj][m][0], b = acc[ai][bj][m][1];
                    u32x4 w; w.x = pk(bflo(o.x) + a[0], bfhi(o.x) + a[1]); w.y = pk(bflo(o.y) + a[2], bfhi(o.y) + a[3]);
                    w.z = pk(bflo(o.z) + b[0], bfhi(o.z) + b[1]); w.w = pk(bflo(o.w) + b[2], bfhi(o.w) + b[3]); *p = w; } }
    }
};

DI void tload(const float* W, int N, int item, int nblk, int lane, f32x4 (&tv)[8]) {
    const int kb = item / nblk, nb = item % nblk, k0 = 64 * kb, n0 = 32 * nb;
    const int n4 = (lane & 7) * 4, kr = lane >> 3; const bool ok = n0 + n4 < N;
#pragma unroll
    for (int i = 0; i < 8; ++i) tv[i] = ok ? __builtin_nontemporal_load((const f32x4*)(W + (size_t)(k0 + 8 * i + kr) * N + n0 + n4)) : (f32x4){0.f, 0.f, 0.f, 0.f};
}
DI void tstore(const f32x4 (&tv)[8], int K, bf16_t* WT, LAS float* scr, int item, int nblk, int lane) {
    const int kb = item / nblk, nb = item % nblk, k0 = 64 * kb, n0 = 32 * nb;
    const int n4 = (lane & 7) * 4, kr = lane >> 3;
#pragma unroll
    for (int i = 0; i < 8; ++i) { LAS float* d = scr + (8 * i + kr) * 33 + n4; d[0] = tv[i][0]; d[1] = tv[i][1]; d[2] = tv[i][2]; d[3] = tv[i][3]; }
    __builtin_amdgcn_s_waitcnt(0xc07f); asm volatile("" ::: "memory");
    const int c = lane & 7;
#pragma unroll
    for (int j = 0; j < 4; ++j) { const int nn = (lane >> 3) + 8 * j; const LAS float* s = scr + (8 * c) * 33 + nn;
        u32x4 o; o.x = pk(s[0 * 33], s[1 * 33]); o.y = pk(s[2 * 33], s[3 * 33]); o.z = pk(s[4 * 33], s[5 * 33]); o.w = pk(s[6 * 33], s[7 * 33]);
        __builtin_nontemporal_store(o, (u32x4*)(WT + (size_t)(n0 + nn) * K + k0 + 8 * c)); }
    __builtin_amdgcn_s_waitcnt(0xc07f); asm volatile("" ::: "memory");
}
DI void prologue(const Params& p, LAS unsigned char* lds, int gw, int ngw, int wv, int lane) {
    LAS float* scr = (LAS float*)(lds + wv * 8704);
    for (int mat = 0; mat < 6; ++mat) {
        const float* src; int K, N, Np, cnt; size_t dst;
        switch (mat) {
            case 0: src = p.in[10]; K = 1024; N = NHR; Np = NH; cnt = 2; dst = WS_WINH; break;
            case 1: src = p.in[16]; K = 1024; N = 1024; Np = 1024; cnt = 2; dst = WS_WOUTH; break;
            case 2: src = p.in[17]; K = 1024; N = NSR; Np = NS; cnt = 2; dst = WS_WINS; break;
            case 3: src = p.in[24]; K = 2048; N = 1024; Np = 1024; cnt = 2; dst = WS_WOUTS; break;
            case 4: src = p.in[25]; K = 1024; N = FF; Np = FF; cnt = 4; dst = WS_W1; break;
            default: src = p.in[26]; K = FF; N = 1024; Np = 1024; cnt = 4; dst = WS_W2; break;
        }
        const int nblk = Np / 32, per = (K / 64) * nblk, tot = per * cnt;
        f32x4 ta[8], tb[8];
        int it = gw;
        if (it < tot) tload(src + (size_t)(it / per) * K * N, N, it % per, nblk, lane, ta);
#pragma nounroll
        for (; it < tot; it += 2 * ngw) {
            const int it2 = it + ngw;
            if (it2 < tot) tload(src + (size_t)(it2 / per) * K * N, N, it2 % per, nblk, lane, tb);
            tstore(ta, K, (bf16_t*)(p.ws + dst) + (size_t)(it / per) * Np * K, scr, it % per, nblk, lane);
            const int it3 = it2 + ngw;
            if (it3 < tot) tload(src + (size_t)(it3 / per) * K * N, N, it3 % per, nblk, lane, ta);
            if (it2 < tot) tstore(tb, K, (bf16_t*)(p.ws + dst) + (size_t)(it2 / per) * Np * K, scr, it2 % per, nblk, lane);
        }
    }
    bf16_t* H = (bf16_t*)(p.ws + WS_H);
    for (int m = TR + gw; m < MP; m += ngw) { u32x4 z = {0u, 0u, 0u, 0u}; *(u32x4*)(H + (size_t)m * D + lane * 8) = z; *(u32x4*)(H + (size_t)m * D + 512 + lane * 8) = z; }
}

constexpr size_t WS_XS = WS_X + (size_t)MP * 1024 * 2;
DI void norm_rows(const Params& p, const float* w, bool copy, int gw, int ngw, int lane) {
    bf16_t* X16 = (bf16_t*)(p.ws + WS_X); float* Xs = (float*)(p.ws + WS_XS); bf16_t* H = (bf16_t*)(p.ws + WS_H);
    f32x4 wv[4];
#pragma unroll
    for (int j = 0; j < 2; ++j) { wv[2 * j] = *(const f32x4*)(w + 8 * lane + 512 * j); wv[2 * j + 1] = *(const f32x4*)(w + 8 * lane + 512 * j + 4); }
    for (int m0 = gw * 2; m0 < TP; m0 += ngw * 2) {
        f32x4 v[2][4];
#pragma unroll
        for (int rr = 0; rr < 2; ++rr) { const int m = m0 + rr;
            if (copy) {
#pragma unroll
                for (int j = 0; j < 2; ++j) { v[rr][2 * j] = __builtin_nontemporal_load((const f32x4*)(p.in[0] + (size_t)m * D + 8 * lane + 512 * j)); v[rr][2 * j + 1] = __builtin_nontemporal_load((const f32x4*)(p.in[0] + (size_t)m * D + 8 * lane + 512 * j + 4)); }
            } else {
#pragma unroll
                for (int j = 0; j < 2; ++j) { const u32x4 u = *(const u32x4*)(X16 + (size_t)m * D + 8 * lane + 512 * j);
                    v[rr][2 * j] = (f32x4){bflo(u.x), bfhi(u.x), bflo(u.y), bfhi(u.y)}; v[rr][2 * j + 1] = (f32x4){bflo(u.z), bfhi(u.z), bflo(u.w), bfhi(u.w)}; }
            } }
#pragma unroll
        for (int rr = 0; rr < 2; ++rr) { const int m = m0 + rr; float ss = 0.f;
#pragma unroll
            for (int j = 0; j < 4; ++j) ss += v[rr][j][0] * v[rr][j][0] + v[rr][j][1] * v[rr][j][1] + v[rr][j][2] * v[rr][j][2] + v[rr][j][3] * v[rr][j][3];
            ss = wsum(ss); const float r = rsqrtf(ss * (1.f / 1024.f) + 1e-6f);
#pragma unroll
            for (int j = 0; j < 2; ++j) { const f32x4 a = v[rr][2 * j], b = v[rr][2 * j + 1];
                if (copy) { u32x4 xo; xo.x = pk(a[0], a[1]); xo.y = pk(a[2], a[3]); xo.z = pk(b[0], b[1]); xo.w = pk(b[2], b[3]); *(u32x4*)(X16 + (size_t)m * D + 8 * lane + 512 * j) = xo; }
                u32x4 o; o.x = pk(a[0] * r * wv[2 * j][0], a[1] * r * wv[2 * j][1]); o.y = pk(a[2] * r * wv[2 * j][2], a[3] * r * wv[2 * j][3]);
                o.z = pk(b[0] * r * wv[2 * j + 1][0], b[1] * r * wv[2 * j + 1][1]); o.w = pk(b[2] * r * wv[2 * j + 1][2], b[3] * r * wv[2 * j + 1][3]);
                *(u32x4*)(H + (size_t)m * D + 8 * lane + 512 * j) = o; } }
    }
    for (int m = TP + gw; m < TR; m += ngw) {
        const float* src = copy ? p.in[1] + (size_t)(m - TP) * D : Xs + (size_t)(m - TP) * D;
        f32x4 v[4]; float ss = 0.f;
#pragma unroll
        for (int j = 0; j < 4; ++j) { v[j] = *(const f32x4*)(src + 4 * lane + 256 * j); ss += v[j][0] * v[j][0] + v[j][1] * v[j][1] + v[j][2] * v[j][2] + v[j][3] * v[j][3]; }
        ss = wsum(ss); const float r = rsqrtf(ss * (1.f / 1024.f) + 1e-6f);
#pragma unroll
        for (int j = 0; j < 4; ++j) { const f32x4 ww = *(const f32x4*)(w + 4 * lane + 256 * j);
            if (copy) *(f32x4*)(Xs + (size_t)(m - TP) * D + 4 * lane + 256 * j) = v[j];
            u32x2 o; o.x = pk(v[j][0] * r * ww[0], v[j][1] * r * ww[1]); o.y = pk(v[j][2] * r * ww[2], v[j][3] * r * ww[3]);
            *(u32x2*)(H + (size_t)m * D + 4 * lane + 256 * j) = o; }
    }
}
DI void final_norm(const Params& p, int gw, int ngw, int lane) {
    const bf16_t* X16 = (const bf16_t*)(p.ws + WS_X); const float* Xs = (const float*)(p.ws + WS_XS); const float* w = p.in[9];
    f32x4 wv[4];
#pragma unroll
    for (int j = 0; j < 2; ++j) { wv[2 * j] = *(const f32x4*)(w + 8 * lane + 512 * j); wv[2 * j + 1] = *(const f32x4*)(w + 8 * lane + 512 * j + 4); }
    for (int m0 = gw * 2; m0 < TP; m0 += ngw * 2) {
        f32x4 v[2][4];
#pragma unroll
        for (int rr = 0; rr < 2; ++rr)
#pragma unroll
            for (int j = 0; j < 2; ++j) { const u32x4 u = *(const u32x4*)(X16 + (size_t)(m0 + rr) * D + 8 * lane + 512 * j);
                v[rr][2 * j] = (f32x4){bflo(u.x), bfhi(u.x), bflo(u.y), bfhi(u.y)}; v[rr][2 * j + 1] = (f32x4){bflo(u.z), bfhi(u.z), bflo(u.w), bfhi(u.w)}; }
#pragma unroll
        for (int rr = 0; rr < 2; ++rr) { const int m = m0 + rr; float ss = 0.f; float* dst = p.out + O_YP + (size_t)m * D;
#pragma unroll
            for (int j = 0; j < 4; ++j) ss += v[rr][j][0] * v[rr][j][0] + v[rr][j][1] * v[rr][j][1] + v[rr][j][2] * v[rr][j][2] + v[rr][j][3] * v[rr][j][3];
            ss = wsum(ss); const float r = rsqrtf(ss * (1.f / 1024.f) + 1e-6f);
#pragma unroll
            for (int j = 0; j < 2; ++j) { __builtin_nontemporal_store(v[rr][2 * j] * r * wv[2 * j], (f32x4*)(dst + 8 * lane + 512 * j)); __builtin_nontemporal_store(v[rr][2 * j + 1] * r * wv[2 * j + 1], (f32x4*)(dst + 8 * lane + 512 * j + 4)); } }
    }
    for (int m = TP + gw; m < TR; m += ngw) {
        const float* src = Xs + (size_t)(m - TP) * D; float* dst = p.out + O_YS + (size_t)(m - TP) * D;
        f32x4 v[4]; float ss = 0.f;
#pragma unroll
        for (int j = 0; j < 4; ++j) { v[j] = *(const f32x4*)(src + 4 * lane + 256 * j); ss += v[j][0] * v[j][0] + v[j][1] * v[j][1] + v[j][2] * v[j][2] + v[j][3] * v[j][3]; }
        ss = wsum(ss); const float r = rsqrtf(ss * (1.f / 1024.f) + 1e-6f);
#pragma unroll
        for (int j = 0; j < 4; ++j) { const f32x4 ww = *(const f32x4*)(w + 4 * lane + 256 * j); *(f32x4*)(dst + 4 * lane + 256 * j) = v[j] * r * ww; }
    }
}

constexpr int P_KN = 0, P_QN = 17408, P_KBT = 34816, P_KDT = 53248, P_VBT = 71680, P_AM = 90112, P_TM = 107520, P_SC = 116736, P_TF = 117760;
DI void gdn_prep_unit(LAS unsigned char* lds, const bf16_t* PROJ, const float* convw, float a_log_h, float dtb_h, unsigned char* blk, int row0, int h, int tid) {
    asm volatile("" : "+v"(tid));
    const int lane = tid & 63, w = tid >> 6, r = lane & 15, q = lane >> 4;
    LAS float* scG = (LAS float*)(lds + P_SC); LAS float* scC = scG + 64; LAS float* scB = scG + 128;
    if (w == 0) {
        const bf16_t* pr = PROJ + (size_t)(row0 + lane) * NH;
        const float braw = bf2f(pr[2048 + h]), araw = bf2f(pr[2052 + h]);
        const float beta = 1.f / (1.f + __expf(-braw));
        const float g = -__expf(a_log_h) * softplusf(araw + dtb_h);
        float c = g;
#pragma unroll
        for (int o = 1; o < 64; o <<= 1) { const float t = __shfl_up(c, o); if (lane >= o) c += t; }
        scG[lane] = g; scC[lane] = c; scB[lane] = beta;
    }
    __syncthreads();
    const float gend = scC[63];
    float cw[3][4][2];
#pragma unroll
    for (int grp = 0; grp < 3; ++grp)
#pragma unroll
        for (int tap = 0; tap < 4; ++tap) { const f32x2 t = *(const f32x2*)(convw + tap * 1536 + grp * 512 + h * 128 + 2 * lane); cw[grp][tap][0] = t[0]; cw[grp][tap][1] = t[1]; }
    LAS bf16_t* kbt = (LAS bf16_t*)(lds + P_KBT); LAS bf16_t* kdt = (LAS bf16_t*)(lds + P_KDT); LAS bf16_t* vbt = (LAS bf16_t*)(lds + P_VBT);
    unsigned xr[11][3];
#pragma unroll
    for (int j = 0; j < 11; ++j) { const int t = (row0 & (SEQ - 1)) + w * 8 - 3 + j; const bf16_t* pr = PROJ + (size_t)(row0 + w * 8 - 3 + j) * NH + h * 128 + 2 * lane;
#pragma unroll
        for (int grp = 0; grp < 3; ++grp) xr[j][grp] = (t >= 0) ? *(const unsigned*)(pr + grp * 512) : 0u; }
#pragma unroll
    for (int tt = 0; tt < 8; ++tt) {
        const int i = w * 8 + tt;
        float a[3][2] = {{0.f, 0.f}, {0.f, 0.f}, {0.f, 0.f}};
#pragma unroll
        for (int tap = 0; tap < 4; ++tap)
#pragma unroll
            for (int grp = 0; grp < 3; ++grp) { const unsigned u = xr[tt + tap][grp]; a[grp][0] += cw[grp][tap][0] * bflo(u); a[grp][1] += cw[grp][tap][1] * bfhi(u); }
#pragma unroll
        for (int grp = 0; grp < 3; ++grp) { a[grp][0] = siluf(a[grp][0]); a[grp][1] = siluf(a[grp][1]); }
        const float sq = wsum(a[0][0] * a[0][0] + a[0][1] * a[0][1]), sk = wsum(a[1][0] * a[1][0] + a[1][1] * a[1][1]);
        const float rq = rsqrtf(sq + 1e-6f) * 0.08838834764831845f, rk = rsqrtf(sk + 1e-6f);
        const float q0 = a[0][0] * rq, q1 = a[0][1] * rq, k0 = a[1][0] * rk, k1 = a[1][1] * rk, v0 = a[2][0], v1 = a[2][1];
        const float gc = scC[i], be = scB[i], eg = __expf(gc), ed = __expf(gend - gc);
        *(LAS unsigned*)(lds + P_QN + i * 272 + lane * 4) = pk(q0, q1);
        *(LAS unsigned*)(lds + P_KN + i * 272 + lane * 4) = pk(k0, k1);
        *(unsigned*)(blk + GB_QG + i * 272 + lane * 4) = pk(q0 * eg, q1 * eg);
        kbt[(2 * lane) * 72 + i] = f2bf(k0 * be * eg); kbt[(2 * lane + 1) * 72 + i] = f2bf(k1 * be * eg);
        kdt[(2 * lane) * 72 + i] = f2bf(k0 * ed); kdt[(2 * lane + 1) * 72 + i] = f2bf(k1 * ed);
        vbt[(2 * lane) * 72 + i] = f2bf(v0 * be); vbt[(2 * lane + 1) * 72 + i] = f2bf(v1 * be);
    }
    __syncthreads();
    LAS float* AM = (LAS float*)(lds + P_AM);
    for (int tix = w; tix < 16; tix += 8) { const int mi = tix >> 2, nj = tix & 3;
        f32x4 kk = {0.f, 0.f, 0.f, 0.f}, qk = {0.f, 0.f, 0.f, 0.f};
        if (nj <= mi) {
#pragma unroll
            for (int s = 0; s < 4; ++s) { const bf16x8 bk = lda_nat(lds + P_KN, 16 * nj + r, 272, 32 * s, q), ak = lda_nat(lds + P_KN, 16 * mi + r, 272, 32 * s, q), aq = lda_nat(lds + P_QN, 16 * mi + r, 272, 32 * s, q);
                kk = MFMA16(ak, bk, kk); qk = MFMA16(aq, bk, qk); } }
#pragma unroll
        for (int reg = 0; reg < 4; ++reg) { const int i = 16 * mi + 4 * q + reg, j = 16 * nj + r;
            const float dec = (j <= i) ? __expf(scC[i] - scC[j]) : 0.f;
            AM[j * 68 + i] = (j < i) ? scB[i] * kk[reg] * dec : 0.f;
            *(bf16_t*)(blk + GB_P + (i * 72 + j) * 2) = f2bf(qk[reg] * dec); }
    }
    __syncthreads();
    if (w == 0) {
        LAS bf16_t* TM = (LAS bf16_t*)(lds + P_TM);
        float t[64];
#pragma unroll
        for (int i = 0; i < 64; ++i) t[i] = (lane == i) ? 1.f : 0.f;
#pragma unroll
        for (int j = 0; j < 63; ++j) { const float tj = t[j];
#pragma unroll
            for (int i = j + 1; i < 64; ++i) t[i] -= AM[j * 68 + i] * tj; }
#pragma unroll
        for (int i = 0; i < 64; ++i) TM[i * 72 + lane] = f2bf(t[i]);
    } else {
        for (int idx = tid - 64; idx < 1152; idx += 448) *(u32x4*)(blk + GB_KDT + idx * 16) = *(const LAS u32x4*)(lds + P_KDT + idx * 16);
    }
    __syncthreads();
    for (int tix = w; tix < 64; tix += 8) {
        f32x4 acc = {0.f, 0.f, 0.f, 0.f};
        if (tix < 32) { const int mi = tix >> 3, nv = tix & 7;
#pragma unroll
            for (int s = 0; s < 2; ++s) acc = MFMA16(lda_nat(lds + P_TM, 16 * mi + r, 144, 32 * s, q), lda_nat(lds + P_VBT, 16 * nv + r, 144, 32 * s, q), acc);
            u32x2 o; o.x = pk(acc[0], acc[1]); o.y = pk(acc[2], acc[3]);
            *(u32x2*)(blk + GB_UT + ((16 * nv + r) * 72 + 16 * mi + 4 * q) * 2) = o;
        } else { const int t2 = tix - 32, mk = t2 >> 2, ni = t2 & 3;
#pragma unroll
            for (int s = 0; s < 2; ++s) acc = MFMA16(lda_nat(lds + P_KBT, 16 * mk + r, 144, 32 * s, q), lda_nat(lds + P_TM, 16 * ni + r, 144, 32 * s, q), acc);
            u32x2 o; o.x = pk(-acc[0], -acc[1]); o.y = pk(-acc[2], -acc[3]);
            *(u32x2*)(blk + GB_NW + ((16 * ni + r) * 136 + 16 * mk + 4 * q) * 2) = o; }
    }
    if (tid == 0) *(float*)(blk + GB_SC) = __expf(gend);
    __syncthreads();
}

constexpr int R_QR = 0, R_KR = 9216, R_KDT = 18432, R_VT = 27648;
DI void rot_sincos(float pos, int f, float& sn, float& cs) {
    const float inv = exp2f(-(float)f * (13.287712379549449f / 32.f));
    const float ang = pos * inv;
    double rev = (double)ang * 0.15915494309189535; rev -= __builtin_floor(rev);
    const float fr = (float)rev;
    sn = __builtin_amdgcn_sinf(fr); cs = __builtin_amdgcn_cosf(fr);
}
DI void ret_prep_unit(LAS unsigned char* lds, const bf16_t* PROJ, unsigned char* blk, int row0, int h, int tid) {
    asm volatile("" : "+v"(tid));
    const int lane = tid & 63, w = tid >> 6, r = lane & 15, q = lane >> 4;
    const float lg = __logf(1.f - exp2f(-5.f - (float)h));
    const int f = lane & 31, which = lane >> 5;
    LAS bf16_t* qr = (LAS bf16_t*)(lds + R_QR); LAS bf16_t* kr = (LAS bf16_t*)(lds + R_KR); LAS bf16_t* kdt = (LAS bf16_t*)(lds + R_KDT); LAS bf16_t* vt = (LAS bf16_t*)(lds + R_VT);
#pragma unroll
    for (int tt = 0; tt < 8; ++tt) {
        const int i = w * 8 + tt, t = (row0 & (SEQ - 1)) + i;
        const bf16_t* pr = PROJ + (size_t)(row0 + i) * NH;
        const int base = (which ? 2312 : 2056) + h * 64;
        const float x1 = bf2f(pr[base + f]), x2 = bf2f(pr[base + 32 + f]);
        float sn, cs; rot_sincos((float)t, f, sn, cs);
        float o1 = x1 * cs - x2 * sn, o2 = x2 * cs + x1 * sn;
        if (which == 0) {
            qr[i * 72 + f] = f2bf(o1); qr[i * 72 + 32 + f] = f2bf(o2);
            const float eg = __expf((float)(i + 1) * lg);
            *(bf16_t*)(blk + RB_QG + (i * 72 + f) * 2) = f2bf(o1 * eg); *(bf16_t*)(blk + RB_QG + (i * 72 + 32 + f) * 2) = f2bf(o2 * eg);
        } else {
            o1 *= 0.125f; o2 *= 0.125f;
            kr[i * 72 + f] = f2bf(o1); kr[i * 72 + 32 + f] = f2bf(o2);
            const float ed = __expf((float)(63 - i) * lg);
            kdt[f * 72 + i] = f2bf(o1 * ed); kdt[(32 + f) * 72 + i] = f2bf(o2 * ed);
        }
        const unsigned u = *(const unsigned*)(pr + 2568 + h * 128 + 2 * lane);
        vt[(2 * lane) * 72 + i] = (bf16_t)(u & 0xffffu); vt[(2 * lane + 1) * 72 + i] = (bf16_t)(u >> 16);
    }
    __syncthreads();
    for (int tix = w; tix < 16; tix += 8) { const int mi = tix >> 2, nj = tix & 3;
        f32x4 qk = {0.f, 0.f, 0.f, 0.f};
        if (nj <= mi) {
#pragma unroll
            for (int s = 0; s < 2; ++s) qk = MFMA16(lda_nat(lds + R_QR, 16 * mi + r, 144, 32 * s, q), lda_nat(lds + R_KR, 16 * nj + r, 144, 32 * s, q), qk); }
#pragma unroll
        for (int reg = 0; reg < 4; ++reg) { const int i = 16 * mi + 4 * q + reg, j = 16 * nj + r;
            const float dec = (j <= i) ? __expf((float)(i - j) * lg) : 0.f;
            *(bf16_t*)(blk + RB_P + (i * 72 + j) * 2) = f2bf(qk[reg] * dec); }
    }
    for (int idx = tid; idx < 1728; idx += 512) *(u32x4*)(blk + RB_KDT + idx * 16) = *(const LAS u32x4*)(lds + R_KDT + idx * 16);
    if (tid == 0) *(float*)(blk + RB_SC) = __expf(64.f * lg);
    __syncthreads();
}

constexpr int Q_CM = 0, Q_BM = 17408, Q_BT = 34816, Q_XT = 53248, Q_END = 53248 + 73728;
DI void ssd_prep_unit(LAS unsigned char* lds, const bf16_t* PROJ, const float* convw  , const float* convb, const float* dtb, const float* alog, const float* dsk,
                      unsigned char* gblk, unsigned char* hblk0  , int row0, int g, int tid) {
    asm volatile("" : "+v"(tid));
    const int lane = tid & 63, w = tid >> 6, r = lane & 15, q = lane >> 4;
    int ch[6];
#pragma unroll
    for (int j = 0; j < 4; ++j) ch[j] = g * 512 + 128 * j + 2 * lane;
    ch[4] = 2048 + g * 128 + 2 * lane; ch[5] = 2560 + g * 128 + 2 * lane;
    float cw[6][5][2];
#pragma unroll
    for (int j = 0; j < 6; ++j) {
#pragma unroll
        for (int tap = 0; tap < 4; ++tap) { const f32x2 t = *(const f32x2*)(convw + tap * 3072 + ch[j]); cw[j][tap][0] = t[0]; cw[j][tap][1] = t[1]; }
        const f32x2 t = *(const f32x2*)(convb + ch[j]); cw[j][4][0] = t[0]; cw[j][4][1] = t[1]; }
    LAS bf16_t* bt = (LAS bf16_t*)(lds + Q_BT); LAS bf16_t* xt = (LAS bf16_t*)(lds + Q_XT);
    if (w == 0) {
        const bf16_t* pr = PROJ + (size_t)(row0 + lane) * NS + 5120 + g * 8;
#pragma unroll
        for (int hh = 0; hh < 8; ++hh) { const int head = g * 8 + hh;
            const float dt = softplusf(bf2f(pr[hh]) + dtb[head]); const float gg = -__expf(alog[head]) * dt;
            float c = gg;
#pragma unroll
            for (int o = 1; o < 64; o <<= 1) { const float t = __shfl_up(c, o); if (lane >= o) c += t; }
            const float gend = __shfl(c, 63);
            float* sc = (float*)(hblk0 + (size_t)(hh >> 1) * 32 * 2 * SH_SIZE + (hh & 1) * SH_SIZE + SH_SC);
            sc[lane] = dt * __expf(gend - c); sc[64 + lane] = __expf(c);
            LAS float* ls = (LAS float*)(lds + Q_END) + hh * 128; ls[lane] = dt; ls[64 + lane] = c; }
    }
    unsigned xr[11][6];
#pragma unroll
    for (int jr = 0; jr < 11; ++jr) { const int t = (row0 & (SEQ - 1)) + w * 8 - 3 + jr; const bf16_t* pr = PROJ + (size_t)(row0 + w * 8 - 3 + jr) * NS + 2048;
#pragma unroll
        for (int j = 0; j < 6; ++j) xr[jr][j] = (t >= 0) ? *(const unsigned*)(pr + ch[j]) : 0u; }
#pragma unroll
    for (int tt = 0; tt < 8; ++tt) {
        const int i = w * 8 + tt;
        float a[6][2];
#pragma unroll
        for (int j = 0; j < 6; ++j) { a[j][0] = cw[j][4][0]; a[j][1] = cw[j][4][1]; }
#pragma unroll
        for (int tap = 0; tap < 4; ++tap)
#pragma unroll
            for (int j = 0; j < 6; ++j) { const unsigned u = xr[tt + tap][j]; a[j][0] += cw[j][tap][0] * bflo(u); a[j][1] += cw[j][tap][1] * bfhi(u); }
#pragma unroll
        for (int j = 0; j < 6; ++j) { a[j][0] = siluf(a[j][0]); a[j][1] = siluf(a[j][1]); }
#pragma unroll
        for (int j = 0; j < 4; ++j) { xt[(128 * j + 2 * lane) * 72 + i] = f2bf(a[j][0]); xt[(128 * j + 2 * lane + 1) * 72 + i] = f2bf(a[j][1]); }
        *(LAS unsigned*)(lds + Q_BM + i * 272 + lane * 4) = pk(a[4][0], a[4][1]);
        bt[(2 * lane) * 72 + i] = f2bf(a[4][0]); bt[(2 * lane + 1) * 72 + i] = f2bf(a[4][1]);
        const unsigned cu = pk(a[5][0], a[5][1]);
        *(LAS unsigned*)(lds + Q_CM + i * 272 + lane * 4) = cu;
        *(unsigned*)(gblk + SG_CM + i * 272 + lane * 4) = cu;
    }
    __syncthreads();
    for (int tix = w; tix < 16; tix += 8) { const int mi = tix >> 2, nj = tix & 3;
        f32x4 cb = {0.f, 0.f, 0.f, 0.f};
        if (nj <= mi) {
#pragma unroll
            for (int s = 0; s < 4; ++s) cb = MFMA16(lda_nat(lds + Q_CM, 16 * mi + r, 272, 32 * s, q), lda_nat(lds + Q_BM, 16 * nj + r, 272, 32 * s, q), cb); }
#pragma unroll
        for (int hh = 0; hh < 8; ++hh) { const LAS float* ls = (const LAS float*)(lds + Q_END) + hh * 128; const float dj = ls[16 * nj + r], gj = ls[64 + 16 * nj + r], dk = dsk[g * 8 + hh];
            unsigned char* pb = hblk0 + (size_t)(hh >> 1) * 32 * 2 * SH_SIZE + (hh & 1) * SH_SIZE + SH_PP;
#pragma unroll
            for (int reg = 0; reg < 4; ++reg) { const int i = 16 * mi + 4 * q + reg, j = 16 * nj + r;
                float v = (j <= i) ? cb[reg] * __expf(ls[64 + i] - gj) * dj : 0.f; if (i == j) v += dk;
                *(bf16_t*)(pb + (i * 72 + j) * 2) = f2bf(v); } }
    }
    for (int idx = tid; idx < 1152; idx += 512) *(u32x4*)(gblk + SG_BT + idx * 16) = *(const LAS u32x4*)(lds + Q_BT + idx * 16);
    for (int idx = tid; idx < 4608; idx += 512) { const int hh = idx / 576, o = idx % 576;
        *(u32x4*)(hblk0 + (size_t)(hh >> 1) * 32 * 2 * SH_SIZE + (hh & 1) * SH_SIZE + SH_XT + o * 16) = *(const LAS u32x4*)(lds + Q_XT + idx * 16); }
    __syncthreads();
}
#define XB_T0(wid) ((wid) == 0 && __builtin_amdgcn_mbcnt_hi(~0u, __builtin_amdgcn_mbcnt_lo(~0u, 0u)) == 0u)
#define XB_TMO      128
#define XB_XCNT(j)  (256  + 64 * (j))
#define XB_XSUB(j)  (1280 + 64 * (j))
#define XB_XGEN(j)  (2304 + 64 * (j))
#define XB_TOP      3328
#define XB_TOPGEN   3392
#define XCD_BAR_WORDS 3456
#define XB_SPIN_CAP (1u << 18)

__device__ __forceinline__ unsigned xb_ld(unsigned* p)              { return __hip_atomic_load(p, __ATOMIC_RELAXED, __HIP_MEMORY_SCOPE_AGENT); }
__device__ __forceinline__ unsigned xb_add(unsigned* p, unsigned v) { return __hip_atomic_fetch_add(p, v, __ATOMIC_RELAXED, __HIP_MEMORY_SCOPE_AGENT); }
__device__ __forceinline__ unsigned xb_xcc_id() { return (unsigned)__builtin_amdgcn_s_getreg((3 << 11) | 20) & 0xFu; }
#define XB_SPIN(cond, bar) do { unsigned _sp = 0; while (cond) { __builtin_amdgcn_s_sleep(1); \
    if ((++_sp & 255u) == 0u) { if (xb_ld(&(bar)[XB_TMO])) break; if (_sp > XB_SPIN_CAP) { atomicAdd(&(bar)[XB_TMO], 1u); break; } } } } while (0)

struct XcdBarrier {
    unsigned* bar; unsigned x; int wid;
    volatile LAS unsigned* st;
};

__device__ __forceinline__ XcdBarrier xcd_barrier_post(unsigned* bar, volatile LAS unsigned* st, int wid) {
    XcdBarrier b; b.bar = bar; b.x = xb_xcc_id(); b.st = st; b.wid = wid;
    if (XB_T0(wid)) (void)xb_add(&bar[XB_XCNT(b.x)], 1u);
    return b;
}
__device__ __forceinline__ void xcd_barrier_complete(unsigned* bar, unsigned x, unsigned& nloc, unsigned& nx) {
    const unsigned G = gridDim.x * gridDim.y * gridDim.z;
    unsigned sum, cnt, mine, sp = 0u;
    for (;;) {
        sum = 0u; cnt = 0u; mine = 0u;
#pragma unroll
        for (unsigned j = 0; j < 16; ++j) { const unsigned c = xb_ld(&bar[XB_XCNT(j)]); sum += c; cnt += (c > 0u) ? 1u : 0u; mine = (j == x) ? c : mine; }
        if (sum == G) break;
        __builtin_amdgcn_s_sleep(1);
        if ((++sp & 255u) == 0u) { if (xb_ld(&bar[XB_TMO])) break; if (sp > XB_SPIN_CAP) { atomicAdd(&bar[XB_TMO], 1u); break; } }
    }
    nloc = mine > 0u ? mine : 1u; nx = cnt > 0u ? cnt : 1u;
}

__device__ __forceinline__ void xcd_barrier(const XcdBarrier& b) {
    asm volatile("s_waitcnt vmcnt(0)" ::: "memory");
    __syncthreads();
    if (XB_T0(b.wid)) {
        unsigned* bar = b.bar;
        __builtin_amdgcn_s_waitcnt(0);
        unsigned nloc = b.st[0], nx = b.st[1];
        if (nloc == 0u) { xcd_barrier_complete(bar, b.x, nloc, nx); b.st[0] = nloc; b.st[1] = nx; }
        const unsigned old = xb_add(&bar[XB_XSUB(b.x)], 1u);
        const unsigned gen = old / nloc;
        if (old + 1u == (gen + 1u) * nloc) {
            __builtin_amdgcn_fence(__ATOMIC_RELEASE, "agent");
            asm volatile("s_waitcnt vmcnt(0)" ::: "memory");
            const unsigned og = xb_add(&bar[XB_TOP], 1u);
            const unsigned tg = og / nx;
            if (og + 1u == (tg + 1u) * nx) xb_add(&bar[XB_TOPGEN], 1u);
            else XB_SPIN(xb_ld(&bar[XB_TOPGEN]) == tg, bar);
            __builtin_amdgcn_fence(__ATOMIC_ACQUIRE, "agent");
            xb_add(&bar[XB_XGEN(b.x)], 1u);
            asm volatile("s_waitcnt vmcnt(0)" ::: "memory");
        } else {
            XB_SPIN(xb_ld(&bar[XB_XGEN(b.x)]) == gen, bar);
            __builtin_amdgcn_fence(__ATOMIC_ACQUIRE, "agent");
            asm volatile("s_waitcnt vmcnt(0)" ::: "memory");
        }
    }
    __syncthreads();
}


#define PF_LOAD(pf, n, src, nvec) do { _Pragma("unroll") for (int _k = 0; _k < (n); ++_k) { const int _i = tid + _k * 512; if (_i < (nvec)) pf[_k] = ((const u32x4*)(src))[_i]; } } while (0)
#define PF_LOAD_NT(pf, n, src, nvec) do { _Pragma("unroll") for (int _k = 0; _k < (n); ++_k) { const int _i = tid + _k * 512; if (_i < (nvec)) pf[_k] = __builtin_nontemporal_load((const u32x4*)(src) + _i); } } while (0)
#define PF_STORE(pf, n, nvec) do { _Pragma("unroll") for (int _k = 0; _k < (n); ++_k) { const int _i = tid + _k * 512; if (_i < (nvec)) ((LAS u32x4*)lds)[_i] = pf[_k]; } } while (0)

constexpr int GL_UT = 62464, GL_SC = 67072, GL_SIZE = 67136, GL_NV = GL_SIZE / 16;
constexpr int GS_SF = 2 * GL_SIZE, GS_DF = GS_SF + 8192;
static_assert(GS_DF + 4096 <= LDS_BYTES - 32, "GDN scan LDS budget");
DI void gdn_scan(LAS unsigned char* lds, const unsigned char* blk0, bf16_t* YRAW, int row0, int h, float* sout, int tid, const int vs) {
    asm volatile("" : "+v"(tid));
    const int lane = tid & 63, w = tid >> 6, r = lane & 15, q = lane >> 4, ct = w & 1, rg = w >> 1, v0 = 32 * vs + 16 * ct;
    f32x4 S0 = (f32x4){0.f, 0.f, 0.f, 0.f}, S1 = S0;
    u32x4 pfA[9], pfB[9];
#define GDN_LOAD(pf, cc) do { const u32x4* _s = (const u32x4*)(blk0 + (size_t)(cc) * GB_SIZE); _Pragma("unroll") for (int _k = 0; _k < 9; ++_k) { const int _i = tid + _k * 512; \
        if (_i < GL_NV) pf[_k] = _s[_i < 3904 ? _i : (_i < 4192 ? _i + vs * 288 : _i + 864)]; } } while (0)
#define GDN_STORE(pf, boff) do { _Pragma("unroll") for (int _k = 0; _k < 9; ++_k) { const int _i = tid + _k * 512; if (_i < GL_NV) ((LAS u32x4*)(lds + (boff)))[_i] = pf[_k]; } } while (0)
    GDN_LOAD(pfA, 0);
    GDN_STORE(pfA, 0);
    GDN_LOAD(pfA, 1); GDN_LOAD(pfB, 2);
    LAS u32x4* SF = (LAS u32x4*)(lds + GS_SF) + ct * 4 * 64;
    LAS unsigned char* DF = lds + GS_DF + ct * 2 * 1024;
    SF[rg * 64 + lane] = (u32x4){0u, 0u, 0u, 0u};
    __syncthreads();
    auto step = [&](auto BC, const int c, u32x4 (&pf)[9]) __attribute__((always_inline)) {
        constexpr int BUFC = decltype(BC)::value ? GL_SIZE : 0, BUFN = GL_SIZE - BUFC;
        const LAS unsigned char* bc = lds + BUFC;
        const float e = *(const LAS float*)(bc + GL_SC);
        const u32x2 uu = *(const LAS u32x2*)(bc + GL_UT + ((16 * ct + r) * 72 + 16 * rg + 4 * q) * 2);
        f32x4 Dl = (f32x4){bflo(uu.x), bfhi(uu.x), bflo(uu.y), bfhi(uu.y)}, Y = (f32x4){0.f, 0.f, 0.f, 0.f};
#pragma unroll
        for (int s = 0; s < 4; ++s) { const bf16x8 bs = __builtin_bit_cast(bf16x8, SF[s * 64 + lane]);
            Dl = MFMA16(lda_perm(bc + GB_NW, 16 * rg + r, 272, 32 * s, q), bs, Dl); Y = MFMA16(lda_perm(bc + GB_QG, 16 * rg + r, 272, 32 * s, q), bs, Y); }
        { u32x2 dd; dd.x = pk(Dl[0], Dl[1]); dd.y = pk(Dl[2], Dl[3]); *(LAS u32x2*)(DF + (rg >> 1) * 1024 + lane * 16 + (rg & 1) * 8) = dd; }
        __syncthreads();
        if (c + 1 < 32) GDN_STORE(pf, BUFN);
        if (c + 3 < 32) GDN_LOAD(pf, c + 3);
        S0 = S0 * e; S1 = S1 * e;
#pragma unroll
        for (int s2 = 0; s2 < 2; ++s2) { const bf16x8 bd = *(const LAS bf16x8*)(DF + s2 * 1024 + lane * 16);
            Y = MFMA16(lda_perm(bc + GB_P, 16 * rg + r, 144, 32 * s2, q), bd, Y);
            S0 = MFMA16(lda_perm(bc + GB_KDT, 16 * (2 * rg) + r, 144, 32 * s2, q), bd, S0);
            S1 = MFMA16(lda_perm(bc + GB_KDT, 16 * (2 * rg + 1) + r, 144, 32 * s2, q), bd, S1); }
#pragma unroll
        for (int reg = 0; reg < 4; ++reg) YRAW[(size_t)(row0 + c * 64 + 16 * rg + 4 * q + reg) * 2048 + h * 128 + v0 + r] = f2bf(Y[reg]);
        SF[rg * 64 + lane] = __builtin_bit_cast(u32x4, pack2(S0, S1));
        __syncthreads();
    };
#pragma nounroll
    for (int c = 0; c < 32; c += 2) { step(std::integral_constant<int, 0>{}, c, pfA); step(std::integral_constant<int, 1>{}, c + 1, pfB); }
#pragma unroll
    for (int reg = 0; reg < 4; ++reg) { sout[(16 * (2 * rg) + 4 * q + reg) * 128 + v0 + r] = S0[reg]; sout[(16 * (2 * rg + 1) + 4 * q + reg) * 128 + v0 + r] = S1[reg]; }
#undef GDN_LOAD
#undef GDN_STORE
}

DI void ret_scan(LAS unsigned char* lds, const unsigned char* blk0, bf16_t* YRAW, int row0, int h, float* sout, int tid) {
    asm volatile("" : "+v"(tid));
    const int lane = tid & 63, w = tid >> 6, r = lane & 15, q = lane >> 4, v0 = 16 * w;
    constexpr int RL = 46208;
    f32x4 S[4];
#pragma unroll
    for (int k = 0; k < 4; ++k) S[k] = (f32x4){0.f, 0.f, 0.f, 0.f};
    u32x4 pfA[6], pfB[6];
#define RET_STORE(pf, boff) do { _Pragma("unroll") for (int _k = 0; _k < 6; ++_k) { const int _i = tid + _k * 512; if (_i < RB_SIZE / 16) ((LAS u32x4*)(lds + (boff)))[_i] = pf[_k]; } } while (0)
    PF_LOAD_NT(pfA, 6, blk0, RB_SIZE / 16);
    RET_STORE(pfA, 0);
    PF_LOAD_NT(pfA, 6, blk0 + RB_SIZE, RB_SIZE / 16);
    PF_LOAD_NT(pfB, 6, blk0 + 2 * (size_t)RB_SIZE, RB_SIZE / 16);
    __syncthreads();
    auto step = [&](auto BC, const int c, u32x4 (&pf)[6]) __attribute__((always_inline)) {
        constexpr int BUFC = decltype(BC)::value ? RL : 0, BUFN = RL - BUFC;
        const LAS unsigned char* bc = lds + BUFC;
        if (c + 1 < 32) RET_STORE(pf, BUFN);
        if (c + 3 < 32) PF_LOAD_NT(pf, 6, blk0 + (size_t)(c + 3) * RB_SIZE, RB_SIZE / 16);
        const float e = *(const LAS float*)(bc + RB_SC);
        f32x4 Y[4];
#pragma unroll
        for (int m = 0; m < 4; ++m) Y[m] = (f32x4){0.f, 0.f, 0.f, 0.f};
#pragma unroll
        for (int s = 0; s < 2; ++s) { const bf16x8 bs = pack2(S[2 * s], S[2 * s + 1]);
#pragma unroll
            for (int m = 0; m < 4; ++m) Y[m] = MFMA16(lda_perm(bc + RB_QG, 16 * m + r, 144, 32 * s, q), bs, Y[m]); }
#pragma unroll
        for (int k = 0; k < 4; ++k) S[k] = S[k] * e;
#pragma unroll
        for (int s2 = 0; s2 < 2; ++s2) { const bf16x8 bv = lda_nat(bc + RB_VT, v0 + r, 144, 32 * s2, q);
#pragma unroll
            for (int m = 0; m < 4; ++m) Y[m] = MFMA16(lda_nat(bc + RB_P, 16 * m + r, 144, 32 * s2, q), bv, Y[m]);
#pragma unroll
            for (int k = 0; k < 4; ++k) S[k] = MFMA16(lda_nat(bc + RB_KDT, 16 * k + r, 144, 32 * s2, q), bv, S[k]); }
#pragma unroll
        for (int m = 0; m < 4; ++m)
#pragma unroll
            for (int reg = 0; reg < 4; ++reg) YRAW[(size_t)(row0 + c * 64 + 16 * m + 4 * q + reg) * 2048 + 512 + h * 128 + v0 + r] = f2bf(Y[m][reg]);
        __syncthreads();
    };
#pragma nounroll
    for (int c = 0; c < 32; c += 2) { step(std::integral_constant<int, 0>{}, c, pfA); step(std::integral_constant<int, 1>{}, c + 1, pfB); }
#pragma unroll
    for (int k = 0; k < 4; ++k)
#pragma unroll
        for (int reg = 0; reg < 4; ++reg) sout[(16 * k + 4 * q + reg) * 128 + v0 + r] = S[k][reg];
#undef RET_STORE
}

constexpr int SL_SIZE = SG_SIZE + SH_SIZE, SS_SF = 2 * SL_SIZE;
static_assert(SS_SF + 32768 <= LDS_BYTES - 32, "SSD scan LDS budget");
DI void ssd_scan(LAS unsigned char* lds, const unsigned char* gblk0, const unsigned char* hblk0, bf16_t* YRAW, int row0, int head, float* so, int tid) {
    asm volatile("" : "+v"(tid));
    const int lane = tid & 63, w = tid >> 6, r = lane & 15, q = lane >> 4, ct = w & 3, rh = w >> 2, p0 = 16 * ct;
    f32x4 S[4];
#pragma unroll
    for (int k = 0; k < 4; ++k) S[k] = (f32x4){0.f, 0.f, 0.f, 0.f};
    u32x4 pfA[7], pfB[7];
    constexpr int NG = SG_SIZE / 16, NV = NG + SH_SIZE / 16; static_assert(NV <= 7 * 512, "ssd staging");
#define SSD_LOAD(pf, cc) do { _Pragma("unroll") for (int _k = 0; _k < 7; ++_k) { const int _i = tid + _k * 512; if (_i < NG) pf[_k] = ((const u32x4*)(gblk0 + (size_t)(cc) * SG_SIZE))[_i]; \
        else if (_i < NV) pf[_k] = __builtin_nontemporal_load((const u32x4*)(hblk0 + (size_t)(cc) * 2 * SH_SIZE) + (_i - NG)); } } while (0)
#define SSD_STORE(pf, boff) do { _Pragma("unroll") for (int _k = 0; _k < 7; ++_k) { const int _i = tid + _k * 512; if (_i < NV) ((LAS u32x4*)(lds + (boff)))[_i] = pf[_k]; } } while (0)
    SSD_LOAD(pfA, 0);
    SSD_STORE(pfA, 0);
    SSD_LOAD(pfA, 1); SSD_LOAD(pfB, 2);
    LAS u32x4* SF = (LAS u32x4*)(lds + SS_SF) + ct * 4 * 64;
    SF[(2 * rh) * 64 + lane] = (u32x4){0u, 0u, 0u, 0u}; SF[(2 * rh + 1) * 64 + lane] = (u32x4){0u, 0u, 0u, 0u};
    __syncthreads();
    auto step = [&](auto BC, const int c, u32x4 (&pf)[7]) __attribute__((always_inline)) {
        constexpr int PAR = decltype(BC)::value, BUFC = PAR ? SL_SIZE : 0, BUFN = SL_SIZE - BUFC;
        const LAS unsigned char* bc = lds + BUFC;
        const LAS unsigned char* hd = bc + SG_SIZE;
        const LAS unsigned char* pp = hd + SH_PP;
        const LAS float* sx = (const LAS float*)(hd + SH_SC);
        LAS u32x4* SFc = SF + PAR * 1024; LAS u32x4* SFn = SF + (1 - PAR) * 1024;
        if (c + 1 < 32) SSD_STORE(pf, BUFN);
        if (c + 3 < 32) SSD_LOAD(pf, c + 3);
        const float e = sx[64 + 63];
        f32x4 Y[2];
#pragma unroll
        for (int mm = 0; mm < 2; ++mm) Y[mm] = (f32x4){0.f, 0.f, 0.f, 0.f};
#pragma unroll
        for (int s = 0; s < 4; ++s) { const bf16x8 bs = __builtin_bit_cast(bf16x8, SFc[s * 64 + lane]);
#pragma unroll
            for (int mm = 0; mm < 2; ++mm) Y[mm] = MFMA16(lda_perm(bc + SG_CM, 16 * (2 * rh + mm) + r, 272, 32 * s, q), bs, Y[mm]); }
#pragma unroll
        for (int mm = 0; mm < 2; ++mm)
#pragma unroll
            for (int reg = 0; reg < 4; ++reg) Y[mm][reg] *= sx[64 + 16 * (2 * rh + mm) + 4 * q + reg];
#pragma unroll
        for (int k = 0; k < 4; ++k) S[k] = S[k] * e;
#pragma unroll
        for (int s2 = 0; s2 < 2; ++s2) { const bf16x8 bx = lda_nat(hd + SH_XT, p0 + r, 144, 32 * s2, q);
#pragma unroll
            for (int mm = 0; mm < 2; ++mm) Y[mm] = MFMA16(lda_nat(pp, 16 * (2 * rh + mm) + r, 144, 32 * s2, q), bx, Y[mm]);
            const u32x4 xu = __builtin_bit_cast(u32x4, bx); u32x4 xs;
            const LAS float* wj = sx + 32 * s2 + 8 * q;
            xs.x = pk(bflo(xu.x) * wj[0], bfhi(xu.x) * wj[1]); xs.y = pk(bflo(xu.y) * wj[2], bfhi(xu.y) * wj[3]);
            xs.z = pk(bflo(xu.z) * wj[4], bfhi(xu.z) * wj[5]); xs.w = pk(bflo(xu.w) * wj[6], bfhi(xu.w) * wj[7]);
            const bf16x8 bx2 = __builtin_bit_cast(bf16x8, xs);
#pragma unroll
            for (int k = 0; k < 4; ++k) S[k] = MFMA16(lda_nat(bc + SG_BT, 16 * (4 * rh + k) + r, 144, 32 * s2, q), bx2, S[k]); }
#pragma unroll
        for (int mm = 0; mm < 2; ++mm)
#pragma unroll
            for (int reg = 0; reg < 4; ++reg) YRAW[(size_t)(row0 + c * 64 + 16 * (2 * rh + mm) + 4 * q + reg) * 2048 + head * 64 + p0 + r] = f2bf(Y[mm][reg]);
        SFn[(2 * rh) * 64 + lane] = __builtin_bit_cast(u32x4, pack2(S[0], S[1])); SFn[(2 * rh + 1) * 64 + lane] = __builtin_bit_cast(u32x4, pack2(S[2], S[3]));
        __syncthreads();
    };
#pragma nounroll
    for (int c = 0; c < 32; c += 2) { step(std::integral_constant<int, 0>{}, c, pfA); step(std::integral_constant<int, 1>{}, c + 1, pfB); }
#pragma unroll
    for (int k = 0; k < 4; ++k)
#pragma unroll
        for (int reg = 0; reg < 4; ++reg) so[(16 * (4 * rh + k) + 4 * q + reg) * 64 + p0 + r] = S[k][reg];
#undef SSD_LOAD
#undef SSD_STORE
}

constexpr int XB_STEAL = 3520;
DI int steal_unit(unsigned* ctr, LAS unsigned char* lds, int tid) {
    __syncthreads();
    if (tid == 0) *(LAS int*)(lds + LDS_BYTES - 32) = (int)__hip_atomic_fetch_add(ctr, 1u, __ATOMIC_RELAXED, __HIP_MEMORY_SCOPE_AGENT);
    __syncthreads();
    return *(const LAS int*)(lds + LDS_BYTES - 32);
}
DI void gdn_sample_unit(LAS unsigned char* lds, const Params& p, int li, int s, int h, int tid) {
    asm volatile("" : "+v"(tid));
    const int lane = tid & 63, w = tid >> 6, row = TP + s;
    const bf16_t* pr = (const bf16_t*)(p.ws + WS_PROJ) + (size_t)row * NH;
    LAS float* qkv = (LAS float*)lds; LAS float* red = qkv + 384;
    const float* cbuf = p.in[3] + (size_t)(li * 128 + s) * 3 * 1536; float* cout = p.out + O_SGC + (size_t)(li * 128 + s) * 3 * 1536;
    const float* cwp = p.in[11] + (size_t)li * 4 * 1536;
    if (tid < 384) { const int grp = tid >> 7, cl = tid & 127, ch = grp * 512 + h * 128 + cl;
        const float x = bf2f(pr[ch]), b0 = cbuf[ch], b1 = cbuf[1536 + ch], b2 = cbuf[3072 + ch];
        const float o = b0 * cwp[ch] + b1 * cwp[1536 + ch] + b2 * cwp[3072 + ch] + x * cwp[4608 + ch];
        qkv[tid] = siluf(o); cout[ch] = b1; cout[1536 + ch] = b2; cout[3072 + ch] = x; }
    __syncthreads();
    const float qa = qkv[2 * lane], qb = qkv[2 * lane + 1], ka = qkv[128 + 2 * lane], kb = qkv[128 + 2 * lane + 1];
    const float rq = rsqrtf(wsum(qa * qa + qb * qb) + 1e-6f) * 0.08838834764831845f, rk = rsqrtf(wsum(ka * ka + kb * kb) + 1e-6f);
    const float beta = 1.f / (1.f + __expf(-bf2f(pr[2048 + h])));
    const float g = -__expf(p.in[12][li * 4 + h]) * softplusf(bf2f(pr[2052 + h]) + p.in[13][li * 4 + h]);
    const float e = __expf(g);
    const size_t sidx = ((size_t)(li * 128 + s) * 4 + h) * 128 * 128;
    const float* Sin = p.in[2] + sidx; float* Sout = p.out + O_SGDN + sidx;
    f32x2 Sr[16]; float a0 = 0.f, a1 = 0.f;
#pragma unroll
    for (int rr = 0; rr < 16; ++rr) { Sr[rr] = __builtin_nontemporal_load((const f32x2*)(Sin + (16 * w + rr) * 128 + 2 * lane)) * e; const float kn = qkv[128 + 16 * w + rr] * rk; a0 += kn * Sr[rr][0]; a1 += kn * Sr[rr][1]; }
    red[w * 128 + 2 * lane] = a0; red[w * 128 + 2 * lane + 1] = a1;
    __syncthreads();
    a0 = 0.f; a1 = 0.f;
#pragma unroll
    for (int ww = 0; ww < 8; ++ww) { a0 += red[ww * 128 + 2 * lane]; a1 += red[ww * 128 + 2 * lane + 1]; }
    const float d0 = beta * (qkv[256 + 2 * lane] - a0), d1 = beta * (qkv[256 + 2 * lane + 1] - a1);
    __syncthreads();
    float y0 = 0.f, y1 = 0.f;
#pragma unroll
    for (int rr = 0; rr < 16; ++rr) { const float kn = qkv[128 + 16 * w + rr] * rk, qn = qkv[16 * w + rr] * rq;
        Sr[rr][0] += kn * d0; Sr[rr][1] += kn * d1; y0 += qn * Sr[rr][0]; y1 += qn * Sr[rr][1];
        __builtin_nontemporal_store(Sr[rr], (f32x2*)(Sout + (16 * w + rr) * 128 + 2 * lane)); }
    red[w * 128 + 2 * lane] = y0; red[w * 128 + 2 * lane + 1] = y1;
    __syncthreads();
    if (w == 0) { y0 = 0.f; y1 = 0.f;
#pragma unroll
        for (int ww = 0; ww < 8; ++ww) { y0 += red[ww * 128 + 2 * lane]; y1 += red[ww * 128 + 2 * lane + 1]; }
        *(unsigned*)((bf16_t*)(p.ws + WS_YRAW) + (size_t)row * 2048 + h * 128 + 2 * lane) = pk(y0, y1); }
    __syncthreads();
}
DI void ret_sample_unit(LAS unsigned char* lds, const Params& p, int li, int s, int h, int tid) {
    asm volatile("" : "+v"(tid));
    const int lane = tid & 63, w = tid >> 6, row = TP + s;
    const bf16_t* pr = (const bf16_t*)(p.ws + WS_PROJ) + (size_t)row * NH;
    LAS float* qk = (LAS float*)lds; LAS float* red = qk + 128;
    if (tid < 64) { const int f = tid & 31, which = tid >> 5, base = (which ? 2312 : 2056) + h * 64;
        const float x1 = bf2f(pr[base + f]), x2 = bf2f(pr[base + 32 + f]);
        float sn, cs; rot_sincos(16384.f, f, sn, cs);
        float o1 = x1 * cs - x2 * sn, o2 = x2 * cs + x1 * sn;
        if (which) { o1 *= 0.125f; o2 *= 0.125f; }
        qk[which * 64 + f] = o1; qk[which * 64 + 32 + f] = o2; }
    __syncthreads();
    const float gam = 1.f - exp2f(-5.f - (float)h);
    const unsigned vu = *(const unsigned*)(pr + 2568 + h * 128 + 2 * lane);
    const float va = bflo(vu), vb = bfhi(vu);
    const size_t sidx = ((size_t)(li * 128 + s) * 4 + h) * 64 * 128;
    const float* Sin = p.in[4] + sidx; float* Sout = p.out + O_SRET + sidx;
    float y0 = 0.f, y1 = 0.f;
#pragma unroll
    for (int rr = 0; rr < 8; ++rr) { const int k = 8 * w + rr; f32x2 sv = __builtin_nontemporal_load((const f32x2*)(Sin + k * 128 + 2 * lane)) * gam; const float kk = qk[64 + k], qq = qk[k];
        sv[0] += kk * va; sv[1] += kk * vb; y0 += qq * sv[0]; y1 += qq * sv[1]; __builtin_nontemporal_store(sv, (f32x2*)(Sout + k * 128 + 2 * lane)); }
    red[w * 128 + 2 * lane] = y0; red[w * 128 + 2 * lane + 1] = y1;
    __syncthreads();
    if (w == 0) { y0 = 0.f; y1 = 0.f;
#pragma unroll
        for (int ww = 0; ww < 8; ++ww) { y0 += red[ww * 128 + 2 * lane]; y1 += red[ww * 128 + 2 * lane + 1]; }
        *(unsigned*)((bf16_t*)(p.ws + WS_YRAW) + (size_t)row * 2048 + 512 + h * 128 + 2 * lane) = pk(y0, y1); }
    __syncthreads();
}
DI void ssd_sample_unit(LAS unsigned char* lds, const Params& p, int li, int s, int g, int tid) {
    asm volatile("" : "+v"(tid));
    const int lane = tid & 63, w = tid >> 6, row = TP + s, pq = lane & 15, nq = lane >> 4;
    const bf16_t* pr = (const bf16_t*)(p.ws + WS_PROJ) + (size_t)row * NS;
    LAS float* xs = (LAS float*)lds; LAS float* Bv = xs + 512; LAS float* Cv = xs + 640;
    const float* cbuf = p.in[6] + (size_t)(li * 128 + s) * 3 * 3072; float* cout = p.out + O_SSC + (size_t)(li * 128 + s) * 3 * 3072;
    const float* cwp = p.in[18] + (size_t)li * 4 * 3072; const float* cbp = p.in[19] + (size_t)li * 3072;
    const int head = g * 8 + w;
    const size_t sidx = ((size_t)(li * 128 + s) * 32 + head) * 128 * 64;
    const f32x4* Sin4 = (const f32x4*)(p.in[5] + sidx); f32x4* Sout4 = (f32x4*)(p.out + O_SSSM + sidx);
    f32x4 sb[2][8];
#pragma unroll
    for (int j = 0; j < 8; ++j) sb[0][j] = __builtin_nontemporal_load(Sin4 + j * 64 + lane);
    {
        float xv_[2], b0_[2], b1_[2], b2_[2], w_[2][5]; int ch_[2];
#pragma unroll
        for (int it = 0; it < 2; ++it) { const int t = tid + it * 512; const bool ok = t < 768; const int tc = ok ? t : 0;
            const int ch = tc < 512 ? g * 512 + tc : (tc < 640 ? 2048 + g * 128 + (tc - 512) : 2560 + g * 128 + (tc - 640)); ch_[it] = ch;
            xv_[it] = bf2f(pr[2048 + ch]); b0_[it] = cbuf[ch]; b1_[it] = cbuf[3072 + ch]; b2_[it] = cbuf[6144 + ch];
            w_[it][0] = cwp[ch]; w_[it][1] = cwp[3072 + ch]; w_[it][2] = cwp[6144 + ch]; w_[it][3] = cwp[9216 + ch]; w_[it][4] = cbp[ch]; }
#pragma unroll
        for (int it = 0; it < 2; ++it) { const int t = tid + it * 512; if (t < 768) { const int ch = ch_[it];
            const float o = w_[it][4] + b0_[it] * w_[it][0] + b1_[it] * w_[it][1] + b2_[it] * w_[it][2] + xv_[it] * w_[it][3];
            xs[t] = siluf(o); cout[ch] = b1_[it]; cout[3072 + ch] = b2_[it]; cout[6144 + ch] = xv_[it]; } }
    }
    __syncthreads();
    const float dt = softplusf(bf2f(pr[5120 + head]) + p.in[20][li * 32 + head]);
    const float e = __expf(-__expf(p.in[21][li * 32 + head]) * dt);
    const f32x4 xv = *(const LAS f32x4*)(xs + w * 64 + 4 * pq), xd = xv * dt;
    f32x4 y = (f32x4){0.f, 0.f, 0.f, 0.f};
#pragma unroll
    for (int b = 0; b < 4; ++b) {
        if (b < 3) {
#pragma unroll
            for (int j = 0; j < 8; ++j) sb[(b + 1) & 1][j] = __builtin_nontemporal_load(Sin4 + ((b + 1) * 8 + j) * 64 + lane); }
#pragma unroll
        for (int j = 0; j < 8; ++j) { const int n = 4 * (b * 8 + j) + nq; const f32x4 v = sb[b & 1][j] * e + xd * Bv[n]; y = y + v * Cv[n]; __builtin_nontemporal_store(v, Sout4 + (b * 8 + j) * 64 + lane); }
    }
#pragma unroll
    for (int j = 0; j < 4; ++j) { y[j] += __shfl_xor(y[j], 16); y[j] += __shfl_xor(y[j], 32); }
    y = y + xv * p.in[22][li * 32 + head];
    if (nq == 0) { u32x2 o; o.x = pk(y[0], y[1]); o.y = pk(y[2], y[3]); *(u32x2*)((bf16_t*)(p.ws + WS_YRAW) + (size_t)row * 2048 + head * 64 + 4 * pq) = o; }
    __syncthreads();
}

DI void gate_hyb(const Params& p, int li, int gw, int ngw, int lane) {
    const bf16_t* YR = (const bf16_t*)(p.ws + WS_YRAW); const bf16_t* PROJ = (const bf16_t*)(p.ws + WS_PROJ); bf16_t* MIX = (bf16_t*)(p.ws + WS_MIX);
    const int cl = 8 * (lane & 15), h = lane >> 4;
    f32x4 ga[2], ra[2];
    ga[0] = *(const f32x4*)(p.in[14] + li * 128 + cl); ga[1] = *(const f32x4*)(p.in[14] + li * 128 + cl + 4);
    ra[0] = *(const f32x4*)(p.in[15] + li * 512 + h * 128 + cl); ra[1] = *(const f32x4*)(p.in[15] + li * 512 + h * 128 + cl + 4);
    for (int it0 = gw * 2; it0 < TR * 2; it0 += ngw * 2) {
        u32x4 ya[2], za[2];
#pragma unroll
        for (int rr = 0; rr < 2; ++rr) { const int it = it0 + rr, m = it >> 1, half = it & 1;
            ya[rr] = *(const u32x4*)(YR + (size_t)m * 2048 + half * 512 + h * 128 + cl);
            za[rr] = *(const u32x4*)(PROJ + (size_t)m * NH + (half ? 3080 : 1536) + h * 128 + cl); }
#pragma unroll
        for (int rr = 0; rr < 2; ++rr) { const int it = it0 + rr, m = it >> 1, half = it & 1;
            const unsigned yu[4] = {ya[rr].x, ya[rr].y, ya[rr].z, ya[rr].w}, zu[4] = {za[rr].x, za[rr].y, za[rr].z, za[rr].w};
            float v[8], z[8]; float s1 = 0.f;
#pragma unroll
            for (int j = 0; j < 4; ++j) { v[2 * j] = bflo(yu[j]); v[2 * j + 1] = bfhi(yu[j]); z[2 * j] = bflo(zu[j]); z[2 * j + 1] = bfhi(zu[j]); s1 += v[2 * j] + v[2 * j + 1]; }
            float mean = 0.f;
            if (half) { s1 += __shfl_xor(s1, 1); s1 += __shfl_xor(s1, 2); s1 += __shfl_xor(s1, 4); s1 += __shfl_xor(s1, 8); mean = s1 * (1.f / 128.f); }
            float ss = 0.f;
#pragma unroll
            for (int j = 0; j < 8; ++j) { v[j] -= mean; ss += v[j] * v[j]; }
            ss += __shfl_xor(ss, 1); ss += __shfl_xor(ss, 2); ss += __shfl_xor(ss, 4); ss += __shfl_xor(ss, 8);
            const float rs = rsqrtf(ss * (1.f / 128.f) + 1e-6f);
            float o[8];
#pragma unroll
            for (int j = 0; j < 8; ++j) { const float gn = half ? ra[j >> 2][j & 3] : ga[j >> 2][j & 3]; o[j] = v[j] * rs * gn * siluf(z[j]); }
            u32x4 w; w.x = pk(o[0], o[1]); w.y = pk(o[2], o[3]); w.z = pk(o[4], o[5]); w.w = pk(o[6], o[7]);
            *(u32x4*)(MIX + (size_t)m * 1024 + half * 512 + h * 128 + cl) = w; }
    }
    for (int idx = gw * 64 + lane; idx < 8 * 3 * 1536; idx += ngw * 64) { const int ch = idx % 1536, rr = (idx / 1536) % 3, b = idx / (3 * 1536);
        p.out[O_PGC + (size_t)(li * 8 + b) * 3 * 1536 + rr * 1536 + ch] = bf2f(PROJ[(size_t)(b * SEQ + SEQ - 3 + rr) * NH + ch]); }
}
DI void gate_ssm(const Params& p, int li, int gw, int ngw, int lane) {
    const bf16_t* YR = (const bf16_t*)(p.ws + WS_YRAW); const bf16_t* PROJ = (const bf16_t*)(p.ws + WS_PROJ); bf16_t* MIX = (bf16_t*)(p.ws + WS_MIX);
    const float* nw = p.in[23] + li * 2048;
    for (int m = gw; m < TR; m += ngw) {
        const bf16_t* yr = YR + (size_t)m * 2048; const bf16_t* pr = PROJ + (size_t)m * NS; bf16_t* mx = MIX + (size_t)m * 2048;
        u32x4 ua[4], za[4];
#pragma unroll
        for (int g = 0; g < 4; ++g) { ua[g] = *(const u32x4*)(yr + g * 512 + 8 * lane); za[g] = *(const u32x4*)(pr + g * 512 + 8 * lane); }
#pragma unroll
        for (int g = 0; g < 4; ++g) {
            const u32x4 u = ua[g], z = za[g];
            float v[8]; const unsigned uu[4] = {u.x, u.y, u.z, u.w}, zz[4] = {z.x, z.y, z.z, z.w}; float ss = 0.f;
#pragma unroll
            for (int j = 0; j < 4; ++j) { v[2 * j] = bflo(uu[j]) * siluf(bflo(zz[j])); v[2 * j + 1] = bfhi(uu[j]) * siluf(bfhi(zz[j])); ss += v[2 * j] * v[2 * j] + v[2 * j + 1] * v[2 * j + 1]; }
            const float rs = rsqrtf(wsum(ss) * (1.f / 512.f) + 1e-6f);
            const f32x4 w0 = *(const f32x4*)(nw + g * 512 + 8 * lane), w1 = *(const f32x4*)(nw + g * 512 + 8 * lane + 4);
            u32x4 o; o.x = pk(v[0] * rs * w0[0], v[1] * rs * w0[1]); o.y = pk(v[2] * rs * w0[2], v[3] * rs * w0[3]); o.z = pk(v[4] * rs * w1[0], v[5] * rs * w1[1]); o.w = pk(v[6] * rs * w1[2], v[7] * rs * w1[3]);
            *(u32x4*)(mx + g * 512 + 8 * lane) = o;
        }
    }
    for (int idx = gw * 64 + lane; idx < 8 * 3 * 3072; idx += ngw * 64) { const int ch = idx % 3072, rr = (idx / 3072) % 3, b = idx / (3 * 3072);
        p.out[O_PSC + (size_t)(li * 8 + b) * 3 * 3072 + rr * 3072 + ch] = bf2f(PROJ[(size_t)(b * SEQ + SEQ - 3 + rr) * NS + 2048 + ch]); }
}

struct EpiBR {
    static constexpr bool PERM = true, AFTER_DRAIN = false;
    bf16_t* O; int ldc; int act;
    DI void operator()(const f32x4 (&acc)[2][2][4][2], const pg8::Unit& u, int wr, int wc, int fr, int fq) const {
        const int row0 = u.pm * 256 + wr * 64 + fr, col0 = u.pn * 256 + wc * 32 + 8 * fq;
#pragma unroll
        for (int ai = 0; ai < 2; ++ai)
#pragma unroll
            for (int m = 0; m < 4; ++m) { bf16_t* rowp = O + (size_t)(row0 + ai * 128 + m * 16) * ldc + col0;
#pragma unroll
                for (int bj = 0; bj < 2; ++bj) { f32x4 v0 = acc[ai][bj][m][0], v1 = acc[ai][bj][m][1];
                    if (act) {
#pragma unroll
                        for (int j = 0; j < 4; ++j) { const float a = fmaxf(v0[j], 0.f), b = fmaxf(v1[j], 0.f); v0[j] = a * a; v1[j] = b * b; } }
                    u32x4 w; w.x = pk(v0[0], v0[1]); w.y = pk(v0[2], v0[3]); w.z = pk(v1[0], v1[1]); w.w = pk(v1[2], v1[3]);
                    *(u32x4*)(rowp + bj * 128) = w; } }
    }
};
template <int EPI> DI void skinny_tile(LAS unsigned char* lds, const bf16_t* A, const bf16_t* Bt, const int Kext, void* outp, const int ldc, int tid, const int lda = 0) {
    asm volatile("" : "+v"(tid));
    const int lane = tid & 63, w = tid >> 6, r = lane & 15, q = lane >> 4;
    const int K = lda ? lda : Kext;
    constexpr int kw = 128; (void)Kext;
    f32x4 acc[8];
#pragma unroll
    for (int m = 0; m < 8; ++m) acc[m] = (f32x4){0.f, 0.f, 0.f, 0.f};
    const bf16_t* ap = A + (size_t)r * K + w * kw + 8 * q; const bf16_t* bp = Bt + (size_t)r * K + w * kw + 8 * q;
#pragma unroll
    for (int k0 = 0; k0 < kw; k0 += 32) {
        const bf16x8 b = *(const bf16x8*)(bp + k0);
#pragma unroll
        for (int m = 0; m < 8; ++m) acc[m] = MFMA16(*(const bf16x8*)(ap + (size_t)(16 * m) * K + k0), b, acc[m]);
    }
    LAS float* part = (LAS float*)lds;
#pragma unroll
    for (int m = 0; m < 8; ++m)
#pragma unroll
        for (int reg = 0; reg < 4; ++reg) part[(w * 128 + 16 * m + 4 * q + reg) * 16 + r] = acc[m][reg];
    __syncthreads();
    const int row = tid >> 2, c4 = (tid & 3) * 4;
    f32x4 sum = (f32x4){0.f, 0.f, 0.f, 0.f};
#pragma unroll
    for (int ww = 0; ww < 8; ++ww) sum = sum + *(const LAS f32x4*)(part + (ww * 128 + row) * 16 + c4);
    if (EPI == 2) { f32x4* o = (f32x4*)((float*)outp + (size_t)row * ldc + c4); *o = *o + sum; }
    else if (EPI == 3) { float* o = (float*)outp + (size_t)row * ldc + c4;
#pragma unroll
        for (int j = 0; j < 4; ++j) (void)__hip_atomic_fetch_add(o + j, sum[j], __ATOMIC_RELAXED, __HIP_MEMORY_SCOPE_AGENT); }
    else { if (EPI == 1) {
#pragma unroll
            for (int j = 0; j < 4; ++j) { const float a = fmaxf(sum[j], 0.f); sum[j] = a * a; } }
        u32x2 o; o.x = pk(sum[0], sum[1]); o.y = pk(sum[2], sum[3]); *(u32x2*)((bf16_t*)outp + (size_t)row * ldc + c4) = o; }
    __syncthreads();
}

template <int KIND, bool hyb> DI void run_phase(const Params& P, LAS unsigned char* lds, const int L, const int tid, const int bid, const int G) {
    const int lane = tid & 63, wv = tid >> 6, gw = bid * 8 + wv, ngw = G * 8, li = L >> 1;
    unsigned char* ws = P.ws;
    bf16_t* H = (bf16_t*)(ws + WS_H); bf16_t* PROJ = (bf16_t*)(ws + WS_PROJ); bf16_t* YRAW = (bf16_t*)(ws + WS_YRAW); bf16_t* MIX = (bf16_t*)(ws + WS_MIX); bf16_t* ACT = (bf16_t*)(ws + WS_ACT);
    float* X = (float*)(ws + WS_X);
    if constexpr (KIND == 0) prologue(P, lds, gw, ngw, wv, lane);
    if constexpr (KIND == 1) norm_rows(P, P.in[7] + L * D, L == 0, gw, ngw, lane);
    if constexpr (KIND == 7) norm_rows(P, P.in[8] + L * D, false, gw, ngw, lane);
    if constexpr (KIND == 2 || KIND == 8) {
        constexpr bool up = KIND == 8;
        const bf16_t* Bt = up ? (const bf16_t*)(ws + WS_W1) + (size_t)L * FF * 1024 : (hyb ? (const bf16_t*)(ws + WS_WINH) + (size_t)li * NH * 1024 : (const bf16_t*)(ws + WS_WINS) + (size_t)li * NS * 1024);
        constexpr int N = up ? FF : (hyb ? NH : NS), NMAIN = up ? FF : (hyb ? NH : 5120);
        pg8::Gemm g{H, Bt, TP, NMAIN, 1024}; pg8::StaticOrder S; S.init(TP, NMAIN, G, bid); EpiB<up ? 1 : 0> E{up ? ACT : PROJ, N};
        pg8::gemm_phase<EpiB<up ? 1 : 0>, pg8::StaticOrder>((PG8_LAS unsigned char*)lds, g, S, E, nullptr, tid);
        constexpr int NCB = up ? FF / 16 : (hyb ? (NHR + 15) / 16 : NSR / 16);
        constexpr int NT = NCB + ((!up && !hyb) ? 256 : 0);
        const int nw = (!up && hyb) ? 64 : G;
        const int first = G - 1 - bid;
        if (first < nw) {
#pragma nounroll
            for (int t = first; t < NT; t += nw) {
                if (t < NCB) skinny_tile<up ? 1 : 0>(lds, H + (size_t)TP * 1024, Bt + (size_t)t * 16 * 1024, 1024, (up ? ACT : PROJ) + (size_t)TP * N + t * 16, N, tid);
                else { const int t2 = t - NCB, rb = t2 >> 1, cb = t2 & 1;
                    skinny_tile<0>(lds, H + (size_t)rb * 128 * 1024, Bt + (size_t)(5120 + cb * 16) * 1024, 1024, PROJ + (size_t)rb * 128 * N + 5120 + cb * 16, N, tid); }
            }
        }
    }
    if constexpr (KIND == 6 || KIND == 9) {
        constexpr bool dn = KIND == 9;
        const bf16_t* Bt = dn ? (const bf16_t*)(ws + WS_W2) + (size_t)L * 1024 * FF : (hyb ? (const bf16_t*)(ws + WS_WOUTH) + (size_t)li * 1024 * 1024 : (const bf16_t*)(ws + WS_WOUTS) + (size_t)li * 1024 * 2048);
        constexpr int K = dn ? FF : (hyb ? 1024 : 2048);
        pg8::Gemm g{dn ? ACT : MIX, Bt, TP, 1024, K}; pg8::StaticOrder S; S.init(TP, 1024, G, bid); EpiRes E{(bf16_t*)(ws + WS_X)};
        pg8::gemm_phase<EpiRes, pg8::StaticOrder>((PG8_LAS unsigned char*)lds, g, S, E, nullptr, tid);
        const int first = G - 1 - bid;
        constexpr int KS = K / 1024;
#pragma nounroll
        for (int t = first; t < 64 * KS; t += G) { const int ct = t / KS, ks = t % KS;
            skinny_tile<3>(lds, (dn ? ACT : MIX) + (size_t)TP * K + ks * 1024, Bt + (size_t)ct * 16 * K + ks * 1024, 1024, (float*)(ws + WS_XS) + ct * 16, 1024, tid, K); }
    }
    if constexpr (KIND == 3) {
        if constexpr (hyb) {
#pragma nounroll
            for (int u = bid; u < 1024; u += G) { const int b = u >> 7, c = (u >> 2) & 31, h = u & 3;
                gdn_prep_unit(lds, PROJ, P.in[11] + (size_t)li * 4 * 1536, P.in[12][li * 4 + h], P.in[13][li * 4 + h], ws + WS_CHK + CHK_GDN + (size_t)((b * 4 + h) * 32 + c) * GB_SIZE, b * SEQ + c * 64, h, tid); }
#ifdef PROBE_GDNPREP
#pragma nounroll
            for (int u = bid; u < 1024; u += G) { const int b = u >> 7, c = (u >> 2) & 31, h = u & 3;
                gdn_prep_unit(lds, PROJ, P.in[11] + (size_t)li * 4 * 1536, P.in[12][li * 4 + h], P.in[13][li * 4 + h], ws + WS_CHK + CHK_GDN + (size_t)((b * 4 + h) * 32 + c) * GB_SIZE, b * SEQ + c * 64, h, tid); }
#endif
#pragma nounroll
            for (int u2 = bid; u2 < 1024; u2 += G) { const int b = u2 >> 7, c = (u2 >> 2) & 31, h = u2 & 3;
                ret_prep_unit(lds, PROJ, ws + WS_CHK + CHK_RET + (size_t)((b * 4 + h) * 32 + c) * RB_SIZE, b * SEQ + c * 64, h, tid); }
        } else {
            for (int u = bid; u < 1024; u += G) { const int b = u >> 7, c = (u >> 2) & 31, g = u & 3;
                ssd_prep_unit(lds, PROJ, P.in[18] + (size_t)li * 4 * 3072, P.in[19] + (size_t)li * 3072, P.in[20] + li * 32, P.in[21] + li * 32, P.in[22] + li * 32,
                              ws + WS_CHK + CHK_SG + (size_t)((b * 4 + g) * 32 + c) * SG_SIZE, ws + WS_CHK + CHK_SH + (size_t)(((b * 16 + 4 * g) * 32 + c) * 2) * SH_SIZE, b * SEQ + c * 64, g, tid); }
        }
    }
    if constexpr (KIND == 4) {
        if constexpr (hyb) {
            if (bid < 128) { const int xq = bid & 7, jq = bid >> 3, bh = xq * 4 + (jq >> 2), b = bh >> 2, h = bh & 3;
                gdn_scan(lds, ws + WS_CHK + CHK_GDN + (size_t)((b * 4 + h) * 32) * GB_SIZE, YRAW, b * SEQ, h, P.out + O_PGDN + (size_t)((li * 8 + b) * 4 + h) * 128 * 128, tid, jq & 3); }
            else if (bid < 160) { const int b = (bid - 128) >> 2, h = bid & 3;
                ret_scan(lds, ws + WS_CHK + CHK_RET + (size_t)((b * 4 + h) * 32) * RB_SIZE, YRAW, b * SEQ, h, P.out + O_PRET + (size_t)((li * 8 + b) * 4 + h) * 64 * 128, tid); }
            for (;;) { const int u = steal_unit((unsigned*)(ws + WS_BAR) + XB_STEAL + 64 * L, lds, tid); if (u >= 1024) break;
                if (u < 512) gdn_sample_unit(lds, P, li, u >> 2, u & 3, tid); else ret_sample_unit(lds, P, li, (u - 512) >> 2, u & 3, tid); }
        } else {
#pragma nounroll
            for (int unit = bid; unit < 256; unit += G) { const int xq = unit & 7, jq = unit >> 3, grp = xq * 4 + (jq >> 3), b = grp >> 2, g = grp & 3, head = g * 8 + (jq & 7), u = head >> 1;
                ssd_scan(lds, ws + WS_CHK + CHK_SG + (size_t)((b * 4 + g) * 32) * SG_SIZE, ws + WS_CHK + CHK_SH + (size_t)(((b * 16 + u) * 32) * 2 + (head & 1)) * SH_SIZE, YRAW, b * SEQ, head,
                         P.out + O_PSSM + (size_t)((li * 8 + b) * 32 + head) * 128 * 64, tid); }
            for (;;) { const int u = steal_unit((unsigned*)(ws + WS_BAR) + XB_STEAL + 64 * L, lds, tid); if (u >= 512) break; ssd_sample_unit(lds, P, li, u >> 2, u & 3, tid); }
        }
    }
    if constexpr (KIND == 5) { if constexpr (hyb) gate_hyb(P, li, gw, ngw, lane); else gate_ssm(P, li, gw, ngw, lane); }
    if constexpr (KIND == 10) final_norm(P, gw, ngw, lane);
}
constexpr int LDS_ST = LDS_BYTES - 16;
template <int PH> DI void do_phase(const Params& p, cg::grid_group& grid, const int wid_s) {
    constexpr int kind = PH == 37 ? 10 : (PH == 0 ? 0 : 1 + (PH - 1) % 9), L = (PH == 0 || PH == 37) ? 0 : (PH - 1) / 9;
    constexpr bool hyb = (L & 1) == 0, hsel = (kind == 2 || kind == 3 || kind == 4 || kind == 5 || kind == 6) ? hyb : true;
    extern __shared__ __attribute__((aligned(16))) unsigned char smem[];
    int tid; asm volatile("v_mbcnt_lo_u32_b32 %0, -1, 0\n\tv_mbcnt_hi_u32_b32 %0, -1, %0" : "=v"(tid)); tid += wid_s * 64;
    unsigned lbase = 0; asm volatile("" : "+v"(lbase));
    LAS unsigned char* lds = (LAS unsigned char*)smem + lbase;
    int bid = blockIdx.x; asm volatile("" : "+s"(bid));
    int Gr = (int)gridDim.x; asm volatile("" : "+s"(Gr));
    run_phase<kind, hsel>(p, lds, L, tid, bid, Gr);
#ifdef PROBE_DUP
    if constexpr ((((PROBE_DUP) >> kind) & 1) && (PROBE_HYB == 2 || (PROBE_HYB == 1) == hyb)) { __syncthreads(); asm volatile("" : "+v"(tid)); run_phase<kind, hsel>(p, lds, L, tid, bid, Gr); }
#endif
    if (PH == 0) grid.sync();
    else if (PH < 37) { XcdBarrier b; b.bar = (unsigned*)(p.ws + WS_BAR); b.x = xb_xcc_id(); b.wid = wid_s; b.st = (volatile LAS unsigned*)((LAS unsigned char*)smem + LDS_ST); xcd_barrier(b); }
}
template <int... PH> DI void all_phases(const Params& p, cg::grid_group& grid, const int wid_s, std::integer_sequence<int, PH...>) { (do_phase<PH>(p, grid, wid_s), ...); }
__global__ void __launch_bounds__(512, 2) fwd_megakernel(Params p) {
    extern __shared__ __attribute__((aligned(16))) unsigned char smem[];
    cg::grid_group grid = cg::this_grid();
    const int wid_s = __builtin_amdgcn_readfirstlane(threadIdx.x >> 6);
    if (threadIdx.x == 0) { volatile LAS unsigned* st = (volatile LAS unsigned*)((LAS unsigned char*)smem + LDS_ST); st[0] = 0u; st[1] = 0u; }
    __syncthreads();
    (void)xcd_barrier_post((unsigned*)(p.ws + WS_BAR), (volatile LAS unsigned*)((LAS unsigned char*)smem + LDS_ST), wid_s);
    all_phases(p, grid, wid_s, std::make_integer_sequence<int, 38>{});
}

extern "C" void kernel_launch(void* const* d_in, const int* in_sizes, int n_in, void* d_out, int out_size, void* d_ws, size_t ws_size, hipStream_t stream) {
    static int grid = 0;
    if (grid == 0) {
        if (n_in != 27 || ws_size < WS_END) { fprintf(stderr, "kernel_launch: bad inputs n_in=%d ws=%zu need %zu\n", n_in, ws_size, (size_t)WS_END); grid = -1; return; }
        int dev = 0, cus = 0, per_cu = 0;
        (void)hipGetDevice(&dev); (void)hipDeviceGetAttribute(&cus, hipDeviceAttributeMultiprocessorCount, dev);
        if (hipFuncSetAttribute((const void*)fwd_megakernel, hipFuncAttributeMaxDynamicSharedMemorySize, LDS_BYTES) != hipSuccess) { fprintf(stderr, "kernel_launch: hipFuncSetAttribute failed\n"); grid = -1; return; }
        (void)hipOccupancyMaxActiveBlocksPerMultiprocessor(&per_cu, (const void*)fwd_megakernel, 512, LDS_BYTES);
        if (per_cu < 1) { fprintf(stderr, "kernel_launch: occupancy query says %d blocks/CU\n", per_cu); per_cu = 1; }
        (void)hipGetLastError();
        grid = cus;
        if (grid < 192) fprintf(stderr, "kernel_launch: only %d CUs\n", grid);
    }
    if (grid < 0) return;
    Params p{};
    for (int i = 0; i < 27; ++i) p.in[i] = (const float*)d_in[i];
    p.out = (float*)d_out; p.ws = (unsigned char*)d_ws; p.ph_lo = 0; p.ph_hi = 38;
    if (hipMemsetAsync((char*)d_ws + WS_BAR, 0, 16384, stream) != hipSuccess) { fprintf(stderr, "kernel_launch: memset failed\n"); return; }
    void* args[] = {&p};
    hipError_t e = hipLaunchCooperativeKernel((const void*)fwd_megakernel, dim3(grid), dim3(512), args, LDS_BYTES, stream);
    if (e != hipSuccess) fprintf(stderr, "cooperative launch failed: %s (grid %d)\n", hipGetErrorString(e), grid);
}
```

```cpp
#include <hip/hip_runtime.h>
#include <hip/hip_cooperative_groups.h>
#include <cstdio>
#include <utility>
namespace cg = cooperative_groups;
namespace pg8 {
#define PG8_LAS __attribute__((address_space(3)))
typedef unsigned short bf16_t;
typedef short bf16x8 __attribute__((ext_vector_type(8)));
typedef float f32x4 __attribute__((ext_vector_type(4)));
typedef unsigned u32x4 __attribute__((ext_vector_type(4)));
constexpr int BM = 256, BK = 64, HALF = 128, HTB = HALF * BK * 2  , STAGE_BYTES = 8 * HTB, NXCD = 8, WGM = 8;

__host__ __device__ __forceinline__ int lds_byte(int r, int c) { const int st = (r >> 4) * 2 + (c >> 5), rr = r & 15, cc = c & 31, ob = rr * 64 + cc * 2; return st * 1024 + (ob ^ (((ob >> 9) & 1) << 5)); }
__host__ __device__ __forceinline__ void stage_rc(int b, int& R, int& C) { const int st = b / 1024, sb = b % 1024, swz = sb ^ (((sb >> 9) & 1) << 5); R = (st >> 1) * 16 + swz / 64; C = (st & 1) * 32 + (swz % 64) / 2; }
__host__ __device__ __forceinline__ int perm32(int rho) { const int n = rho >> 4, i = rho & 15; return 8 * (i >> 2) + 4 * n + (i & 3); }

struct Unit { int pm, pn; };
struct Gemm { const bf16_t* A; const bf16_t* Bt; int M, N, K; };

struct StaticOrder {
    int nM, nN, nwg, G, c;
    __host__ __device__ void init(int M, int N, int G_, int c_) { nM = M / BM; nN = N / BM; nwg = nM * nN; G = G_; c = c_; }
    __host__ __device__ bool next(int i, Unit& u) const {
        const long L = (long)i * G + c; if (L >= nwg) return false;
        int wgid = (int)L; { const int q = nwg / NXCD, r = nwg % NXCD, xcd = wgid % NXCD, off = wgid / NXCD; wgid = (xcd < r ? xcd * (q + 1) : r * (q + 1) + (xcd - r) * q) + off; }
        const int nig = WGM * nN, gid = wgid / nig, fm = gid * WGM, gsz = (nM - fm) < WGM ? (nM - fm) : WGM;
        u.pm = fm + ((wgid % nig) % gsz); u.pn = (wgid % nig) / gsz; return true;
    }
    __device__ __forceinline__ void a_ready(const Unit&) const {}
    __device__ __forceinline__ void done(const Unit&) const {}
};
template <class Epi, class Sched, bool STAMP = false>
__device__ __forceinline__ void gemm_phase(PG8_LAS unsigned char* lds, const Gemm g, const Sched& S, const Epi& E, unsigned long long* stamps, const int tid_in) {
    const int tid = tid_in, wid = __builtin_amdgcn_readfirstlane(tid >> 6), lane = tid & 63, wr = wid >> 2, wc = wid & 3, fr = lane & 15, fq = lane >> 4;
    const int K = g.K, nt = K / BK;
    int ts_lo = 0, ts_hi = 0, nts = 0; const unsigned long long rt_entry = STAMP ? (unsigned long long)wall_clock64() : 0ull;
#define PG8_STAMP() do { if (STAMP && wid == 0 && nts < 64) { const unsigned long long _c = (unsigned long long)clock64(); \
        ts_lo = (lane == nts) ? (int)(unsigned)_c : ts_lo; ts_hi = (lane == nts) ? (int)(unsigned)(_c >> 32) : ts_hi; ++nts; } } while (0)
    PG8_STAMP();
    unsigned voffA[2], voffB[2];
#pragma unroll
    for (int i = 0; i < 2; ++i) { int R, C; stage_rc(tid * 16 + i * 8192, R, C); const int Rb = Epi::PERM ? ((R & ~31) + perm32(R & 31)) : R;
        voffA[i] = (unsigned)(R * K + C) * 2u; voffB[i] = (unsigned)(Rb * K + C) * 2u; }
    const size_t kstep = (size_t)(BK * 2);
    const size_t hstep = (size_t)HALF * K * 2;
    const size_t tstep = 2 * hstep;
    const unsigned ldsw = (unsigned)wid * 1024u;
    const int aoff = lds_byte(wr * 64 + fr, fq * 8), boff = lds_byte(wc * 32 + fr, fq * 8);
#define PG8_SA(b, h) (((b) * 2 + (h)) * HTB)
#define PG8_SB(b, h) ((4 + (b) * 2 + (h)) * HTB)
#define PG8_STAGE(bufoff, gbase, voff) do { _Pragma("unroll") for (int _i = 0; _i < 2; ++_i) \
        __builtin_amdgcn_global_load_lds((const unsigned*)((const char*)(gbase) + (voff)[_i]), (PG8_LAS unsigned*)(lds + (bufoff) + ldsw + _i * 8192), 16, 0, 0); } while (0)
#define PG8_LDA(dst, b, h) do { _Pragma("unroll") for (int m = 0; m < 4; ++m) _Pragma("unroll") for (int k = 0; k < 2; ++k) dst[m][k] = *(const PG8_LAS bf16x8*)(lds + PG8_SA(b, h) + aoff + m * 2048 + k * 1024); } while (0)
#define PG8_LDB(dst, b, h) do { _Pragma("unroll") for (int n = 0; n < 2; ++n) _Pragma("unroll") for (int k = 0; k < 2; ++k) dst[n][k] = *(const PG8_LAS bf16x8*)(lds + PG8_SB(b, h) + boff + n * 2048 + k * 1024); } while (0)
#define PG8_MMA(ai, bj, At, Bt) do { __builtin_amdgcn_s_setprio(1); _Pragma("unroll") for (int m = 0; m < 4; ++m) _Pragma("unroll") for (int n = 0; n < 2; ++n) _Pragma("unroll") for (int k = 0; k < 2; ++k) \
        acc[ai][bj][m][n] = __builtin_amdgcn_mfma_f32_16x16x32_bf16(Bt[n][k], At[m][k], acc[ai][bj][m][n], 0, 0, 0); __builtin_amdgcn_s_setprio(0); } while (0)
#define PG8_WAIT_V(n) asm volatile("s_waitcnt vmcnt(" #n ")" ::: "memory")
#define PG8_WAIT_L(n) asm volatile("s_waitcnt lgkmcnt(" #n ")" ::: "memory")
#define PG8_BAR __builtin_amdgcn_s_barrier()
#define PG8_SCHED __builtin_amdgcn_sched_barrier(0)
    Unit cur, nxt; int ui = 0;
    if (!S.next(0, cur)) return;
    f32x4 acc[2][2][4][2];
#pragma unroll
    for (int a = 0; a < 2; ++a)
#pragma unroll
        for (int b = 0; b < 2; ++b)
#pragma unroll
            for (int m = 0; m < 4; ++m)
#pragma unroll
                for (int n = 0; n < 2; ++n) acc[a][b][m][n] = (f32x4){0.f, 0.f, 0.f, 0.f};
    bf16x8 At[4][2], B0[2][2], B1[2][2];
    const char* cA = (const char*)g.A + (size_t)cur.pm * tstep; const char* cB = (const char*)g.Bt + (size_t)cur.pn * tstep;
    S.a_ready(cur);
    PG8_STAGE(PG8_SB(0, 0), cB, voffB); PG8_STAGE(PG8_SA(0, 0), cA, voffA); PG8_STAGE(PG8_SB(0, 1), cB + hstep, voffB); PG8_STAGE(PG8_SA(0, 1), cA + hstep, voffA);
    if (wr == 1) PG8_BAR;
    PG8_WAIT_V(4); PG8_BAR;
    PG8_STAGE(PG8_SB(1, 0), cB + kstep, voffB); PG8_STAGE(PG8_SA(1, 0), cA + kstep, voffA); PG8_STAGE(PG8_SB(1, 1), cB + hstep + kstep, voffB);
    PG8_WAIT_V(6); PG8_BAR;
    PG8_STAMP();
    for (;;) {
        const bool has_next = S.next(ui + 1, nxt);
        const char* nA = has_next ? (const char*)g.A + (size_t)nxt.pm * tstep : cA; const char* nB = has_next ? (const char*)g.Bt + (size_t)nxt.pn * tstep : cB;
        for (int t = 0; t < nt; t += 2) {
            const bool last = (t == nt - 2);
            const char* a1 = cA + (size_t)(t + 1) * kstep;
            const char* a2 = last ? nA : cA + (size_t)(t + 2) * kstep; const char* b2 = last ? nB : cB + (size_t)(t + 2) * kstep;
            const char* a3 = a2 + kstep; const char* b3 = b2 + kstep;
            if (last && has_next) S.a_ready(nxt);
            PG8_LDB(B0, 0, 0); PG8_SCHED; PG8_LDA(At, 0, 0); PG8_STAGE(PG8_SA(1, 1), a1 + hstep, voffA);
            PG8_WAIT_L(8); PG8_BAR; PG8_WAIT_L(0); PG8_MMA(0, 0, At, B0); PG8_BAR; PG8_SCHED;
            PG8_LDB(B1, 0, 1); PG8_STAGE(PG8_SB(0, 0), b2, voffB);
            PG8_BAR; PG8_WAIT_L(0); PG8_MMA(0, 1, At, B1); PG8_BAR;
            PG8_LDA(At, 0, 1); PG8_STAGE(PG8_SA(0, 0), a2, voffA);
            PG8_BAR; PG8_WAIT_L(0); PG8_MMA(1, 0, At, B0); PG8_BAR; PG8_SCHED;
            PG8_STAGE(PG8_SB(0, 1), b2 + hstep, voffB);
            PG8_WAIT_V(6); PG8_BAR; PG8_MMA(1, 1, At, B1); PG8_BAR;
            PG8_LDB(B0, 1, 0); PG8_SCHED; PG8_LDA(At, 1, 0); PG8_STAGE(PG8_SA(0, 1), a2 + hstep, voffA);
            PG8_WAIT_L(8); PG8_BAR; PG8_WAIT_L(0); PG8_MMA(0, 0, At, B0); PG8_BAR; PG8_SCHED;
            PG8_LDB(B1, 1, 1); PG8_STAGE(PG8_SB(1, 0), b3, voffB);
            PG8_BAR; PG8_WAIT_L(0); PG8_MMA(0, 1, At, B1); PG8_BAR;
            PG8_LDA(At, 1, 1); PG8_STAGE(PG8_SA(1, 0), a3, voffA);
            PG8_BAR; PG8_WAIT_L(0); PG8_MMA(1, 0, At, B0); PG8_BAR; PG8_SCHED;
            PG8_STAGE(PG8_SB(1, 1), b3 + hstep, voffB);
            PG8_WAIT_V(6); PG8_BAR; PG8_MMA(1, 1, At, B1); PG8_BAR;
        }
        PG8_STAMP();
        if constexpr (!Epi::AFTER_DRAIN) { E(acc, cur, wr, wc, fr, fq); S.done(cur); }
        PG8_STAMP();
        if (!has_next) break;
#pragma unroll
        for (int a = 0; a < 2; ++a)
#pragma unroll
            for (int b = 0; b < 2; ++b)
#pragma unroll
                for (int m = 0; m < 4; ++m)
#pragma unroll
                    for (int n = 0; n < 2; ++n) acc[a][b][m][n] = (f32x4){0.f, 0.f, 0.f, 0.f};
        cur = nxt; cA = nA; cB = nB; ++ui;
    }
    PG8_WAIT_V(0);
    if (wr == 0) PG8_BAR;
    PG8_BAR;
    if constexpr (Epi::AFTER_DRAIN) { E.fused(acc, cur, wr, wc, fr, fq, lds, wid, lane); S.done(cur); }
    PG8_STAMP();
    if (STAMP && wid == 0) { stamps[lane] = lane < nts ? (((unsigned long long)(unsigned)ts_hi << 32) | (unsigned)ts_lo) : 0ull;
        if (lane == 62) stamps[62] = rt_entry; if (lane == 63) stamps[63] = (unsigned long long)wall_clock64(); }
#undef PG8_STAMP
#undef PG8_SA
#undef PG8_SB
#undef PG8_STAGE
#undef PG8_LDA
#undef PG8_LDB
#undef PG8_MMA
#undef PG8_WAIT_V
#undef PG8_WAIT_L
#undef PG8_BAR
#undef PG8_SCHED
}
}

#define DI __device__ __forceinline__
#define LAS __attribute__((address_space(3)))
using pg8::bf16_t; using pg8::bf16x8; using pg8::f32x4; using pg8::u32x4;
typedef short s16x4 __attribute__((ext_vector_type(4)));
typedef unsigned u32x2 __attribute__((ext_vector_type(2)));
typedef float f32x2 __attribute__((ext_vector_type(2)));
typedef __bf16 bfv2 __attribute__((ext_vector_type(2)));

constexpr int D = 1024, TP = 16384, TS = 128, TR = TP + TS, MP = 16640, SEQ = 2048;
constexpr int NH = 3840, NHR = 3592, NS = 5376, NSR = 5152, FF = 4096;
constexpr int LDS_BYTES = 150 * 1024;
constexpr size_t O_YP = 0, O_YS = 16777216, O_PGDN = O_YS + 131072, O_PGC = O_PGDN + 1048576, O_PRET = O_PGC + 73728, O_PSSM = O_PRET + 524288,
                 O_PSC = O_PSSM + 4194304, O_SGDN = O_PSC + 147456, O_SGC = O_SGDN + 16777216, O_SRET = O_SGC + 1179648, O_SSSM = O_SRET + 8388608, O_SSC = O_SSSM + 67108864;
constexpr size_t WS_WINH = 0, WS_WOUTH = WS_WINH + 2ull * NH * 1024 * 2, WS_WINS = WS_WOUTH + 2ull * 1024 * 1024 * 2, WS_WOUTS = WS_WINS + 2ull * NS * 1024 * 2,
                 WS_W1 = WS_WOUTS + 2ull * 1024 * 2048 * 2, WS_W2 = WS_W1 + 4ull * 4096 * 1024 * 2, WS_X = WS_W2 + 4ull * 4096 * 1024 * 2, WS_H = WS_X + (size_t)MP * 1024 * 4,
                 WS_PROJ = WS_H + (size_t)MP * 1024 * 2, WS_YRAW = WS_PROJ + (size_t)MP * NS * 2, WS_MIX = WS_YRAW + (size_t)MP * 2048 * 2, WS_ACT = WS_MIX + (size_t)MP * 2048 * 2,
                 WS_CHK = WS_ACT + (size_t)MP * 4096 * 2;
constexpr int GB_NW = 0, GB_QG = 17408, GB_P = 34816, GB_KDT = 44032, GB_UT = 62464, GB_SC = 80896, GB_SIZE = 80960;
constexpr int RB_QG = 0, RB_P = 9216, RB_KDT = 18432, RB_VT = 27648, RB_SC = 46080, RB_SIZE = 46144;
constexpr int SG_CM = 0, SG_BT = 17408, SG_SIZE = 35840;
constexpr int SH_XT = 0, SH_PP = 9216, SH_SC = 18432, SH_SIZE = 19456;
constexpr size_t CHK_GDN = 0, CHK_RET = 1024ull * GB_SIZE, CHK_SG = 0, CHK_SH = 1024ull * SG_SIZE, CHK_END = 1024ull * GB_SIZE + 1024ull * RB_SIZE;
constexpr size_t WS_BAR = WS_CHK + (CHK_END > (1024ull * SG_SIZE + 8192ull * SH_SIZE) ? CHK_END : (1024ull * SG_SIZE + 8192ull * SH_SIZE));
constexpr size_t WS_END = WS_BAR + 16384;

struct Params { const float* in[27]; float* out; unsigned char* ws; int ph_lo, ph_hi; };

DI unsigned pk(float a, float b) { f32x2 v = {a, b}; bfv2 r = __builtin_convertvector(v, bfv2); return __builtin_bit_cast(unsigned, r); }
DI bf16_t f2bf(float a) { return (bf16_t)(pk(a, a) & 0xffffu); }
DI float bf2f(bf16_t b) { return __uint_as_float((unsigned)b << 16); }
DI float bflo(unsigned u) { return __uint_as_float(u << 16); }
DI float bfhi(unsigned u) { return __uint_as_float(u & 0xffff0000u); }
DI float wsum(float v) {
#pragma unroll
    for (int o = 32; o >= 1; o >>= 1) v += __shfl_xor(v, o);
    return v; }
DI float siluf(float x) { return x / (1.f + __expf(-x)); }
DI float softplusf(float x) { return fmaxf(x, 0.f) + log1pf(__expf(-fabsf(x))); }
DI bf16x8 lda_nat(const LAS unsigned char* base, int row, int strideB, int k0, int q) { return *(const LAS bf16x8*)(base + row * strideB + (k0 + 8 * q) * 2); }
DI bf16x8 lda_perm(const LAS unsigned char* base, int row, int strideB, int k0, int q) {
    const s16x4 lo = *(const LAS s16x4*)(base + row * strideB + (k0 + 4 * q) * 2);
    const s16x4 hi = *(const LAS s16x4*)(base + row * strideB + (k0 + 16 + 4 * q) * 2);
    return __builtin_shufflevector(lo, hi, 0, 1, 2, 3, 4, 5, 6, 7); }
DI bf16x8 pack2(f32x4 a, f32x4 b) { u32x4 p; p.x = pk(a[0], a[1]); p.y = pk(a[2], a[3]); p.z = pk(b[0], b[1]); p.w = pk(b[2], b[3]); return __builtin_bit_cast(bf16x8, p); }
#define MFMA16(a, b, c) __builtin_amdgcn_mfma_f32_16x16x32_bf16((a), (b), (c), 0, 0, 0)

template <int ACT> struct EpiB {
    static constexpr bool PERM = true, AFTER_DRAIN = false;
    bf16_t* O; int ldc;
    DI void operator()(const f32x4 (&acc)[2][2][4][2], const pg8::Unit& u, int wr, int wc, int fr, int fq) const {
        const int row0 = u.pm * 256 + wr * 64 + fr, col0 = u.pn * 256 + wc * 32 + 8 * fq;
#pragma unroll
        for (int ai = 0; ai < 2; ++ai)
#pragma unroll
            for (int m = 0; m < 4; ++m) { bf16_t* rowp = O + (size_t)(row0 + ai * 128 + m * 16) * ldc + col0;
#pragma unroll
                for (int bj = 0; bj < 2; ++bj) { f32x4 v0 = acc[ai][bj][m][0], v1 = acc[ai][bj][m][1];
                    if (ACT == 1) {
#pragma unroll
                        for (int j = 0; j < 4; ++j) { const float a = fmaxf(v0[j], 0.f), b = fmaxf(v1[j], 0.f); v0[j] = a * a; v1[j] = b * b; } }
                    u32x4 w; w.x = pk(v0[0], v0[1]); w.y = pk(v0[2], v0[3]); w.z = pk(v1[0], v1[1]); w.w = pk(v1[2], v1[3]);
                    *(u32x4*)(rowp + bj * 128) = w; } }
    }
};
struct EpiRes {
    static constexpr bool PERM = true, AFTER_DRAIN = false;
    bf16_t* X;
    DI void operator()(const f32x4 (&acc)[2][2][4][2], const pg8::Unit& u, int wr, int wc, int fr, int fq) const {
        const int row0 = u.pm * 256 + wr * 64 + fr, col0 = u.pn * 256 + wc * 32 + 8 * fq;
#pragma unroll
        for (int ai = 0; ai < 2; ++ai)
#pragma unroll
            for (int m = 0; m < 4; ++m) { bf16_t* rowp = X + (size_t)(row0 + ai * 128 + m * 16) * D + col0;
#pragma unroll
                for (int bj = 0; bj < 2; ++bj) { u32x4* p = (u32x4*)(rowp + bj * 128); const u32x4 o = *p; const f32x4 a = acc[ai][bj][m][0], b = acc[ai][bj][m][1];
                    u32x4 w; w.x = pk(bflo(o.x) + a[0], bfhi(o.x) + a[1]); w.y = pk(bflo(o.y) + a[2], bfhi(o.y) + a[3]);
                    w.z = pk(bflo(o.z) + b[0], bfhi(o.z) + b[1]); w.w = pk(bflo(o.w) + b[2], bfhi(o.w) + b[3]); *p = w; } }
    }
};

DI void tload(const float* W, int N, int item, int nblk, int lane, f32x4 (&tv)[8]) {
    const int kb = item / nblk, nb = item % nblk, k0 = 64 * kb, n0 = 32 * nb;
    const int n4 = (lane & 7) * 4, kr = lane >> 3; const bool ok = n0 + n4 < N;
#pragma unroll
    for (int i = 0; i < 8; ++i) tv[i] = ok ? __builtin_nontemporal_load((const f32x4*)(W + (size_t)(k0 + 8 * i + kr) * N + n0 + n4)) : (f32x4){0.f, 0.f, 0.f, 0.f};
}
DI void tstore(const f32x4 (&tv)[8], int K, bf16_t* WT, LAS float* scr, int item, int nblk, int lane) {
    const int kb = item / nblk, nb = item % nblk, k0 = 64 * kb, n0 = 32 * nb;
    const int n4 = (lane & 7) * 4, kr = lane >> 3;
#pragma unroll
    for (int i = 0; i < 8; ++i) { LAS float* d = scr + (8 * i + kr) * 33 + n4; d[0] = tv[i][0]; d[1] = tv[i][1]; d[2] = tv[i][2]; d[3] = tv[i][3]; }
    __builtin_amdgcn_s_waitcnt(0xc07f); asm volatile("" ::: "memory");
    const int c = lane & 7;
#pragma unroll
    for (int j = 0; j < 4; ++j) { const int nn = (lane >> 3) + 8 * j; const LAS float* s = scr + (8 * c) * 33 + nn;
        u32x4 o; o.x = pk(s[0 * 33], s[1 * 33]); o.y = pk(s[2 * 33], s[3 * 33]); o.z = pk(s[4 * 33], s[5 * 33]); o.w = pk(s[6 * 33], s[7 * 33]);
        __builtin_nontemporal_store(o, (u32x4*)(WT + (size_t)(n0 + nn) * K + k0 + 8 * c)); }
    __builtin_amdgcn_s_waitcnt(0xc07f); asm volatile("" ::: "memory");
}
DI void prologue(const Params& p, LAS unsigned char* lds, int gw, int ngw, int wv, int lane) {
    LAS float* scr = (LAS float*)(lds + wv * 8704);
    for (int mat = 0; mat < 6; ++mat) {
        const float* src; int K, N, Np, cnt; size_t dst;
        switch (mat) {
            case 0: src = p.in[10]; K = 1024; N = NHR; Np = NH; cnt = 2; dst = WS_WINH; break;
            case 1: src = p.in[16]; K = 1024; N = 1024; Np = 1024; cnt = 2; dst = WS_WOUTH; break;
            case 2: src = p.in[17]; K = 1024; N = NSR; Np = NS; cnt = 2; dst = WS_WINS; break;
            case 3: src = p.in[24]; K = 2048; N = 1024; Np = 1024; cnt = 2; dst = WS_WOUTS; break;
            case 4: src = p.in[25]; K = 1024; N = FF; Np = FF; cnt = 4; dst = WS_W1; break;
            default: src = p.in[26]; K = FF; N = 1024; Np = 1024; cnt = 4; dst = WS_W2; break;
        }
        const int nblk = Np / 32, per = (K / 64) * nblk, tot = per * cnt;
        f32x4 ta[8], tb[8];
        int it = gw;
        if (it < tot) tload(src + (size_t)(it / per) * K * N, N, it % per, nblk, lane, ta);
#pragma nounroll
        for (; it < tot; it += 2 * ngw) {
            const int it2 = it + ngw;
            if (it2 < tot) tload(src + (size_t)(it2 / per) * K * N, N, it2 % per, nblk, lane, tb);
            tstore(ta, K, (bf16_t*)(p.ws + dst) + (size_t)(it / per) * Np * K, scr, it % per, nblk, lane);
            const int it3 = it2 + ngw;
            if (it3 < tot) tload(src + (size_t)(it3 / per) * K * N, N, it3 % per, nblk, lane, ta);
            if (it2 < tot) tstore(tb, K, (bf16_t*)(p.ws + dst) + (size_t)(it2 / per) * Np * K, scr, it2 % per, nblk, lane);
        }
    }
    bf16_t* H = (bf16_t*)(p.ws + WS_H);
    for (int m = TR + gw; m < MP; m += ngw) { u32x4 z = {0u, 0u, 0u, 0u}; *(u32x4*)(H + (size_t)m * D + lane * 8) = z; *(u32x4*)(H + (size_t)m * D + 512 + lane * 8) = z; }
}

constexpr size_t WS_XS = WS_X + (size_t)MP * 1024 * 2;
DI void norm_rows(const Params& p, const float* w, bool copy, int gw, int ngw, int lane) {
    bf16_t* X16 = (bf16_t*)(p.ws + WS_X); float* Xs = (float*)(p.ws + WS_XS); bf16_t* H = (bf16_t*)(p.ws + WS_H);
    f32x4 wv[4];
#pragma unroll
    for (int j = 0; j < 2; ++j) { wv[2 * j] = *(const f32x4*)(w + 8 * lane + 512 * j); wv[2 * j + 1] = *(const f32x4*)(w + 8 * lane + 512 * j + 4); }
    for (int m0 = gw * 2; m0 < TP; m0 += ngw * 2) {
        f32x4 v[2][4];
#pragma unroll
        for (int rr = 0; rr < 2; ++rr) { const int m = m0 + rr;
            if (copy) {
#pragma unroll
                for (int j = 0; j < 2; ++j) { v[rr][2 * j] = __builtin_nontemporal_load((const f32x4*)(p.in[0] + (size_t)m * D + 8 * lane + 512 * j)); v[rr][2 * j + 1] = __builtin_nontemporal_load((const f32x4*)(p.in[0] + (size_t)m * D + 8 * lane + 512 * j + 4)); }
            } else {
#pragma unroll
                for (int j = 0; j < 2; ++j) { const u32x4 u = *(const u32x4*)(X16 + (size_t)m * D + 8 * lane + 512 * j);
                    v[rr][2 * j] = (f32x4){bflo(u.x), bfhi(u.x), bflo(u.y), bfhi(u.y)}; v[rr][2 * j + 1] = (f32x4){bflo(u.z), bfhi(u.z), bflo(u.w), bfhi(u.w)}; }
            } }
#pragma unroll
        for (int rr = 0; rr < 2; ++rr) { const int m = m0 + rr; float ss = 0.f;
#pragma unroll
            for (int j = 0; j < 4; ++j) ss += v[rr][j][0] * v[rr][j][0] + v[rr][j][1] * v[rr][j][1] + v[rr][j][2] * v[rr][j][2] + v[rr][j][3] * v[rr][j][3];
            ss = wsum(ss); const float r = rsqrtf(ss * (1.f / 1024.f) + 1e-6f);
#pragma unroll
            for (int j = 0; j < 2; ++j) { const f32x4 a = v[rr][2 * j], b = v[rr][2 * j + 1];
                if (copy) { u32x4 xo; xo.x = pk(a[0], a[1]); xo.y = pk(a[2], a[3]); xo.z = pk(b[0], b[1]); xo.w = pk(b[2], b[3]); *(u32x4*)(X16 + (size_t)m * D + 8 * lane + 512 * j) = xo; }
                u32x4 o; o.x = pk(a[0] * r * wv[2 * j][0], a[1] * r * wv[2 * j][1]); o.y = pk(a[2] * r * wv[2 * j][2], a[3] * r * wv[2 * j][3]);
                o.z = pk(b[0] * r * wv[2 * j + 1][0], b[1] * r * wv[2 * j + 1][1]); o.w = pk(b[2] * r * wv[2 * j + 1][2], b[3] * r * wv[2 * j + 1][3]);
                *(u32x4*)(H + (size_t)m * D + 8 * lane + 512 * j) = o; } }
    }
    for (int m = TP + gw; m < TR; m += ngw) {
        const float* src = copy ? p.in[1] + (size_t)(m - TP) * D : Xs + (size_t)(m - TP) * D;
        f32x4 v[4]; float ss = 0.f;
#pragma unroll
        for (int j = 0; j < 4; ++j) { v[j] = *(const f32x4*)(src + 4 * lane + 256 * j); ss += v[j][0] * v[j][0] + v[j][1] * v[j][1] + v[j][2] * v[j][2] + v[j][3] * v[j][3]; }
        ss = wsum(ss); const float r = rsqrtf(ss * (1.f / 1024.f) + 1e-6f);
#pragma unroll
        for (int j = 0; j < 4; ++j) { const f32x4 ww = *(const f32x4*)(w + 4 * lane + 256 * j);
            if (copy) *(f32x4*)(Xs + (size_t)(m - TP) * D + 4 * lane + 256 * j) = v[j];
            u32x2 o; o.x = pk(v[j][0] * r * ww[0], v[j][1] * r * ww[1]); o.y = pk(v[j][2] * r * ww[2], v[j][3] * r * ww[3]);
            *(u32x2*)(H + (size_t)m * D + 4 * lane + 256 * j) = o; }
    }
}
DI void final_norm(const Params& p, int gw, int ngw, int lane) {
    const bf16_t* X16 = (const bf16_t*)(p.ws + WS_X); const float* Xs = (const float*)(p.ws + WS_XS); const float* w = p.in[9];
    f32x4 wv[4];
#pragma unroll
    for (int j = 0; j < 2; ++j) { wv[2 * j] = *(const f32x4*)(w + 8 * lane + 512 * j); wv[2 * j + 1] = *(const f32x4*)(w + 8 * lane + 512 * j + 4); }
    for (int m0 = gw * 2; m0 < TP; m0 += ngw * 2) {
        f32x4 v[2][4];
#pragma unroll
        for (int rr = 0; rr < 2; ++rr)
#pragma unroll
            for (int j = 0; j < 2; ++j) { const u32x4 u = *(const u32x4*)(X16 + (size_t)(m0 + rr) * D + 8 * lane + 512 * j);
                v[rr][2 * j] = (f32x4){bflo(u.x), bfhi(u.x), bflo(u.y), bfhi(u.y)}; v[rr][2 * j + 1] = (f32x4){bflo(u.z), bfhi(u.z), bflo(u.w), bfhi(u.w)}; }
#pragma unroll
        for (int rr = 0; rr < 2; ++rr) { const int m = m0 + rr; float ss = 0.f; float* dst = p.out + O_YP + (size_t)m * D;
#pragma unroll
            for (int j = 0; j < 4; ++j) ss += v[rr][j][0] * v[rr][j][0] + v[rr][j][1] * v[rr][j][1] + v[rr][j][2] * v[rr][j][2] + v[rr][j][3] * v[rr][j][3];
            ss = wsum(ss); const float r = rsqrtf(ss * (1.f / 1024.f) + 1e-6f);
#pragma unroll
            for (int j = 0; j < 2; ++j) { __builtin_nontemporal_store(v[rr][2 * j] * r * wv[2 * j], (f32x4*)(dst + 8 * lane + 512 * j)); __builtin_nontemporal_store(v[rr][2 * j + 1] * r * wv[2 * j + 1], (f32x4*)(dst + 8 * lane + 512 * j + 4)); } }
    }
    for (int m = TP + gw; m < TR; m += ngw) {
        const float* src = Xs + (size_t)(m - TP) * D; float* dst = p.out + O_YS + (size_t)(m - TP) * D;
        f32x4 v[4]; float ss = 0.f;
#pragma unroll
        for (int j = 0; j < 4; ++j) { v[j] = *(const f32x4*)(src + 4 * lane + 256 * j); ss += v[j][0] * v[j][0] + v[j][1] * v[j][1] + v[j][2] * v[j][2] + v[j][3] * v[j][3]; }
        ss = wsum(ss); const float r = rsqrtf(ss * (1.f / 1024.f) + 1e-6f);
#pragma unroll
        for (int j = 0; j < 4; ++j) { const f32x4 ww = *(const f32x4*)(w + 4 * lane + 256 * j); *(f32x4*)(dst + 4 * lane + 256 * j) = v[j] * r * ww; }
    }
}

constexpr int P_KN = 0, P_QN = 17408, P_KBT = 34816, P_KDT = 53248, P_VBT = 71680, P_AM = 90112, P_TM = 107520, P_SC = 116736, P_TF = 117760;
DI void gdn_prep_unit(LAS unsigned char* lds, const bf16_t* PROJ, const float* convw, float a_log_h, float dtb_h, unsigned char* blk, int row0, int h, int tid) {
    asm volatile("" : "+v"(tid));
    const int lane = tid & 63, w = tid >> 6, r = lane & 15, q = lane >> 4;
    LAS float* scG = (LAS float*)(lds + P_SC); LAS float* scC = scG + 64; LAS float* scB = scG + 128;
    if (w == 0) {
        const bf16_t* pr = PROJ + (size_t)(row0 + lane) * NH;
        const float braw = bf2f(pr[2048 + h]), araw = bf2f(pr[2052 + h]);
        const float beta = 1.f / (1.f + __expf(-braw));
        const float g = -__expf(a_log_h) * softplusf(araw + dtb_h);
        float c = g;
#pragma unroll
        for (int o = 1; o < 64; o <<= 1) { const float t = __shfl_up(c, o); if (lane >= o) c += t; }
        scG[lane] = g; scC[lane] = c; scB[lane] = beta;
    }
    __syncthreads();
    const float gend = scC[63];
    float cw[3][4][2];
#pragma unroll
    for (int grp = 0; grp < 3; ++grp)
#pragma unroll
        for (int tap = 0; tap < 4; ++tap) { const f32x2 t = *(const f32x2*)(convw + tap * 1536 + grp * 512 + h * 128 + 2 * lane); cw[grp][tap][0] = t[0]; cw[grp][tap][1] = t[1]; }
    LAS bf16_t* kbt = (LAS bf16_t*)(lds + P_KBT); LAS bf16_t* kdt = (LAS bf16_t*)(lds + P_KDT); LAS bf16_t* vbt = (LAS bf16_t*)(lds + P_VBT);
    unsigned xr[11][3];
#pragma unroll
    for (int j = 0; j < 11; ++j) { const int t = (row0 & (SEQ - 1)) + w * 8 - 3 + j; const bf16_t* pr = PROJ + (size_t)(row0 + w * 8 - 3 + j) * NH + h * 128 + 2 * lane;
#pragma unroll
        for (int grp = 0; grp < 3; ++grp) xr[j][grp] = (t >= 0) ? *(const unsigned*)(pr + grp * 512) : 0u; }
#pragma unroll
    for (int tt = 0; tt < 8; ++tt) {
        const int i = w * 8 + tt;
        float a[3][2] = {{0.f, 0.f}, {0.f, 0.f}, {0.f, 0.f}};
#pragma unroll
        for (int tap = 0; tap < 4; ++tap)
#pragma unroll
            for (int grp = 0; grp < 3; ++grp) { const unsigned u = xr[tt + tap][grp]; a[grp][0] += cw[grp][tap][0] * bflo(u); a[grp][1] += cw[grp][tap][1] * bfhi(u); }
#pragma unroll
        for (int grp = 0; grp < 3; ++grp) { a[grp][0] = siluf(a[grp][0]); a[grp][1] = siluf(a[grp][1]); }
        const float sq = wsum(a[0][0] * a[0][0] + a[0][1] * a[0][1]), sk = wsum(a[1][0] * a[1][0] + a[1][1] * a[1][1]);
        const float rq = rsqrtf(sq + 1e-6f) * 0.08838834764831845f, rk = rsqrtf(sk + 1e-6f);
        const float q0 = a[0][0] * rq, q1 = a[0][1] * rq, k0 = a[1][0] * rk, k1 = a[1][1] * rk, v0 = a[2][0], v1 = a[2][1];
        const float gc = scC[i], be = scB[i], eg = __expf(gc), ed = __expf(gend - gc);
        *(LAS unsigned*)(lds + P_QN + i * 272 + lane * 4) = pk(q0, q1);
        *(LAS unsigned*)(lds + P_KN + i * 272 + lane * 4) = pk(k0, k1);
        *(unsigned*)(blk + GB_QG + i * 272 + lane * 4) = pk(q0 * eg, q1 * eg);
        kbt[(2 * lane) * 72 + i] = f2bf(k0 * be * eg); kbt[(2 * lane + 1) * 72 + i] = f2bf(k1 * be * eg);
        kdt[(2 * lane) * 72 + i] = f2bf(k0 * ed); kdt[(2 * lane + 1) * 72 + i] = f2bf(k1 * ed);
        vbt[(2 * lane) * 72 + i] = f2bf(v0 * be); vbt[(2 * lane + 1) * 72 + i] = f2bf(v1 * be);
    }
    __syncthreads();
    LAS float* AM = (LAS float*)(lds + P_AM);
    for (int tix = w; tix < 16; tix += 8) { const int mi = tix >> 2, nj = tix & 3;
        f32x4 kk = {0.f, 0.f, 0.f, 0.f}, qk = {0.f, 0.f, 0.f, 0.f};
        if (nj <= mi) {
#pragma unroll
            for (int s = 0; s < 4; ++s) { const bf16x8 bk = lda_nat(lds + P_KN, 16 * nj + r, 272, 32 * s, q), ak = lda_nat(lds + P_KN, 16 * mi + r, 272, 32 * s, q), aq = lda_nat(lds + P_QN, 16 * mi + r, 272, 32 * s, q);
                kk = MFMA16(ak, bk, kk); qk = MFMA16(aq, bk, qk); } }
#pragma unroll
        for (int reg = 0; reg < 4; ++reg) { const int i = 16 * mi + 4 * q + reg, j = 16 * nj + r;
            const float dec = (j <= i) ? __expf(scC[i] - scC[j]) : 0.f;
            AM[j * 68 + i] = (j < i) ? scB[i] * kk[reg] * dec : 0.f;
            *(bf16_t*)(blk + GB_P + (i * 72 + j) * 2) = f2bf(qk[reg] * dec); }
    }
    __syncthreads();
    if (w == 0) {
        LAS bf16_t* TM = (LAS bf16_t*)(lds + P_TM);
        float t[64];
#pragma unroll
        for (int i = 0; i < 64; ++i) t[i] = (lane == i) ? 1.f : 0.f;
#pragma unroll
        for (int j = 0; j < 63; ++j) { const float tj = t[j];
#pragma unroll
            for (int i = j + 1; i < 64; ++i) t[i] -= AM[j * 68 + i] * tj; }
#pragma unroll
        for (int i = 0; i < 64; ++i) TM[i * 72 + lane] = f2bf(t[i]);
    } else {
        for (int idx = tid - 64; idx < 1152; idx += 448) *(u32x4*)(blk + GB_KDT + idx * 16) = *(const LAS u32x4*)(lds + P_KDT + idx * 16);
    }
    __syncthreads();
    for (int tix = w; tix < 64; tix += 8) {
        f32x4 acc = {0.f, 0.f, 0.f, 0.f};
        if (tix < 32) { const int mi = tix >> 3, nv = tix & 7;
#pragma unroll
            for (int s = 0; s < 2; ++s) acc = MFMA16(lda_nat(lds + P_TM, 16 * mi + r, 144, 32 * s, q), lda_nat(lds + P_VBT, 16 * nv + r, 144, 32 * s, q), acc);
            u32x2 o; o.x = pk(acc[0], acc[1]); o.y = pk(acc[2], acc[3]);
            *(u32x2*)(blk + GB_UT + ((16 * nv + r) * 72 + 16 * mi + 4 * q) * 2) = o;
        } else { const int t2 = tix - 32, mk = t2 >> 2, ni = t2 & 3;
#pragma unroll
            for (int s = 0; s < 2; ++s) acc = MFMA16(lda_nat(lds + P_KBT, 16 * mk + r, 144, 32 * s, q), lda_nat(lds + P_TM, 16 * ni + r, 144, 32 * s, q), acc);
            u32x2 o; o.x = pk(-acc[0], -acc[1]); o.y = pk(-acc[2], -acc[3]);
            *(u32x2*)(blk + GB_NW + ((16 * ni + r) * 136 + 16 * mk + 4 * q) * 2) = o; }
    }
    if (tid == 0) *(float*)(blk + GB_SC) = __expf(gend);
    __syncthreads();
}

constexpr int R_QR = 0, R_KR = 9216, R_KDT = 18432, R_VT = 27648;
DI void rot_sincos(float pos, int f, float& sn, float& cs) {
    const float inv = exp2f(-(float)f * (13.287712379549449f / 32.f));
    const float ang = pos * inv;
    double rev = (double)ang * 0.15915494309189535; rev -= __builtin_floor(rev);
    const float fr = (float)rev;
    sn = __builtin_amdgcn_sinf(fr); cs = __builtin_amdgcn_cosf(fr);
}
DI void ret_prep_unit(LAS unsigned char* lds, const bf16_t* PROJ, unsigned char* blk, int row0, int h, int tid) {
    asm volatile("" : "+v"(tid));
    const int lane = tid & 63, w = tid >> 6, r = lane & 15, q = lane >> 4;
    const float lg = __logf(1.f - exp2f(-5.f - (float)h));
    const int f = lane & 31, which = lane >> 5;
    LAS bf16_t* qr = (LAS bf16_t*)(lds + R_QR); LAS bf16_t* kr = (LAS bf16_t*)(lds + R_KR); LAS bf16_t* kdt = (LAS bf16_t*)(lds + R_KDT); LAS bf16_t* vt = (LAS bf16_t*)(lds + R_VT);
#pragma unroll
    for (int tt = 0; tt < 8; ++tt) {
        const int i = w * 8 + tt, t = (row0 & (SEQ - 1)) + i;
        const bf16_t* pr = PROJ + (size_t)(row0 + i) * NH;
        const int base = (which ? 2312 : 2056) + h * 64;
        const float x1 = bf2f(pr[base + f]), x2 = bf2f(pr[base + 32 + f]);
        float sn, cs; rot_sincos((float)t, f, sn, cs);
        float o1 = x1 * cs - x2 * sn, o2 = x2 * cs + x1 * sn;
        if (which == 0) {
            qr[i * 72 + f] = f2bf(o1); qr[i * 72 + 32 + f] = f2bf(o2);
            const float eg = __expf((float)(i + 1) * lg);
            *(bf16_t*)(blk + RB_QG + (i * 72 + f) * 2) = f2bf(o1 * eg); *(bf16_t*)(blk + RB_QG + (i * 72 + 32 + f) * 2) = f2bf(o2 * eg);
        } else {
            o1 *= 0.125f; o2 *= 0.125f;
            kr[i * 72 + f] = f2bf(o1); kr[i * 72 + 32 + f] = f2bf(o2);
            const float ed = __expf((float)(63 - i) * lg);
            kdt[f * 72 + i] = f2bf(o1 * ed); kdt[(32 + f) * 72 + i] = f2bf(o2 * ed);
        }
        const unsigned u = *(const unsigned*)(pr + 2568 + h * 128 + 2 * lane);
        vt[(2 * lane) * 72 + i] = (bf16_t)(u & 0xffffu); vt[(2 * lane + 1) * 72 + i] = (bf16_t)(u >> 16);
    }
    __syncthreads();
    for (int tix = w; tix < 16; tix += 8) { const int mi = tix >> 2, nj = tix & 3;
        f32x4 qk = {0.f, 0.f, 0.f, 0.f};
        if (nj <= mi) {
#pragma unroll
            for (int s = 0; s < 2; ++s) qk = MFMA16(lda_nat(lds + R_QR, 16 * mi + r, 144, 32 * s, q), lda_nat(lds + R_KR, 16 * nj + r, 144, 32 * s, q), qk); }
#pragma unroll
        for (int reg = 0; reg < 4; ++reg) { const int i = 16 * mi + 4 * q + reg, j = 16 * nj + r;
            const float dec = (j <= i) ? __expf((float)(i - j) * lg) : 0.f;
            *(bf16_t*)(blk + RB_P + (i * 72 + j) * 2) = f2bf(qk[reg] * dec); }
    }
    for (int idx = tid; idx < 1728; idx += 512) __builtin_nontemporal_store(*(const LAS u32x4*)(lds + R_KDT + idx * 16), (u32x4*)(blk + RB_KDT + idx * 16));
    if (tid == 0) *(float*)(blk + RB_SC) = __expf(64.f * lg);
    __syncthreads();
}

constexpr int Q_CM = 0, Q_BM = 17408, Q_BT = 34816, Q_XT = 53248, Q_END = 53248 + 73728;
DI void ssd_prep_unit(LAS unsigned char* lds, const bf16_t* PROJ, const float* convw  , const float* convb, const float* dtb, const float* alog, const float* dsk,
                      unsigned char* gblk, unsigned char* hblk0  , int row0, int g, int tid) {
    asm volatile("" : "+v"(tid));
    const int lane = tid & 63, w = tid >> 6, r = lane & 15, q = lane >> 4;
    int ch[6];
#pragma unroll
    for (int j = 0; j < 4; ++j) ch[j] = g * 512 + 128 * j + 2 * lane;
    ch[4] = 2048 + g * 128 + 2 * lane; ch[5] = 2560 + g * 128 + 2 * lane;
    float cw[6][5][2];
#pragma unroll
    for (int j = 0; j < 6; ++j) {
#pragma unroll
        for (int tap = 0; tap < 4; ++tap) { const f32x2 t = *(const f32x2*)(convw + tap * 3072 + ch[j]); cw[j][tap][0] = t[0]; cw[j][tap][1] = t[1]; }
        const f32x2 t = *(const f32x2*)(convb + ch[j]); cw[j][4][0] = t[0]; cw[j][4][1] = t[1]; }
    LAS bf16_t* bt = (LAS bf16_t*)(lds + Q_BT); LAS bf16_t* xt = (LAS bf16_t*)(lds + Q_XT);
    if (w == 0) {
        const bf16_t* pr = PROJ + (size_t)(row0 + lane) * NS + 5120 + g * 8;
#pragma unroll
        for (int hh = 0; hh < 8; ++hh) { const int head = g * 8 + hh;
            const float dt = softplusf(bf2f(pr[hh]) + dtb[head]); const float gg = -__expf(alog[head]) * dt;
            float c = gg;
#pragma unroll
            for (int o = 1; o < 64; o <<= 1) { const float t = __shfl_up(c, o); if (lane >= o) c += t; }
            const float gend = __shfl(c, 63);
            float* sc = (float*)(hblk0 + (size_t)(hh >> 1) * 32 * 2 * SH_SIZE + (hh & 1) * SH_SIZE + SH_SC);
            sc[lane] = dt * __expf(gend - c); sc[64 + lane] = __expf(c);
            LAS float* ls = (LAS float*)(lds + Q_END) + hh * 128; ls[lane] = dt; ls[64 + lane] = c; }
    }
    unsigned xr[11][6];
#pragma unroll
    for (int jr = 0; jr < 11; ++jr) { const int t = (row0 & (SEQ - 1)) + w * 8 - 3 + jr; const bf16_t* pr = PROJ + (size_t)(row0 + w * 8 - 3 + jr) * NS + 2048;
#pragma unroll
        for (int j = 0; j < 6; ++j) xr[jr][j] = (t >= 0) ? *(const unsigned*)(pr + ch[j]) : 0u; }
#pragma unroll
    for (int tt = 0; tt < 8; ++tt) {
        const int i = w * 8 + tt;
        float a[6][2];
#pragma unroll
        for (int j = 0; j < 6; ++j) { a[j][0] = cw[j][4][0]; a[j][1] = cw[j][4][1]; }
#pragma unroll
        for (int tap = 0; tap < 4; ++tap)
#pragma unroll
            for (int j = 0; j < 6; ++j) { const unsigned u = xr[tt + tap][j]; a[j][0] += cw[j][tap][0] * bflo(u); a[j][1] += cw[j][tap][1] * bfhi(u); }
#pragma unroll
        for (int j = 0; j < 6; ++j) { a[j][0] = siluf(a[j][0]); a[j][1] = siluf(a[j][1]); }
#pragma unroll
        for (int j = 0; j < 4; ++j) { xt[(128 * j + 2 * lane) * 72 + i] = f2bf(a[j][0]); xt[(128 * j + 2 * lane + 1) * 72 + i] = f2bf(a[j][1]); }
        *(LAS unsigned*)(lds + Q_BM + i * 272 + lane * 4) = pk(a[4][0], a[4][1]);
        bt[(2 * lane) * 72 + i] = f2bf(a[4][0]); bt[(2 * lane + 1) * 72 + i] = f2bf(a[4][1]);
        const unsigned cu = pk(a[5][0], a[5][1]);
        *(LAS unsigned*)(lds + Q_CM + i * 272 + lane * 4) = cu;
        *(unsigned*)(gblk + SG_CM + i * 272 + lane * 4) = cu;
    }
    __syncthreads();
    for (int tix = w; tix < 16; tix += 8) { const int mi = tix >> 2, nj = tix & 3;
        f32x4 cb = {0.f, 0.f, 0.f, 0.f};
        if (nj <= mi) {
#pragma unroll
            for (int s = 0; s < 4; ++s) cb = MFMA16(lda_nat(lds + Q_CM, 16 * mi + r, 272, 32 * s, q), lda_nat(lds + Q_BM, 16 * nj + r, 272, 32 * s, q), cb); }
#pragma unroll
        for (int hh = 0; hh < 8; ++hh) { const LAS float* ls = (const LAS float*)(lds + Q_END) + hh * 128; const float dj = ls[16 * nj + r], gj = ls[64 + 16 * nj + r], dk = dsk[g * 8 + hh];
            unsigned char* pb = hblk0 + (size_t)(hh >> 1) * 32 * 2 * SH_SIZE + (hh & 1) * SH_SIZE + SH_PP;
#pragma unroll
            for (int reg = 0; reg < 4; ++reg) { const int i = 16 * mi + 4 * q + reg, j = 16 * nj + r;
                float v = (j <= i) ? cb[reg] * __expf(ls[64 + i] - gj) * dj : 0.f; if (i == j) v += dk;
                *(bf16_t*)(pb + (i * 72 + j) * 2) = f2bf(v); } }
    }
    for (int idx = tid; idx < 1152; idx += 512) *(u32x4*)(gblk + SG_BT + idx * 16) = *(const LAS u32x4*)(lds + Q_BT + idx * 16);
    for (int idx = tid; idx < 4608; idx += 512) { const int hh = idx / 576, o = idx % 576;
        __builtin_nontemporal_store(*(const LAS u32x4*)(lds + Q_XT + idx * 16), (u32x4*)(hblk0 + (size_t)(hh >> 1) * 32 * 2 * SH_SIZE + (hh & 1) * SH_SIZE + SH_XT + o * 16)); }
    __syncthreads();
}
#define XB_T0(wid) ((wid) == 0 && __builtin_amdgcn_mbcnt_hi(~0u, __builtin_amdgcn_mbcnt_lo(~0u, 0u)) == 0u)
#define XB_TMO      128
#define XB_XCNT(j)  (256  + 64 * (j))
#define XB_XSUB(j)  (1280 + 64 * (j))
#define XB_XGEN(j)  (2304 + 64 * (j))
#define XB_TOP      3328
#define XB_TOPGEN   3392
#define XCD_BAR_WORDS 3456
#define XB_SPIN_CAP (1u << 18)

__device__ __forceinline__ unsigned xb_ld(unsigned* p)              { return __hip_atomic_load(p, __ATOMIC_RELAXED, __HIP_MEMORY_SCOPE_AGENT); }
__device__ __forceinline__ unsigned xb_add(unsigned* p, unsigned v) { return __hip_atomic_fetch_add(p, v, __ATOMIC_RELAXED, __HIP_MEMORY_SCOPE_AGENT); }
__device__ __forceinline__ unsigned xb_xcc_id() { return (unsigned)__builtin_amdgcn_s_getreg((3 << 11) | 20) & 0xFu; }
#define XB_SPIN(cond, bar) do { unsigned _sp = 0; while (cond) { __builtin_amdgcn_s_sleep(1); \
    if ((++_sp & 255u) == 0u) { if (xb_ld(&(bar)[XB_TMO])) break; if (_sp > XB_SPIN_CAP) { atomicAdd(&(bar)[XB_TMO], 1u); break; } } } } while (0)

struct XcdBarrier {
    unsigned* bar; unsigned x; int wid;
    volatile LAS unsigned* st;
};

__device__ __forceinline__ XcdBarrier xcd_barrier_post(unsigned* bar, volatile LAS unsigned* st, int wid) {
    XcdBarrier b; b.bar = bar; b.x = xb_xcc_id(); b.st = st; b.wid = wid;
    if (XB_T0(wid)) (void)xb_add(&bar[XB_XCNT(b.x)], 1u);
    return b;
}
__device__ __forceinline__ void xcd_barrier_complete(unsigned* bar, unsigned x, unsigned& nloc, unsigned& nx) {
    const unsigned G = gridDim.x * gridDim.y * gridDim.z;
    unsigned sum, cnt, mine, sp = 0u;
    for (;;) {
        sum = 0u; cnt = 0u; mine = 0u;
#pragma unroll
        for (unsigned j = 0; j < 16; ++j) { const unsigned c = xb_ld(&bar[XB_XCNT(j)]); sum += c; cnt += (c > 0u) ? 1u : 0u; mine = (j == x) ? c : mine; }
        if (sum == G) break;
        __builtin_amdgcn_s_sleep(1);
        if ((++sp & 255u) == 0u) { if (xb_ld(&bar[XB_TMO])) break; if (sp > XB_SPIN_CAP) { atomicAdd(&bar[XB_TMO], 1u); break; } }
    }
    nloc = mine > 0u ? mine : 1u; nx = cnt > 0u ? cnt : 1u;
}

__device__ __forceinline__ void xcd_barrier(const XcdBarrier& b) {
    asm volatile("s_waitcnt vmcnt(0)" ::: "memory");
    __syncthreads();
    if (XB_T0(b.wid)) {
        unsigned* bar = b.bar;
        __builtin_amdgcn_s_waitcnt(0);
        unsigned nloc = b.st[0], nx = b.st[1];
        if (nloc == 0u) { xcd_barrier_complete(bar, b.x, nloc, nx); b.st[0] = nloc; b.st[1] = nx; }
        const unsigned old = xb_add(&bar[XB_XSUB(b.x)], 1u);
        const unsigned gen = old / nloc;
        if (old + 1u == (gen + 1u) * nloc) {
            __builtin_amdgcn_fence(__ATOMIC_RELEASE, "agent");
            asm volatile("s_waitcnt vmcnt(0)" ::: "memory");
            const unsigned og = xb_add(&bar[XB_TOP], 1u);
            const unsigned tg = og / nx;
            if (og + 1u == (tg + 1u) * nx) xb_add(&bar[XB_TOPGEN], 1u);
            else XB_SPIN(xb_ld(&bar[XB_TOPGEN]) == tg, bar);
            __builtin_amdgcn_fence(__ATOMIC_ACQUIRE, "agent");
            xb_add(&bar[XB_XGEN(b.x)], 1u);
            asm volatile("s_waitcnt vmcnt(0)" ::: "memory");
        } else {
            XB_SPIN(xb_ld(&bar[XB_XGEN(b.x)]) == gen, bar);
            __builtin_amdgcn_fence(__ATOMIC_ACQUIRE, "agent");
            asm volatile("s_waitcnt vmcnt(0)" ::: "memory");
        }
    }
    __syncthreads();
}


#define PF_LOAD(pf, n, src, nvec) do { _Pragma("unroll") for (int _k = 0; _k < (n); ++_k) { const int _i = tid + _k * 512; if (_i < (nvec)) pf[_k] = ((const u32x4*)(src))[_i]; } } while (0)
#define PF_LOAD_NT(pf, n, src, nvec) do { _Pragma("unroll") for (int _k = 0; _k < (n); ++_k) { const int _i = tid + _k * 512; if (_i < (nvec)) pf[_k] = __builtin_nontemporal_load((const u32x4*)(src) + _i); } } while (0)
#define PF_STORE(pf, n, nvec) do { _Pragma("unroll") for (int _k = 0; _k < (n); ++_k) { const int _i = tid + _k * 512; if (_i < (nvec)) ((LAS u32x4*)lds)[_i] = pf[_k]; } } while (0)

constexpr int GL_UT = 62464, GL_SC = 67072, GL_SIZE = 67136, GL_NV = GL_SIZE / 16;
constexpr int GS_SF = 2 * GL_SIZE, GS_DF = GS_SF + 8192;
static_assert(GS_DF + 4096 <= LDS_BYTES - 32, "GDN scan LDS budget");
DI void gdn_scan(LAS unsigned char* lds, const unsigned char* blk0, bf16_t* YRAW, int row0, int h, float* sout, int tid, const int vs) {
    asm volatile("" : "+v"(tid));
    const int lane = tid & 63, w = tid >> 6, r = lane & 15, q = lane >> 4, ct = w & 1, rg = w >> 1, v0 = 32 * vs + 16 * ct;
    f32x4 S0 = (f32x4){0.f, 0.f, 0.f, 0.f}, S1 = S0;
    u32x4 pfA[9], pfB[9];
#define GDN_LOAD(pf, cc) do { const u32x4* _s = (const u32x4*)(blk0 + (size_t)(cc) * GB_SIZE); _Pragma("unroll") for (int _k = 0; _k < 9; ++_k) { const int _i = tid + _k * 512; \
        if (_i < GL_NV) pf[_k] = _s[_i < 3904 ? _i : (_i < 4192 ? _i + vs * 288 : _i + 864)]; } } while (0)
#define GDN_STORE(pf, boff) do { _Pragma("unroll") for (int _k = 0; _k < 9; ++_k) { const int _i = tid + _k * 512; if (_i < GL_NV) ((LAS u32x4*)(lds + (boff)))[_i] = pf[_k]; } } while (0)
    GDN_LOAD(pfA, 0);
    GDN_STORE(pfA, 0);
    GDN_LOAD(pfA, 1); GDN_LOAD(pfB, 2);
    LAS u32x4* SF = (LAS u32x4*)(lds + GS_SF) + ct * 4 * 64;
    LAS unsigned char* DF = lds + GS_DF + ct * 2 * 1024;
    SF[rg * 64 + lane] = (u32x4){0u, 0u, 0u, 0u};
    __syncthreads();
    auto step = [&](auto BC, const int c, u32x4 (&pf)[9]) __attribute__((always_inline)) {
        constexpr int BUFC = decltype(BC)::value ? GL_SIZE : 0, BUFN = GL_SIZE - BUFC;
        const LAS unsigned char* bc = lds + BUFC;
        const float e = *(const LAS float*)(bc + GL_SC);
        const u32x2 uu = *(const LAS u32x2*)(bc + GL_UT + ((16 * ct + r) * 72 + 16 * rg + 4 * q) * 2);
        f32x4 Dl = (f32x4){bflo(uu.x), bfhi(uu.x), bflo(uu.y), bfhi(uu.y)}, Y = (f32x4){0.f, 0.f, 0.f, 0.f};
#pragma unroll
        for (int s = 0; s < 4; ++s) { const bf16x8 bs = __builtin_bit_cast(bf16x8, SF[s * 64 + lane]);
            Dl = MFMA16(lda_perm(bc + GB_NW, 16 * rg + r, 272, 32 * s, q), bs, Dl); Y = MFMA16(lda_perm(bc + GB_QG, 16 * rg + r, 272, 32 * s, q), bs, Y); }
        { u32x2 dd; dd.x = pk(Dl[0], Dl[1]); dd.y = pk(Dl[2], Dl[3]); *(LAS u32x2*)(DF + (rg >> 1) * 1024 + lane * 16 + (rg & 1) * 8) = dd; }
        __syncthreads();
        if (c + 1 < 32) GDN_STORE(pf, BUFN);
        if (c + 3 < 32) GDN_LOAD(pf, c + 3);
        S0 = S0 * e; S1 = S1 * e;
#pragma unroll
        for (int s2 = 0; s2 < 2; ++s2) { const bf16x8 bd = *(const LAS bf16x8*)(DF + s2 * 1024 + lane * 16);
            Y = MFMA16(lda_perm(bc + GB_P, 16 * rg + r, 144, 32 * s2, q), bd, Y);
            S0 = MFMA16(lda_perm(bc + GB_KDT, 16 * (2 * rg) + r, 144, 32 * s2, q), bd, S0);
            S1 = MFMA16(lda_perm(bc + GB_KDT, 16 * (2 * rg + 1) + r, 144, 32 * s2, q), bd, S1); }
#pragma unroll
        for (int reg = 0; reg < 4; ++reg) YRAW[(size_t)(row0 + c * 64 + 16 * rg + 4 * q + reg) * 2048 + h * 128 + v0 + r] = f2bf(Y[reg]);
        SF[rg * 64 + lane] = __builtin_bit_cast(u32x4, pack2(S0, S1));
        __syncthreads();
    };
#pragma nounroll
    for (int c = 0; c < 32; c += 2) { step(std::integral_constant<int, 0>{}, c, pfA); step(std::integral_constant<int, 1>{}, c + 1, pfB); }
#pragma unroll
    for (int reg = 0; reg < 4; ++reg) { sout[(16 * (2 * rg) + 4 * q + reg) * 128 + v0 + r] = S0[reg]; sout[(16 * (2 * rg + 1) + 4 * q + reg) * 128 + v0 + r] = S1[reg]; }
#undef GDN_LOAD
#undef GDN_STORE
}

DI void ret_scan(LAS unsigned char* lds, const unsigned char* blk0, bf16_t* YRAW, int row0, int h, float* sout, int tid) {
    asm volatile("" : "+v"(tid));
    const int lane = tid & 63, w = tid >> 6, r = lane & 15, q = lane >> 4, v0 = 16 * w;
    constexpr int RL = 46208;
    f32x4 S[4];
#pragma unroll
    for (int k = 0; k < 4; ++k) S[k] = (f32x4){0.f, 0.f, 0.f, 0.f};
    u32x4 pfA[6], pfB[6];
#define RET_STORE(pf, boff) do { _Pragma("unroll") for (int _k = 0; _k < 6; ++_k) { const int _i = tid + _k * 512; if (_i < RB_SIZE / 16) ((LAS u32x4*)(lds + (boff)))[_i] = pf[_k]; } } while (0)
    PF_LOAD_NT(pfA, 6, blk0, RB_SIZE / 16);
    RET_STORE(pfA, 0);
    PF_LOAD_NT(pfA, 6, blk0 + RB_SIZE, RB_SIZE / 16);
    PF_LOAD_NT(pfB, 6, blk0 + 2 * (size_t)RB_SIZE, RB_SIZE / 16);
    __syncthreads();
    auto step = [&](auto BC, const int c, u32x4 (&pf)[6]) __attribute__((always_inline)) {
        constexpr int BUFC = decltype(BC)::value ? RL : 0, BUFN = RL - BUFC;
        const LAS unsigned char* bc = lds + BUFC;
        if (c + 1 < 32) RET_STORE(pf, BUFN);
        if (c + 3 < 32) PF_LOAD_NT(pf, 6, blk0 + (size_t)(c + 3) * RB_SIZE, RB_SIZE / 16);
        const float e = *(const LAS float*)(bc + RB_SC);
        f32x4 Y[4];
#pragma unroll
        for (int m = 0; m < 4; ++m) Y[m] = (f32x4){0.f, 0.f, 0.f, 0.f};
#pragma unroll
        for (int s = 0; s < 2; ++s) { const bf16x8 bs = pack2(S[2 * s], S[2 * s + 1]);
#pragma unroll
            for (int m = 0; m < 4; ++m) Y[m] = MFMA16(lda_perm(bc + RB_QG, 16 * m + r, 144, 32 * s, q), bs, Y[m]); }
#pragma unroll
        for (int k = 0; k < 4; ++k) S[k] = S[k] * e;
#pragma unroll
        for (int s2 = 0; s2 < 2; ++s2) { const bf16x8 bv = lda_nat(bc + RB_VT, v0 + r, 144, 32 * s2, q);
#pragma unroll
            for (int m = 0; m < 4; ++m) Y[m] = MFMA16(lda_nat(bc + RB_P, 16 * m + r, 144, 32 * s2, q), bv, Y[m]);
#pragma unroll
            for (int k = 0; k < 4; ++k) S[k] = MFMA16(lda_nat(bc + RB_KDT, 16 * k + r, 144, 32 * s2, q), bv, S[k]); }
#pragma unroll
        for (int m = 0; m < 4; ++m)
#pragma unroll
            for (int reg = 0; reg < 4; ++reg) YRAW[(size_t)(row0 + c * 64 + 16 * m + 4 * q + reg) * 2048 + 512 + h * 128 + v0 + r] = f2bf(Y[m][reg]);
        __syncthreads();
    };
#pragma nounroll
    for (int c = 0; c < 32; c += 2) { step(std::integral_constant<int, 0>{}, c, pfA); step(std::integral_constant<int, 1>{}, c + 1, pfB); }
#pragma unroll
    for (int k = 0; k < 4; ++k)
#pragma unroll
        for (int reg = 0; reg < 4; ++reg) sout[(16 * k + 4 * q + reg) * 128 + v0 + r] = S[k][reg];
#undef RET_STORE
}

constexpr int SL_SIZE = SG_SIZE + SH_SIZE, SS_SF = 2 * SL_SIZE;
static_assert(SS_SF + 32768 <= LDS_BYTES - 32, "SSD scan LDS budget");
DI void ssd_scan(LAS unsigned char* lds, const unsigned char* gblk0, const unsigned char* hblk0, bf16_t* YRAW, int row0, int head, float* so, int tid) {
    asm volatile("" : "+v"(tid));
    const int lane = tid & 63, w = tid >> 6, r = lane & 15, q = lane >> 4, ct = w & 3, rh = w >> 2, p0 = 16 * ct;
    f32x4 S[4];
#pragma unroll
    for (int k = 0; k < 4; ++k) S[k] = (f32x4){0.f, 0.f, 0.f, 0.f};
    u32x4 pfA[7], pfB[7];
    constexpr int NG = SG_SIZE / 16, NV = NG + SH_SIZE / 16; static_assert(NV <= 7 * 512, "ssd staging");
#define SSD_LOAD(pf, cc) do { _Pragma("unroll") for (int _k = 0; _k < 7; ++_k) { const int _i = tid + _k * 512; if (_i < NG) pf[_k] = ((const u32x4*)(gblk0 + (size_t)(cc) * SG_SIZE))[_i]; \
        else if (_i < NV) pf[_k] = __builtin_nontemporal_load((const u32x4*)(hblk0 + (size_t)(cc) * 2 * SH_SIZE) + (_i - NG)); } } while (0)
#define SSD_STORE(pf, boff) do { _Pragma("unroll") for (int _k = 0; _k < 7; ++_k) { const int _i = tid + _k * 512; if (_i < NV) ((LAS u32x4*)(lds + (boff)))[_i] = pf[_k]; } } while (0)
    SSD_LOAD(pfA, 0);
    SSD_STORE(pfA, 0);
    SSD_LOAD(pfA, 1); SSD_LOAD(pfB, 2);
    LAS u32x4* SF = (LAS u32x4*)(lds + SS_SF) + ct * 4 * 64;
    SF[(2 * rh) * 64 + lane] = (u32x4){0u, 0u, 0u, 0u}; SF[(2 * rh + 1) * 64 + lane] = (u32x4){0u, 0u, 0u, 0u};
    __syncthreads();
    auto step = [&](auto BC, const int c, u32x4 (&pf)[7]) __attribute__((always_inline)) {
        constexpr int PAR = decltype(BC)::value, BUFC = PAR ? SL_SIZE : 0, BUFN = SL_SIZE - BUFC;
        const LAS unsigned char* bc = lds + BUFC;
        const LAS unsigned char* hd = bc + SG_SIZE;
        const LAS unsigned char* pp = hd + SH_PP;
        const LAS float* sx = (const LAS float*)(hd + SH_SC);
        LAS u32x4* SFc = SF + PAR * 1024; LAS u32x4* SFn = SF + (1 - PAR) * 1024;
        if (c + 1 < 32) SSD_STORE(pf, BUFN);
        if (c + 3 < 32) SSD_LOAD(pf, c + 3);
        const float e = sx[64 + 63];
        f32x4 Y[2];
#pragma unroll
        for (int mm = 0; mm < 2; ++mm) Y[mm] = (f32x4){0.f, 0.f, 0.f, 0.f};
#pragma unroll
        for (int s = 0; s < 4; ++s) { const bf16x8 bs = __builtin_bit_cast(bf16x8, SFc[s * 64 + lane]);
#pragma unroll
            for (int mm = 0; mm < 2; ++mm) Y[mm] = MFMA16(lda_perm(bc + SG_CM, 16 * (2 * rh + mm) + r, 272, 32 * s, q), bs, Y[mm]); }
#pragma unroll
        for (int mm = 0; mm < 2; ++mm)
#pragma unroll
            for (int reg = 0; reg < 4; ++reg) Y[mm][reg] *= sx[64 + 16 * (2 * rh + mm) + 4 * q + reg];
#pragma unroll
        for (int k = 0; k < 4; ++k) S[k] = S[k] * e;
#pragma unroll
        for (int s2 = 0; s2 < 2; ++s2) { const bf16x8 bx = lda_nat(hd + SH_XT, p0 + r, 144, 32 * s2, q);
#pragma unroll
            for (int mm = 0; mm < 2; ++mm) Y[mm] = MFMA16(lda_nat(pp, 16 * (2 * rh + mm) + r, 144, 32 * s2, q), bx, Y[mm]);
            const u32x4 xu = __builtin_bit_cast(u32x4, bx); u32x4 xs;
            const LAS float* wj = sx + 32 * s2 + 8 * q;
            xs.x = pk(bflo(xu.x) * wj[0], bfhi(xu.x) * wj[1]); xs.y = pk(bflo(xu.y) * wj[2], bfhi(xu.y) * wj[3]);
            xs.z = pk(bflo(xu.z) * wj[4], bfhi(xu.z) * wj[5]); xs.w = pk(bflo(xu.w) * wj[6], bfhi(xu.w) * wj[7]);
            const bf16x8 bx2 = __builtin_bit_cast(bf16x8, xs);
#pragma unroll
            for (int k = 0; k < 4; ++k) S[k] = MFMA16(lda_nat(bc + SG_BT, 16 * (4 * rh + k) + r, 144, 32 * s2, q), bx2, S[k]); }
#pragma unroll
        for (int mm = 0; mm < 2; ++mm)
#pragma unroll
            for (int reg = 0; reg < 4; ++reg) YRAW[(size_t)(row0 + c * 64 + 16 * (2 * rh + mm) + 4 * q + reg) * 2048 + head * 64 + p0 + r] = f2bf(Y[mm][reg]);
        SFn[(2 * rh) * 64 + lane] = __builtin_bit_cast(u32x4, pack2(S[0], S[1])); SFn[(2 * rh + 1) * 64 + lane] = __builtin_bit_cast(u32x4, pack2(S[2], S[3]));
        __syncthreads();
    };
#pragma nounroll
    for (int c = 0; c < 32; c += 2) { step(std::integral_constant<int, 0>{}, c, pfA); step(std::integral_constant<int, 1>{}, c + 1, pfB); }
#pragma unroll
    for (int k = 0; k < 4; ++k)
#pragma unroll
        for (int reg = 0; reg < 4; ++reg) so[(16 * (4 * rh + k) + 4 * q + reg) * 64 + p0 + r] = S[k][reg];
#undef SSD_LOAD
#undef SSD_STORE
}

constexpr int XB_STEAL = 3520;
DI int steal_unit(unsigned* ctr, LAS unsigned char* lds, int tid) {
    __syncthreads();
    if (tid == 0) *(LAS int*)(lds + LDS_BYTES - 32) = (int)__hip_atomic_fetch_add(ctr, 1u, __ATOMIC_RELAXED, __HIP_MEMORY_SCOPE_AGENT);
    __syncthreads();
    return *(const LAS int*)(lds + LDS_BYTES - 32);
}
DI void gdn_sample_unit(LAS unsigned char* lds, const Params& p, int li, int s, int h, int tid) {
    asm volatile("" : "+v"(tid));
    const int lane = tid & 63, w = tid >> 6, row = TP + s;
    const bf16_t* pr = (const bf16_t*)(p.ws + WS_PROJ) + (size_t)row * NH;
    LAS float* qkv = (LAS float*)lds; LAS float* red = qkv + 384;
    const float* cbuf = p.in[3] + (size_t)(li * 128 + s) * 3 * 1536; float* cout = p.out + O_SGC + (size_t)(li * 128 + s) * 3 * 1536;
    const float* cwp = p.in[11] + (size_t)li * 4 * 1536;
    if (tid < 384) { const int grp = tid >> 7, cl = tid & 127, ch = grp * 512 + h * 128 + cl;
        const float x = bf2f(pr[ch]), b0 = cbuf[ch], b1 = cbuf[1536 + ch], b2 = cbuf[3072 + ch];
        const float o = b0 * cwp[ch] + b1 * cwp[1536 + ch] + b2 * cwp[3072 + ch] + x * cwp[4608 + ch];
        qkv[tid] = siluf(o); cout[ch] = b1; cout[1536 + ch] = b2; cout[3072 + ch] = x; }
    __syncthreads();
    const float qa = qkv[2 * lane], qb = qkv[2 * lane + 1], ka = qkv[128 + 2 * lane], kb = qkv[128 + 2 * lane + 1];
    const float rq = rsqrtf(wsum(qa * qa + qb * qb) + 1e-6f) * 0.08838834764831845f, rk = rsqrtf(wsum(ka * ka + kb * kb) + 1e-6f);
    const float beta = 1.f / (1.f + __expf(-bf2f(pr[2048 + h])));
    const float g = -__expf(p.in[12][li * 4 + h]) * softplusf(bf2f(pr[2052 + h]) + p.in[13][li * 4 + h]);
    const float e = __expf(g);
    const size_t sidx = ((size_t)(li * 128 + s) * 4 + h) * 128 * 128;
    const float* Sin = p.in[2] + sidx; float* Sout = p.out + O_SGDN + sidx;
    f32x2 Sr[16]; float a0 = 0.f, a1 = 0.f;
#pragma unroll
    for (int rr = 0; rr < 16; ++rr) { Sr[rr] = __builtin_nontemporal_load((const f32x2*)(Sin + (16 * w + rr) * 128 + 2 * lane)) * e; const float kn = qkv[128 + 16 * w + rr] * rk; a0 += kn * Sr[rr][0]; a1 += kn * Sr[rr][1]; }
    red[w * 128 + 2 * lane] = a0; red[w * 128 + 2 * lane + 1] = a1;
    __syncthreads();
    a0 = 0.f; a1 = 0.f;
#pragma unroll
    for (int ww = 0; ww < 8; ++ww) { a0 += red[ww * 128 + 2 * lane]; a1 += red[ww * 128 + 2 * lane + 1]; }
    const float d0 = beta * (qkv[256 + 2 * lane] - a0), d1 = beta * (qkv[256 + 2 * lane + 1] - a1);
    __syncthreads();
    float y0 = 0.f, y1 = 0.f;
#pragma unroll
    for (int rr = 0; rr < 16; ++rr) { const float kn = qkv[128 + 16 * w + rr] * rk, qn = qkv[16 * w + rr] * rq;
        Sr[rr][0] += kn * d0; Sr[rr][1] += kn * d1; y0 += qn * Sr[rr][0]; y1 += qn * Sr[rr][1];
        __builtin_nontemporal_store(Sr[rr], (f32x2*)(Sout + (16 * w + rr) * 128 + 2 * lane)); }
    red[w * 128 + 2 * lane] = y0; red[w * 128 + 2 * lane + 1] = y1;
    __syncthreads();
    if (w == 0) { y0 = 0.f; y1 = 0.f;
#pragma unroll
        for (int ww = 0; ww < 8; ++ww) { y0 += red[ww * 128 + 2 * lane]; y1 += red[ww * 128 + 2 * lane + 1]; }
        *(unsigned*)((bf16_t*)(p.ws + WS_YRAW) + (size_t)row * 2048 + h * 128 + 2 * lane) = pk(y0, y1); }
    __syncthreads();
}
DI void ret_sample_unit(LAS unsigned char* lds, const Params& p, int li, int s, int h, int tid) {
    asm volatile("" : "+v"(tid));
    const int lane = tid & 63, w = tid >> 6, row = TP + s;
    const bf16_t* pr = (const bf16_t*)(p.ws + WS_PROJ) + (size_t)row * NH;
    LAS float* qk = (LAS float*)lds; LAS float* red = qk + 128;
    if (tid < 64) { const int f = tid & 31, which = tid >> 5, base = (which ? 2312 : 2056) + h * 64;
        const float x1 = bf2f(pr[base + f]), x2 = bf2f(pr[base + 32 + f]);
        float sn, cs; rot_sincos(16384.f, f, sn, cs);
        float o1 = x1 * cs - x2 * sn, o2 = x2 * cs + x1 * sn;
        if (which) { o1 *= 0.125f; o2 *= 0.125f; }
        qk[which * 64 + f] = o1; qk[which * 64 + 32 + f] = o2; }
    __syncthreads();
    const float gam = 1.f - exp2f(-5.f - (float)h);
    const unsigned vu = *(const unsigned*)(pr + 2568 + h * 128 + 2 * lane);
    const float va = bflo(vu), vb = bfhi(vu);
    const size_t sidx = ((size_t)(li * 128 + s) * 4 + h) * 64 * 128;
    const float* Sin = p.in[4] + sidx; float* Sout = p.out + O_SRET + sidx;
    float y0 = 0.f, y1 = 0.f;
#pragma unroll
    for (int rr = 0; rr < 8; ++rr) { const int k = 8 * w + rr; f32x2 sv = __builtin_nontemporal_load((const f32x2*)(Sin + k * 128 + 2 * lane)) * gam; const float kk = qk[64 + k], qq = qk[k];
        sv[0] += kk * va; sv[1] += kk * vb; y0 += qq * sv[0]; y1 += qq * sv[1]; __builtin_nontemporal_store(sv, (f32x2*)(Sout + k * 128 + 2 * lane)); }
    red[w * 128 + 2 * lane] = y0; red[w * 128 + 2 * lane + 1] = y1;
    __syncthreads();
    if (w == 0) { y0 = 0.f; y1 = 0.f;
#pragma unroll
        for (int ww = 0; ww < 8; ++ww) { y0 += red[ww * 128 + 2 * lane]; y1 += red[ww * 128 + 2 * lane + 1]; }
        *(unsigned*)((bf16_t*)(p.ws + WS_YRAW) + (size_t)row * 2048 + 512 + h * 128 + 2 * lane) = pk(y0, y1); }
    __syncthreads();
}
DI void ssd_sample_unit(LAS unsigned char* lds, const Params& p, int li, int s, int g, int tid) {
    asm volatile("" : "+v"(tid));
    const int lane = tid & 63, w = tid >> 6, row = TP + s, pq = lane & 15, nq = lane >> 4;
    const bf16_t* pr = (const bf16_t*)(p.ws + WS_PROJ) + (size_t)row * NS;
    LAS float* xs = (LAS float*)lds; LAS float* Bv = xs + 512; LAS float* Cv = xs + 640;
    const float* cbuf = p.in[6] + (size_t)(li * 128 + s) * 3 * 3072; float* cout = p.out + O_SSC + (size_t)(li * 128 + s) * 3 * 3072;
    const float* cwp = p.in[18] + (size_t)li * 4 * 3072; const float* cbp = p.in[19] + (size_t)li * 3072;
    const int head = g * 8 + w;
    const size_t sidx = ((size_t)(li * 128 + s) * 32 + head) * 128 * 64;
    const f32x4* Sin4 = (const f32x4*)(p.in[5] + sidx); f32x4* Sout4 = (f32x4*)(p.out + O_SSSM + sidx);
    f32x4 sb[2][8];
#pragma unroll
    for (int j = 0; j < 8; ++j) sb[0][j] = __builtin_nontemporal_load(Sin4 + j * 64 + lane);
    {
        float xv_[2], b0_[2], b1_[2], b2_[2], w_[2][5]; int ch_[2];
#pragma unroll
        for (int it = 0; it < 2; ++it) { const int t = tid + it * 512; const bool ok = t < 768; const int tc = ok ? t : 0;
            const int ch = tc < 512 ? g * 512 + tc : (tc < 640 ? 2048 + g * 128 + (tc - 512) : 2560 + g * 128 + (tc - 640)); ch_[it] = ch;
            xv_[it] = bf2f(pr[2048 + ch]); b0_[it] = cbuf[ch]; b1_[it] = cbuf[3072 + ch]; b2_[it] = cbuf[6144 + ch];
            w_[it][0] = cwp[ch]; w_[it][1] = cwp[3072 + ch]; w_[it][2] = cwp[6144 + ch]; w_[it][3] = cwp[9216 + ch]; w_[it][4] = cbp[ch]; }
#pragma unroll
        for (int it = 0; it < 2; ++it) { const int t = tid + it * 512; if (t < 768) { const int ch = ch_[it];
            const float o = w_[it][4] + b0_[it] * w_[it][0] + b1_[it] * w_[it][1] + b2_[it] * w_[it][2] + xv_[it] * w_[it][3];
            xs[t] = siluf(o); cout[ch] = b1_[it]; cout[3072 + ch] = b2_[it]; cout[6144 + ch] = xv_[it]; } }
    }
    __syncthreads();
    const float dt = softplusf(bf2f(pr[5120 + head]) + p.in[20][li * 32 + head]);
    const float e = __expf(-__expf(p.in[21][li * 32 + head]) * dt);
    const f32x4 xv = *(const LAS f32x4*)(xs + w * 64 + 4 * pq), xd = xv * dt;
    f32x4 y = (f32x4){0.f, 0.f, 0.f, 0.f};
#pragma unroll
    for (int b = 0; b < 4; ++b) {
        if (b < 3) {
#pragma unroll
            for (int j = 0; j < 8; ++j) sb[(b + 1) & 1][j] = __builtin_nontemporal_load(Sin4 + ((b + 1) * 8 + j) * 64 + lane); }
#pragma unroll
        for (int j = 0; j < 8; ++j) { const int n = 4 * (b * 8 + j) + nq; const f32x4 v = sb[b & 1][j] * e + xd * Bv[n]; y = y + v * Cv[n]; __builtin_nontemporal_store(v, Sout4 + (b * 8 + j) * 64 + lane); }
    }
#pragma unroll
    for (int j = 0; j < 4; ++j) { y[j] += __shfl_xor(y[j], 16); y[j] += __shfl_xor(y[j], 32); }
    y = y + xv * p.in[22][li * 32 + head];
    if (nq == 0) { u32x2 o; o.x = pk(y[0], y[1]); o.y = pk(y[2], y[3]); *(u32x2*)((bf16_t*)(p.ws + WS_YRAW) + (size_t)row * 2048 + head * 64 + 4 * pq) = o; }
    __syncthreads();
}

DI void gate_hyb(const Params& p, int li, int gw, int ngw, int lane) {
    const bf16_t* YR = (const bf16_t*)(p.ws + WS_YRAW); const bf16_t* PROJ = (const bf16_t*)(p.ws + WS_PROJ); bf16_t* MIX = (bf16_t*)(p.ws + WS_MIX);
    const int cl = 8 * (lane & 15), h = lane >> 4;
    f32x4 ga[2], ra[2];
    ga[0] = *(const f32x4*)(p.in[14] + li * 128 + cl); ga[1] = *(const f32x4*)(p.in[14] + li * 128 + cl + 4);
    ra[0] = *(const f32x4*)(p.in[15] + li * 512 + h * 128 + cl); ra[1] = *(const f32x4*)(p.in[15] + li * 512 + h * 128 + cl + 4);
    for (int it0 = gw * 2; it0 < TR * 2; it0 += ngw * 2) {
        u32x4 ya[2], za[2];
#pragma unroll
        for (int rr = 0; rr < 2; ++rr) { const int it = it0 + rr, m = it >> 1, half = it & 1;
            ya[rr] = *(const u32x4*)(YR + (size_t)m * 2048 + half * 512 + h * 128 + cl);
            za[rr] = *(const u32x4*)(PROJ + (size_t)m * NH + (half ? 3080 : 1536) + h * 128 + cl); }
#pragma unroll
        for (int rr = 0; rr < 2; ++rr) { const int it = it0 + rr, m = it >> 1, half = it & 1;
            const unsigned yu[4] = {ya[rr].x, ya[rr].y, ya[rr].z, ya[rr].w}, zu[4] = {za[rr].x, za[rr].y, za[rr].z, za[rr].w};
            float v[8], z[8]; float s1 = 0.f;
#pragma unroll
            for (int j = 0; j < 4; ++j) { v[2 * j] = bflo(yu[j]); v[2 * j + 1] = bfhi(yu[j]); z[2 * j] = bflo(zu[j]); z[2 * j + 1] = bfhi(zu[j]); s1 += v[2 * j] + v[2 * j + 1]; }
            float mean = 0.f;
            if (half) { s1 += __shfl_xor(s1, 1); s1 += __shfl_xor(s1, 2); s1 += __shfl_xor(s1, 4); s1 += __shfl_xor(s1, 8); mean = s1 * (1.f / 128.f); }
            float ss = 0.f;
#pragma unroll
            for (int j = 0; j < 8; ++j) { v[j] -= mean; ss += v[j] * v[j]; }
            ss += __shfl_xor(ss, 1); ss += __shfl_xor(ss, 2); ss += __shfl_xor(ss, 4); ss += __shfl_xor(ss, 8);
            const float rs = rsqrtf(ss * (1.f / 128.f) + 1e-6f);
            float o[8];
#pragma unroll
            for (int j = 0; j < 8; ++j) { const float gn = half ? ra[j >> 2][j & 3] : ga[j >> 2][j & 3]; o[j] = v[j] * rs * gn * siluf(z[j]); }
            u32x4 w; w.x = pk(o[0], o[1]); w.y = pk(o[2], o[3]); w.z = pk(o[4], o[5]); w.w = pk(o[6], o[7]);
            *(u32x4*)(MIX + (size_t)m * 1024 + half * 512 + h * 128 + cl) = w; }
    }
    for (int idx = gw * 64 + lane; idx < 8 * 3 * 1536; idx += ngw * 64) { const int ch = idx % 1536, rr = (idx / 1536) % 3, b = idx / (3 * 1536);
        p.out[O_PGC + (size_t)(li * 8 + b) * 3 * 1536 + rr * 1536 + ch] = bf2f(PROJ[(size_t)(b * SEQ + SEQ - 3 + rr) * NH + ch]); }
}
DI void gate_ssm(const Params& p, int li, int gw, int ngw, int lane) {
    const bf16_t* YR = (const bf16_t*)(p.ws + WS_YRAW); const bf16_t* PROJ = (const bf16_t*)(p.ws + WS_PROJ); bf16_t* MIX = (bf16_t*)(p.ws + WS_MIX);
    const float* nw = p.in[23] + li * 2048;
    for (int m = gw; m < TR; m += ngw) {
        const bf16_t* yr = YR + (size_t)m * 2048; const bf16_t* pr = PROJ + (size_t)m * NS; bf16_t* mx = MIX + (size_t)m * 2048;
        u32x4 ua[4], za[4];
#pragma unroll
        for (int g = 0; g < 4; ++g) { ua[g] = *(const u32x4*)(yr + g * 512 + 8 * lane); za[g] = *(const u32x4*)(pr + g * 512 + 8 * lane); }
#pragma unroll
        for (int g = 0; g < 4; ++g) {
            const u32x4 u = ua[g], z = za[g];
            float v[8]; const unsigned uu[4] = {u.x, u.y, u.z, u.w}, zz[4] = {z.x, z.y, z.z, z.w}; float ss = 0.f;
#pragma unroll
            for (int j = 0; j < 4; ++j) { v[2 * j] = bflo(uu[j]) * siluf(bflo(zz[j])); v[2 * j + 1] = bfhi(uu[j]) * siluf(bfhi(zz[j])); ss += v[2 * j] * v[2 * j] + v[2 * j + 1] * v[2 * j + 1]; }
            const float rs = rsqrtf(wsum(ss) * (1.f / 512.f) + 1e-6f);
            const f32x4 w0 = *(const f32x4*)(nw + g * 512 + 8 * lane), w1 = *(const f32x4*)(nw + g * 512 + 8 * lane + 4);
            u32x4 o; o.x = pk(v[0] * rs * w0[0], v[1] * rs * w0[1]); o.y = pk(v[2] * rs * w0[2], v[3] * rs * w0[3]); o.z = pk(v[4] * rs * w1[0], v[5] * rs * w1[1]); o.w = pk(v[6] * rs * w1[2], v[7] * rs * w1[3]);
            *(u32x4*)(mx + g * 512 + 8 * lane) = o;
        }
    }
    for (int idx = gw * 64 + lane; idx < 8 * 3 * 3072; idx += ngw * 64) { const int ch = idx % 3072, rr = (idx / 3072) % 3, b = idx / (3 * 3072);
        p.out[O_PSC + (size_t)(li * 8 + b) * 3 * 3072 + rr * 3072 + ch] = bf2f(PROJ[(size_t)(b * SEQ + SEQ - 3 + rr) * NS + 2048 + ch]); }
}

struct EpiBR {
    static constexpr bool PERM = true, AFTER_DRAIN = false;
    bf16_t* O; int ldc; int act;
    DI void operator()(const f32x4 (&acc)[2][2][4][2], const pg8::Unit& u, int wr, int wc, int fr, int fq) const {
        const int row0 = u.pm * 256 + wr * 64 + fr, col0 = u.pn * 256 + wc * 32 + 8 * fq;
#pragma unroll
        for (int ai = 0; ai < 2; ++ai)
#pragma unroll
            for (int m = 0; m < 4; ++m) { bf16_t* rowp = O + (size_t)(row0 + ai * 128 + m * 16) * ldc + col0;
#pragma unroll
                for (int bj = 0; bj < 2; ++bj) { f32x4 v0 = acc[ai][bj][m][0], v1 = acc[ai][bj][m][1];
                    if (act) {
#pragma unroll
                        for (int j = 0; j < 4; ++j) { const float a = fmaxf(v0[j], 0.f), b = fmaxf(v1[j], 0.f); v0[j] = a * a; v1[j] = b * b; } }
                    u32x4 w; w.x = pk(v0[0], v0[1]); w.y = pk(v0[2], v0[3]); w.z = pk(v1[0], v1[1]); w.w = pk(v1[2], v1[3]);
                    *(u32x4*)(rowp + bj * 128) = w; } }
    }
};
template <int EPI> DI void skinny_tile(LAS unsigned char* lds, const bf16_t* A, const bf16_t* Bt, const int Kext, void* outp, const int ldc, int tid, const int lda = 0) {
    asm volatile("" : "+v"(tid));
    const int lane = tid & 63, w = tid >> 6, r = lane & 15, q = lane >> 4;
    const int K = lda ? lda : Kext;
    constexpr int kw = 128; (void)Kext;
    f32x4 acc[8];
#pragma unroll
    for (int m = 0; m < 8; ++m) acc[m] = (f32x4){0.f, 0.f, 0.f, 0.f};
    const bf16_t* ap = A + (size_t)r * K + w * kw + 8 * q; const bf16_t* bp = Bt + (size_t)r * K + w * kw + 8 * q;
#pragma unroll
    for (int k0 = 0; k0 < kw; k0 += 32) {
        const bf16x8 b = *(const bf16x8*)(bp + k0);
#pragma unroll
        for (int m = 0; m < 8; ++m) acc[m] = MFMA16(*(const bf16x8*)(ap + (size_t)(16 * m) * K + k0), b, acc[m]);
    }
    LAS float* part = (LAS float*)lds;
#pragma unroll
    for (int m = 0; m < 8; ++m)
#pragma unroll
        for (int reg = 0; reg < 4; ++reg) part[(w * 128 + 16 * m + 4 * q + reg) * 16 + r] = acc[m][reg];
    __syncthreads();
    const int row = tid >> 2, c4 = (tid & 3) * 4;
    f32x4 sum = (f32x4){0.f, 0.f, 0.f, 0.f};
#pragma unroll
    for (int ww = 0; ww < 8; ++ww) sum = sum + *(const LAS f32x4*)(part + (ww * 128 + row) * 16 + c4);
    if (EPI == 2) { f32x4* o = (f32x4*)((float*)outp + (size_t)row * ldc + c4); *o = *o + sum; }
    else if (EPI == 3) { float* o = (float*)outp + (size_t)row * ldc + c4;
#pragma unroll
        for (int j = 0; j < 4; ++j) (void)__hip_atomic_fetch_add(o + j, sum[j], __ATOMIC_RELAXED, __HIP_MEMORY_SCOPE_AGENT); }
    else { if (EPI == 1) {
#pragma unroll
            for (int j = 0; j < 4; ++j) { const float a = fmaxf(sum[j], 0.f); sum[j] = a * a; } }
        u32x2 o; o.x = pk(sum[0], sum[1]); o.y = pk(sum[2], sum[3]); *(u32x2*)((bf16_t*)outp + (size_t)row * ldc + c4) = o; }
    __syncthreads();
}

template <int KIND, bool hyb> DI void run_phase(const Params& P, LAS unsigned char* lds, const int L, const int tid, const int bid, const int G) {
    const int lane = tid & 63, wv = tid >> 6, gw = bid * 8 + wv, ngw = G * 8, li = L >> 1;
    unsigned char* ws = P.ws;
    bf16_t* H = (bf16_t*)(ws + WS_H); bf16_t* PROJ = (bf16_t*)(ws + WS_PROJ); bf16_t* YRAW = (bf16_t*)(ws + WS_YRAW); bf16_t* MIX = (bf16_t*)(ws + WS_MIX); bf16_t* ACT = (bf16_t*)(ws + WS_ACT);
    float* X = (float*)(ws + WS_X);
    if constexpr (KIND == 0) prologue(P, lds, gw, ngw, wv, lane);
    if constexpr (KIND == 1) norm_rows(P, P.in[7] + L * D, L == 0, gw, ngw, lane);
    if constexpr (KIND == 7) norm_rows(P, P.in[8] + L * D, false, gw, ngw, lane);
    if constexpr (KIND == 2 || KIND == 8) {
        constexpr bool up = KIND == 8;
        const bf16_t* Bt = up ? (const bf16_t*)(ws + WS_W1) + (size_t)L * FF * 1024 : (hyb ? (const bf16_t*)(ws + WS_WINH) + (size_t)li * NH * 1024 : (const bf16_t*)(ws + WS_WINS) + (size_t)li * NS * 1024);
        constexpr int N = up ? FF : (hyb ? NH : NS), NMAIN = up ? FF : (hyb ? NH : 5120);
        pg8::Gemm g{H, Bt, TP, NMAIN, 1024}; pg8::StaticOrder S; S.init(TP, NMAIN, G, bid); EpiB<up ? 1 : 0> E{up ? ACT : PROJ, N};
        pg8::gemm_phase<EpiB<up ? 1 : 0>, pg8::StaticOrder>((PG8_LAS unsigned char*)lds, g, S, E, nullptr, tid);
        constexpr int NCB = up ? FF / 16 : (hyb ? (NHR + 15) / 16 : NSR / 16);
        constexpr int NT = NCB + ((!up && !hyb) ? 256 : 0);
        const int nw = (!up && hyb) ? 64 : G;
        const int first = G - 1 - bid;
        if (first < nw) {
#pragma nounroll
            for (int t = first; t < NT; t += nw) {
                if (t < NCB) skinny_tile<up ? 1 : 0>(lds, H + (size_t)TP * 1024, Bt + (size_t)t * 16 * 1024, 1024, (up ? ACT : PROJ) + (size_t)TP * N + t * 16, N, tid);
                else { const int t2 = t - NCB, rb = t2 >> 1, cb = t2 & 1;
                    skinny_tile<0>(lds, H + (size_t)rb * 128 * 1024, Bt + (size_t)(5120 + cb * 16) * 1024, 1024, PROJ + (size_t)rb * 128 * N + 5120 + cb * 16, N, tid); }
            }
        }
    }
    if constexpr (KIND == 6 || KIND == 9) {
        constexpr bool dn = KIND == 9;
        const bf16_t* Bt = dn ? (const bf16_t*)(ws + WS_W2) + (size_t)L * 1024 * FF : (hyb ? (const bf16_t*)(ws + WS_WOUTH) + (size_t)li * 1024 * 1024 : (const bf16_t*)(ws + WS_WOUTS) + (size_t)li * 1024 * 2048);
        constexpr int K = dn ? FF : (hyb ? 1024 : 2048);
        pg8::Gemm g{dn ? ACT : MIX, Bt, TP, 1024, K}; pg8::StaticOrder S; S.init(TP, 1024, G, bid); EpiRes E{(bf16_t*)(ws + WS_X)};
        pg8::gemm_phase<EpiRes, pg8::StaticOrder>((PG8_LAS unsigned char*)lds, g, S, E, nullptr, tid);
        const int first = G - 1 - bid;
        constexpr int KS = K / 1024;
#pragma nounroll
        for (int t = first; t < 64 * KS; t += G) { const int ct = t / KS, ks = t % KS;
            skinny_tile<3>(lds, (dn ? ACT : MIX) + (size_t)TP * K + ks * 1024, Bt + (size_t)ct * 16 * K + ks * 1024, 1024, (float*)(ws + WS_XS) + ct * 16, 1024, tid, K); }
    }
    if constexpr (KIND == 3) {
        if constexpr (hyb) {
#pragma nounroll
            for (int u = bid; u < 1024; u += G) { const int b = u >> 7, c = (u >> 2) & 31, h = u & 3;
                gdn_prep_unit(lds, PROJ, P.in[11] + (size_t)li * 4 * 1536, P.in[12][li * 4 + h], P.in[13][li * 4 + h], ws + WS_CHK + CHK_GDN + (size_t)((b * 4 + h) * 32 + c) * GB_SIZE, b * SEQ + c * 64, h, tid); }
#ifdef PROBE_GDNPREP
#pragma nounroll
            for (int u = bid; u < 1024; u += G) { const int b = u >> 7, c = (u >> 2) & 31, h = u & 3;
                gdn_prep_unit(lds, PROJ, P.in[11] + (size_t)li * 4 * 1536, P.in[12][li * 4 + h], P.in[13][li * 4 + h], ws + WS_CHK + CHK_GDN + (size_t)((b * 4 + h) * 32 + c) * GB_SIZE, b * SEQ + c * 64, h, tid); }
#endif
#pragma nounroll
            for (int u2 = bid; u2 < 1024; u2 += G) { const int b = u2 >> 7, c = (u2 >> 2) & 31, h = u2 & 3;
                ret_prep_unit(lds, PROJ, ws + WS_CHK + CHK_RET + (size_t)((b * 4 + h) * 32 + c) * RB_SIZE, b * SEQ + c * 64, h, tid); }
        } else {
            for (int u = bid; u < 1024; u += G) { const int b = u >> 7, c = (u >> 2) & 31, g = u & 3;
                ssd_prep_unit(lds, PROJ, P.in[18] + (size_t)li * 4 * 3072, P.in[19] + (size_t)li * 3072, P.in[20] + li * 32, P.in[21] + li * 32, P.in[22] + li * 32,
                              ws + WS_CHK + CHK_SG + (size_t)((b * 4 + g) * 32 + c) * SG_SIZE, ws + WS_CHK + CHK_SH + (size_t)(((b * 16 + 4 * g) * 32 + c) * 2) * SH_SIZE, b * SEQ + c * 64, g, tid); }
        }
    }
    if constexpr (KIND == 4) {
        if constexpr (hyb) {
            if (bid < 128) { const int xq = bid & 7, jq = bid >> 3, bh = xq * 4 + (jq >> 2), b = bh >> 2, h = bh & 3;
                gdn_scan(lds, ws + WS_CHK + CHK_GDN + (size_t)((b * 4 + h) * 32) * GB_SIZE, YRAW, b * SEQ, h, P.out + O_PGDN + (size_t)((li * 8 + b) * 4 + h) * 128 * 128, tid, jq & 3); }
            else if (bid < 160) { const int b = (bid - 128) >> 2, h = bid & 3;
                ret_scan(lds, ws + WS_CHK + CHK_RET + (size_t)((b * 4 + h) * 32) * RB_SIZE, YRAW, b * SEQ, h, P.out + O_PRET + (size_t)((li * 8 + b) * 4 + h) * 64 * 128, tid); }
            for (;;) { const int u = steal_unit((unsigned*)(ws + WS_BAR) + XB_STEAL + 64 * L, lds, tid); if (u >= 1024) break;
                if (u < 512) gdn_sample_unit(lds, P, li, u >> 2, u & 3, tid); else ret_sample_unit(lds, P, li, (u - 512) >> 2, u & 3, tid); }
        } else {
#pragma nounroll
            for (int unit = bid; unit < 256; unit += G) { const int xq = unit & 7, jq = unit >> 3, grp = xq * 4 + (jq >> 3), b = grp >> 2, g = grp & 3, head = g * 8 + (jq & 7), u = head >> 1;
                ssd_scan(lds, ws + WS_CHK + CHK_SG + (size_t)((b * 4 + g) * 32) * SG_SIZE, ws + WS_CHK + CHK_SH + (size_t)(((b * 16 + u) * 32) * 2 + (head & 1)) * SH_SIZE, YRAW, b * SEQ, head,
                         P.out + O_PSSM + (size_t)((li * 8 + b) * 32 + head) * 128 * 64, tid); }
            for (;;) { const int u = steal_unit((unsigned*)(ws + WS_BAR) + XB_STEAL + 64 * L, lds, tid); if (u >= 512) break; ssd_sample_unit(lds, P, li, u >> 2, u & 3, tid); }
        }
    }
    if constexpr (KIND == 5) { if constexpr (hyb) gate_hyb(P, li, gw, ngw, lane); else gate_ssm(P, li, gw, ngw, lane); }
    if constexpr (KIND == 10) final_norm(P, gw, ngw, lane);
}
constexpr int LDS_ST = LDS_BYTES - 16;
template <int PH> DI void do_phase(const Params& p, cg::grid_group& grid, const int wid_s) {
    constexpr int kind = PH == 37 ? 10 : (PH == 0 ? 0 : 1 + (PH - 1) % 9), L = (PH == 0 || PH == 37) ? 0 : (PH - 1) / 9;
    constexpr bool hyb = (L & 1) == 0, hsel = (kind == 2 || kind == 3 || kind == 4 || kind == 5 || kind == 6) ? hyb : true;
    extern __shared__ __attribute__((aligned(16))) unsigned char smem[];
    int tid; asm volatile("v_mbcnt_lo_u32_b32 %0, -1, 0\n\tv_mbcnt_hi_u32_b32 %0, -1, %0" : "=v"(tid)); tid += wid_s * 64;
    unsigned lbase = 0; asm volatile("" : "+v"(lbase));
    LAS unsigned char* lds = (LAS unsigned char*)smem + lbase;
    int bid = blockIdx.x; asm volatile("" : "+s"(bid));
    int Gr = (int)gridDim.x; asm volatile("" : "+s"(Gr));
    run_phase<kind, hsel>(p, lds, L, tid, bid, Gr);
#ifdef PROBE_DUP
    if constexpr ((((PROBE_DUP) >> kind) & 1) && (PROBE_HYB == 2 || (PROBE_HYB == 1) == hyb)) { __syncthreads(); asm volatile("" : "+v"(tid)); run_phase<kind, hsel>(p, lds, L, tid, bid, Gr); }
#endif
    if (PH == 0) grid.sync();
    else if (PH < 37) { XcdBarrier b; b.bar = (unsigned*)(p.ws + WS_BAR); b.x = xb_xcc_id(); b.wid = wid_s; b.st = (volatile LAS unsigned*)((LAS unsigned char*)smem + LDS_ST); xcd_barrier(b); }
}
template <int... PH> DI void all_phases(const Params& p, cg::grid_group& grid, const int wid_s, std::integer_sequence<int, PH...>) { (do_phase<PH>(p, grid, wid_s), ...); }
__global__ void __launch_bounds__(512, 2) fwd_megakernel(Params p) {
    extern __shared__ __attribute__((aligned(16))) unsigned char smem[];
    cg::grid_group grid = cg::this_grid();
    const int wid_s = __builtin_amdgcn_readfirstlane(threadIdx.x >> 6);
    if (threadIdx.x == 0) { volatile LAS unsigned* st = (volatile LAS unsigned*)((LAS unsigned char*)smem + LDS_ST); st[0] = 0u; st[1] = 0u; }
    __syncthreads();
    (void)xcd_barrier_post((unsigned*)(p.ws + WS_BAR), (volatile LAS unsigned*)((LAS unsigned char*)smem + LDS_ST), wid_s);
    all_phases(p, grid, wid_s, std::make_integer_sequence<int, 38>{});
}

extern "C" void kernel_launch(void* const* d_in, const int* in_sizes, int n_in, void* d_out, int out_size, void* d_ws, size_t ws_size, hipStream_t stream) {
    static int grid = 0;
    if (grid == 0) {
        if (n_in != 27 || ws_size < WS_END) { fprintf(stderr, "kernel_launch: bad inputs n_in=%d ws=%zu need %zu\n", n_in, ws_size, (size_t)WS_END); grid = -1; return; }
        int dev = 0, cus = 0, per_cu = 0;
        (void)hipGetDevice(&dev); (void)hipDeviceGetAttribute(&cus, hipDeviceAttributeMultiprocessorCount, dev);
        if (hipFuncSetAttribute((const void*)fwd_megakernel, hipFuncAttributeMaxDynamicSharedMemorySize, LDS_BYTES) != hipSuccess) { fprintf(stderr, "kernel_launch: hipFuncSetAttribute failed\n"); grid = -1; return; }
        (void)hipOccupancyMaxActiveBlocksPerMultiprocessor(&per_cu, (const void*)fwd_megakernel, 512, LDS_BYTES);
        if (per_cu < 1) { fprintf(stderr, "kernel_launch: occupancy query says %d blocks/CU\n", per_cu); per_cu = 1; }
        (void)hipGetLastError();
        grid = cus;
        if (grid < 192) fprintf(stderr, "kernel_launch: only %d CUs\n", grid);
    }
    if (grid < 0) return;
    Params p{};
    for (int i = 0; i < 27; ++i) p.in[i] = (const float*)d_in[i];
    p.out = (float*)d_out; p.ws = (unsigned char*)d_ws; p.ph_lo = 0; p.ph_hi = 38;
    if (hipMemsetAsync((char*)d_ws + WS_BAR, 0, 16384, stream) != hipSuccess) { fprintf(stderr, "kernel_launch: memset failed\n"); return; }
    void* args[] = {&p};
    hipError_t e = hipLaunchCooperativeKernel((const void*)fwd_megakernel, dim3(grid), dim3(512), args, LDS_BYTES, stream);
    if (e != hipSuccess) fprintf(stderr, "cooperative launch failed: %s (grid %d)\n", hipGetErrorString(e), grid);
}
```
